# Optimizing an MI355X kernel written in HIP

```python
import math
import jax, jax.numpy as jnp
from jax import lax
import numpy as np

D_MODEL = 1024
BATCH = 4
SEQ = 4096
DEPTH = 4
DEC_BATCH = 128
DEC_SEQ = 4
PAST_LEN = 8192
PAGE_SIZE = 128

N_META = 16
N_A_LAYERS = DEPTH // 2
N_B_LAYERS = DEPTH - N_A_LAYERS
CONV_DIM = D_MODEL
CONV_WIDTH = 3
N_HEADS = 16
QK_NOPE = 64
QK_ROPE = 32
V_HEAD = 64
Q_LORA = D_MODEL // 2
KV_LORA = D_MODEL // 4
MLA_DIM = N_HEADS * V_HEAD
ROPE_THETA = 10000.0
RMS_EPS = 1e-6
Q_BLOCK = 128
SOFTMAX_SCALE = (QK_NOPE + QK_ROPE) ** -0.5

kernel_name = "yoco_shortconv_mla_decoder_step"


def rmsnorm(x, g):
    xf = x.astype(jnp.float32)
    y = xf * lax.rsqrt(jnp.mean(xf * xf, axis=-1, keepdims=True) + RMS_EPS)
    return (y * g.astype(jnp.float32)).astype(x.dtype)


def rope(x, pos):
    half = x.shape[-1] // 2
    inv = ROPE_THETA ** (-jnp.arange(half, dtype=jnp.float32) / half)
    ang = pos.astype(jnp.float32)[:, None] * inv[None, :]
    cos = jnp.cos(ang)[None, :, None, :]
    sin = jnp.sin(ang)[None, :, None, :]
    xf = x.astype(jnp.float32)
    x1, x2 = xf[..., :half], xf[..., half:]
    return jnp.concatenate([x1 * cos - x2 * sin, x1 * sin + x2 * cos], axis=-1).astype(x.dtype)


def conv_mixer(h, prev, w_in, conv_w, w_out):
    L = h.shape[1]
    b_gate, c_gate, u, z = jnp.split(h @ w_in, 4, axis=-1)
    v = c_gate * u
    vc = jnp.concatenate([prev.astype(v.dtype), v], axis=1)
    y = conv_w[0] * vc[:, 0:L]
    for k in range(1, CONV_WIDTH):
        y = y + conv_w[k] * vc[:, k:k + L]
    out = (b_gate * y * jax.nn.silu(z)) @ w_out
    return out, vc[:, L:]


def shared_latent(s, pos, kv_norm_g, w_dkv, kv_lat_g):
    ckr = rmsnorm(s, kv_norm_g) @ w_dkv
    c = rmsnorm(ckr[..., :KV_LORA], kv_lat_g)
    kr = rope(ckr[..., None, KV_LORA:], pos)[:, :, 0]
    return c, kr


def mla_query(h, pos, w_in, q_norm_g, w_uq):
    proj = h @ w_in
    q_lat, z = proj[..., :Q_LORA], proj[..., Q_LORA:]
    q = (rmsnorm(q_lat, q_norm_g) @ w_uq).reshape(h.shape[0], h.shape[1], N_HEADS, QK_NOPE + QK_ROPE)
    return q[..., :QK_NOPE], rope(q[..., QK_NOPE:], pos), z


def attend(q, k, v, q_pos, k_pos):
    Bq, Q = q.shape[0], q.shape[1]
    qb = min(Q_BLOCK, Q)
    nb = -(-Q // qb)
    pad = nb * qb - Q
    qp = jnp.pad(q, ((0, 0), (0, pad), (0, 0), (0, 0), (0, 0)))
    pp = jnp.pad(q_pos, (0, pad), mode='edge')
    q_blocks = jnp.swapaxes(qp.reshape((Bq, nb, qb) + q.shape[2:]), 0, 1)
    p_blocks = pp.reshape(nb, qb)
    neg = jnp.finfo(jnp.float32).min

    def one_block(args):
        qi, pi = args
        s = jnp.einsum('bqghd,bkgd->bghqk', qi, k, preferred_element_type=jnp.float32) * SOFTMAX_SCALE
        s = jnp.where(k_pos[None, :] <= pi[:, None], s, neg)
        p = jax.nn.softmax(s, axis=-1)
        return jnp.einsum('bghqk,bkgv->bqghv', p.astype(v.dtype), v)

    out = lax.map(one_block, (q_blocks, p_blocks))
    out = jnp.swapaxes(out, 0, 1).reshape((Bq, nb * qb) + out.shape[3:])
    return out[:, :Q]


def setup_inputs(seed: int = 0) -> dict:
    key = jax.random.key(seed)
    ks = jax.random.split(key, 24)
    n_pages = PAST_LEN // PAGE_SIZE
    n_used = DEC_BATCH * n_pages
    n_pool = n_used + n_used // 4
    f32 = jnp.float32
    nrm = lambda k, shape, s: jax.random.normal(k, shape, f32) * s
    gain = lambda k, shape: 1.0 + 0.05 * jax.random.normal(k, shape, f32)
    page_table = jax.random.permutation(ks[0], n_pool)[:n_used].reshape(DEC_BATCH, n_pages).astype(jnp.int32)
    return {
        "x_prompt": nrm(ks[1], (BATCH, SEQ, D_MODEL), 1.0),
        "x_sample": nrm(ks[2], (DEC_BATCH, DEC_SEQ, D_MODEL), 1.0),
        "cache_ckv": nrm(ks[3], (n_pool, PAGE_SIZE, KV_LORA), 1.0),
        "cache_krope": nrm(ks[4], (n_pool, PAGE_SIZE, QK_ROPE), 1.0),
        "state_conv": nrm(ks[5], (N_A_LAYERS, DEC_BATCH, CONV_WIDTH - 1, CONV_DIM), 1.0),
        "page_table": page_table,
        "meta_tokens": nrm(ks[6], (N_META, D_MODEL), 1.0),
        "pre_norm_g": gain(ks[7], (DEPTH, D_MODEL)),
        "post_norm_g": gain(ks[8], (DEPTH, D_MODEL)),
        "w_in_conv": nrm(ks[9], (N_A_LAYERS, D_MODEL, 4 * CONV_DIM), D_MODEL ** -0.5),
        "conv_w": nrm(ks[10], (N_A_LAYERS, CONV_WIDTH, CONV_DIM), CONV_WIDTH ** -0.5),
        "w_out_conv": nrm(ks[11], (N_A_LAYERS, CONV_DIM, D_MODEL), CONV_DIM ** -0.5),
        "kv_norm_g": gain(ks[12], (D_MODEL,)),
        "w_dkv": nrm(ks[13], (D_MODEL, KV_LORA + QK_ROPE), D_MODEL ** -0.5),
        "kv_lat_norm_g": gain(ks[14], (KV_LORA,)),
        "w_uk": nrm(ks[15], (KV_LORA, N_HEADS, QK_NOPE), KV_LORA ** -0.5),
        "w_uv": nrm(ks[16], (KV_LORA, N_HEADS, V_HEAD), KV_LORA ** -0.5),
        "w_in_mla": nrm(ks[17], (N_B_LAYERS, D_MODEL, Q_LORA + MLA_DIM), D_MODEL ** -0.5),
        "q_norm_g": gain(ks[18], (N_B_LAYERS, Q_LORA)),
        "w_uq": nrm(ks[19], (N_B_LAYERS, Q_LORA, N_HEADS * (QK_NOPE + QK_ROPE)), Q_LORA ** -0.5),
        "w_out_mla": nrm(ks[20], (N_B_LAYERS, MLA_DIM, D_MODEL), MLA_DIM ** -0.5),
    }


def reference(x_prompt, x_sample, cache_ckv, cache_krope, state_conv, page_table, meta_tokens,
              pre_norm_g, post_norm_g, w_in_conv, conv_w, w_out_conv, kv_norm_g, w_dkv,
              kv_lat_norm_g, w_uk, w_uv, w_in_mla, q_norm_g, w_uq, w_out_mla):

    def trunk(x, pos, conv_prev, past_c, past_kr, k_pos):
        absorbed = past_c is not None
        new_conv = []
        keys = vals = c_new = kr_new = None
        for l in range(DEPTH):
            h = rmsnorm(x, pre_norm_g[l])
            if l < N_A_LAYERS:
                m, st = conv_mixer(h, conv_prev[l], w_in_conv[l], conv_w[l], w_out_conv[l])
                new_conv.append(st)
            else:
                j = l - N_A_LAYERS
                q_nope, q_rope, z = mla_query(h, pos, w_in_mla[j], q_norm_g[j], w_uq[j])
                Bx, L = h.shape[0], h.shape[1]
                if absorbed:
                    q_lat = jnp.einsum('blhd,chd->blhc', q_nope, w_uk)
                    q = jnp.concatenate([q_lat, q_rope], axis=-1)[:, :, None]
                    o_lat = attend(q, keys, vals, pos, k_pos)[:, :, 0]
                    o = jnp.einsum('blhc,chv->blhv', o_lat, w_uv)
                else:
                    q = jnp.concatenate([q_nope, q_rope], axis=-1)[:, :, :, None]
                    o = attend(q, keys, vals, pos, k_pos)[:, :, :, 0]
                m = (o.reshape(Bx, L, MLA_DIM) * jax.nn.silu(z)) @ w_out_mla[j]
            x = x + rmsnorm(m, post_norm_g[l])
            if l == N_A_LAYERS - 1:
                c_new, kr_new = shared_latent(x, pos, kv_norm_g, w_dkv, kv_lat_norm_g)
                if absorbed:
                    c_all = jnp.concatenate([past_c.astype(c_new.dtype), c_new], axis=1)
                    kr_all = jnp.concatenate([past_kr.astype(kr_new.dtype), kr_new], axis=1)
                    keys = jnp.concatenate([c_all, kr_all], axis=-1)[:, :, None]
                    vals = c_all[:, :, None]
                else:
                    k_nope = jnp.einsum('btc,chd->bthd', c_new, w_uk)
                    k_rope_h = jnp.broadcast_to(kr_new[:, :, None], kr_new.shape[:2] + (N_HEADS, QK_ROPE))
                    keys = jnp.concatenate([k_nope, k_rope_h], axis=-1)
                    vals = jnp.einsum('btc,chv->bthv', c_new, w_uv)
        return x, c_new, kr_new, jnp.stack(new_conv)

    bp = x_prompt.shape[0]
    t_total = x_prompt.shape[1] + N_META
    meta = jnp.broadcast_to(meta_tokens[None].astype(x_prompt.dtype), (bp, N_META, D_MODEL))
    xp = jnp.concatenate([meta, x_prompt], axis=1)
    pos_p = jnp.arange(t_total, dtype=jnp.int32)
    conv0 = jnp.zeros((N_A_LAYERS, bp, CONV_WIDTH - 1, CONV_DIM), x_prompt.dtype)
    hp, ckv_prompt, krope_prompt, conv_prompt = trunk(xp, pos_p, conv0, None, None, pos_p)
    y_prompt = hp[:, N_META:]

    bs, ls = x_sample.shape[0], x_sample.shape[1]
    past_len = page_table.shape[1] * cache_ckv.shape[1]
    past_c = cache_ckv[page_table].reshape(bs, past_len, KV_LORA)
    past_kr = cache_krope[page_table].reshape(bs, past_len, QK_ROPE)
    pos_s = past_len + jnp.arange(ls, dtype=jnp.int32)
    k_pos_s = jnp.arange(past_len + ls, dtype=jnp.int32)
    y_sample, ckv_sample, krope_sample, conv_sample = trunk(x_sample, pos_s, state_conv, past_c, past_kr, k_pos_s)

    return (y_prompt, y_sample, ckv_prompt, krope_prompt, conv_prompt, ckv_sample, krope_sample, conv_sample)
```

```cpp
#include <hip/hip_runtime.h>
#include <hip/hip_bf16.h>
#include <cstdio>
#include <cstdint>
#include <cmath>

constexpr int DM = 1024, NB = 4, SEQ = 4096, NMETA = 16, TTOT = SEQ + NMETA;
constexpr int DECB = 128, DECS = 4, PAST = 8192, PAGE = 128, NPAGES = PAST / PAGE;
constexpr int NH = 16, QKN = 64, QKR = 32, VH = 64, QLORA = 512, KVL = 256;
constexpr int NMAIN = NB * SEQ;
constexpr int SAMP0 = NMAIN, NSAMP = DECB * DECS;
constexpr int META0 = SAMP0 + NSAMP;
constexpr int NROWS = META0 + 256;
constexpr int NPOS = TTOT + DECS;
constexpr float RMS_EPS = 1e-6f;
constexpr float QSCALE = 0.10206207261596575f * 1.4426950408889634f;

__device__ __forceinline__ float shfl_xor_f(float v, int mask, int lane) { return __int_as_float(__builtin_amdgcn_ds_bpermute((lane ^ mask) << 2, __float_as_int(v))); }

namespace pg8 {
#define PG8_LAS __attribute__((address_space(3)))
typedef unsigned short bf16_t;
typedef short bf16x8 __attribute__((ext_vector_type(8)));
typedef float f32x4 __attribute__((ext_vector_type(4)));
typedef unsigned u32x4 __attribute__((ext_vector_type(4)));
constexpr int BM = 256, BK = 64, HALF = 128, HTB = HALF * BK * 2  , STAGE_BYTES = 8 * HTB, NXCD = 8, WGM = 8;

__host__ __device__ __forceinline__ int lds_byte(int r, int c) { const int st = (r >> 4) * 2 + (c >> 5), rr = r & 15, cc = c & 31, ob = rr * 64 + cc * 2; return st * 1024 + (ob ^ (((ob >> 9) & 1) << 5)); }
__host__ __device__ __forceinline__ void stage_rc(int b, int& R, int& C) { const int st = b / 1024, sb = b % 1024, swz = sb ^ (((sb >> 9) & 1) << 5); R = (st >> 1) * 16 + swz / 64; C = (st & 1) * 32 + (swz % 64) / 2; }
__host__ __device__ __forceinline__ int perm32(int rho) { const int n = rho >> 4, i = rho & 15; return 8 * (i >> 2) + 4 * n + (i & 3); }

struct Unit { int pm, pn; };
struct Gemm { const bf16_t* A; const bf16_t* Bt; int M, N, K; };

struct StaticOrder {
    int nM, nN, nwg, G, c;
    __host__ __device__ void init(int M, int N, int G_, int c_) { nM = M / BM; nN = N / BM; nwg = nM * nN; G = G_; c = c_; }
    __host__ __device__ bool next(int i, Unit& u) const {
        const long L = (long)i * G + c; if (L >= nwg) return false;
        int wgid = (int)L; { const int q = nwg / NXCD, r = nwg % NXCD, xcd = wgid % NXCD, off = wgid / NXCD; wgid = (xcd < r ? xcd * (q + 1) : r * (q + 1) + (xcd - r) * q) + off; }
        const int nig = WGM * nN, gid = wgid / nig, fm = gid * WGM, gsz = (nM - fm) < WGM ? (nM - fm) : WGM;
        u.pm = fm + ((wgid % nig) % gsz); u.pn = (wgid % nig) / gsz; return true;
    }
    __device__ __forceinline__ void a_ready(const Unit&) const {}
    __device__ __forceinline__ void done(const Unit&) const {}
};


__device__ __forceinline__ unsigned cvt_pk_bf16(float lo, float hi) { unsigned r; asm volatile("v_cvt_pk_bf16_f32 %0, %1, %2" : "=v"(r) : "v"(lo), "v"(hi)); return r; }
typedef unsigned u32x2 __attribute__((ext_vector_type(2)));
__device__ __forceinline__ float sigmoidf_fast(float z) { return __builtin_amdgcn_rcpf(1.0f + __builtin_amdgcn_exp2f(-1.4426950408889634f * z)); }

struct EpiBf16 {
    static constexpr bool PERM = true, AFTER_DRAIN = false;
    bf16_t* O; int ldc; int split_cols; size_t split_stride;
    __device__ __forceinline__ void operator()(const f32x4 (&acc)[2][2][4][2], const Unit& u, int wr, int wc, int fr, int fq) const {
        const int row0 = u.pm * BM + wr * 64 + fr; int colt = u.pn * BM; bf16_t* base = O;
        if (split_cols && colt >= split_cols) { base += split_stride; colt -= split_cols; }
        const int col0 = colt + wc * 32 + 8 * fq;
#pragma unroll
        for (int ai = 0; ai < 2; ++ai)
#pragma unroll
            for (int m = 0; m < 4; ++m) { bf16_t* rowp = base + (size_t)(row0 + ai * HALF + m * 16) * ldc + col0;
#pragma unroll
                for (int bj = 0; bj < 2; ++bj) { const f32x4 v0 = acc[ai][bj][m][0], v1 = acc[ai][bj][m][1];
                    u32x4 w; w.x = cvt_pk_bf16(v0[0], v0[1]); w.y = cvt_pk_bf16(v0[2], v0[3]); w.z = cvt_pk_bf16(v1[0], v1[1]); w.w = cvt_pk_bf16(v1[2], v1[3]);
                    *(u32x4*)(rowp + bj * HALF) = w; } }
    }
};

struct EpiConvSplit {
    static constexpr bool PERM = true, AFTER_DRAIN = false;
    bf16_t* V; bf16_t* GZ;
    __device__ __forceinline__ void operator()(const f32x4 (&acc)[2][2][4][2], const Unit& u, int wr, int wc, int fr, int fq) const {
        const int row0 = u.pm * BM + wr * 64 + fr, ch0 = u.pn * 64 + wc * 16 + fq * 4;
#pragma unroll
        for (int ai = 0; ai < 2; ++ai)
#pragma unroll
            for (int m = 0; m < 4; ++m) { const size_t off = (size_t)(row0 + ai * HALF + m * 16) * 1024 + ch0;
                const f32x4 bg = acc[ai][0][m][0], cg = acc[ai][0][m][1], uu = acc[ai][1][m][0], zz = acc[ai][1][m][1];
                const f32x4 v = cg * uu; f32x4 g;
#pragma unroll
                for (int e = 0; e < 4; ++e) g[e] = bg[e] * zz[e] * sigmoidf_fast(zz[e]);
                u32x2 wv, wg; wv.x = cvt_pk_bf16(v[0], v[1]); wv.y = cvt_pk_bf16(v[2], v[3]); wg.x = cvt_pk_bf16(g[0], g[1]); wg.y = cvt_pk_bf16(g[2], g[3]);
                *(u32x2*)(V + off) = wv; *(u32x2*)(GZ + off) = wg; }
    }
};

struct EpiMlaIn {
    static constexpr bool PERM = true, AFTER_DRAIN = false;
    float* CKR; bf16_t* QL; float* SSQ; bf16_t* SZ; int nck;
    __device__ __forceinline__ void operator()(const f32x4 (&acc)[2][2][4][2], const Unit& u, int wr, int wc, int fr, int fq) const {
        const int row0 = u.pm * BM + wr * 64 + fr; const int t = u.pn - nck;
        if (t < 0) {
            const int col0 = u.pn * BM + wc * 32 + 8 * fq;
#pragma unroll
            for (int ai = 0; ai < 2; ++ai)
#pragma unroll
                for (int m = 0; m < 4; ++m) { float* rowp = CKR + (size_t)(row0 + ai * HALF + m * 16) * 512 + col0;
#pragma unroll
                    for (int bj = 0; bj < 2; ++bj) { *(f32x4*)(rowp + bj * HALF) = acc[ai][bj][m][0]; *(f32x4*)(rowp + bj * HALF + 4) = acc[ai][bj][m][1]; } }
        } else if (t < 2) {
            const int col0 = t * BM + wc * 32 + 8 * fq;
#pragma unroll
            for (int ai = 0; ai < 2; ++ai)
#pragma unroll
                for (int m = 0; m < 4; ++m) { const int row = row0 + ai * HALF + m * 16; bf16_t* rowp = QL + (size_t)row * 512 + col0; float s = 0.f;
#pragma unroll
                    for (int bj = 0; bj < 2; ++bj) { const f32x4 v0 = acc[ai][bj][m][0], v1 = acc[ai][bj][m][1];
                        s += (v0[0] * v0[0] + v0[1] * v0[1]) + (v0[2] * v0[2] + v0[3] * v0[3]) + (v1[0] * v1[0] + v1[1] * v1[1]) + (v1[2] * v1[2] + v1[3] * v1[3]);
                        u32x4 w; w.x = cvt_pk_bf16(v0[0], v0[1]); w.y = cvt_pk_bf16(v0[2], v0[3]); w.z = cvt_pk_bf16(v1[0], v1[1]); w.w = cvt_pk_bf16(v1[2], v1[3]);
                        *(u32x4*)(rowp + bj * HALF) = w; }
                    { const int ln = fq * 16 + fr; s += shfl_xor_f(s, 16, ln); s += shfl_xor_f(s, 32, ln); }
                    if (fq == 0) SSQ[(size_t)row * 8 + t * 4 + wc] = s; }
        } else {
            const int col0 = (t - 2) * BM + wc * 32 + 8 * fq;
#pragma unroll
            for (int ai = 0; ai < 2; ++ai)
#pragma unroll
                for (int m = 0; m < 4; ++m) { bf16_t* rowp = SZ + (size_t)(row0 + ai * HALF + m * 16) * 1024 + col0;
#pragma unroll
                    for (int bj = 0; bj < 2; ++bj) { f32x4 v0 = acc[ai][bj][m][0], v1 = acc[ai][bj][m][1];
#pragma unroll
                        for (int e = 0; e < 4; ++e) { v0[e] = v0[e] * sigmoidf_fast(v0[e]); v1[e] = v1[e] * sigmoidf_fast(v1[e]); }
                        u32x4 w; w.x = cvt_pk_bf16(v0[0], v0[1]); w.y = cvt_pk_bf16(v0[2], v0[3]); w.z = cvt_pk_bf16(v1[0], v1[1]); w.w = cvt_pk_bf16(v1[2], v1[3]);
                        *(u32x4*)(rowp + bj * HALF) = w; } }
        }
    }
};

__device__ __forceinline__ int posidx_of_row(int row) {
    return row < NMAIN ? (row & (SEQ - 1)) + NMETA : (row < META0 ? TTOT + ((row - SAMP0) & 3) : (row < META0 + NMETA ? row - META0 : 0));
}
struct EpiQUp {
    static constexpr bool PERM = true, AFTER_DRAIN = false;
    bf16_t* QN; bf16_t* QR; const float* SSQ; const float* COS; const float* SIN;
    __device__ __forceinline__ void operator()(const f32x4 (&acc)[2][2][4][2], const Unit& u, int wr, int wc, int fr, int fq) const {
        const int row0 = u.pm * BM + wr * 64 + fr;
#pragma unroll
        for (int ai = 0; ai < 2; ++ai)
#pragma unroll
            for (int m = 0; m < 4; ++m) { const int row = row0 + ai * HALF + m * 16;
                const f32x4 s0 = *(const f32x4*)(SSQ + (size_t)row * 8), s1 = *(const f32x4*)(SSQ + (size_t)row * 8 + 4);
                const float ss = ((s0[0] + s0[1]) + (s0[2] + s0[3])) + ((s1[0] + s1[1]) + (s1[2] + s1[3]));
                const float sc = QSCALE / sqrtf(ss * (1.0f / 512.0f) + RMS_EPS);
                if (u.pn < 4) { bf16_t* rowp = QN + (size_t)row * 1024 + u.pn * BM + wc * 32 + 8 * fq;
#pragma unroll
                    for (int bj = 0; bj < 2; ++bj) { const f32x4 v0 = acc[ai][bj][m][0] * sc, v1 = acc[ai][bj][m][1] * sc;
                        u32x4 w; w.x = cvt_pk_bf16(v0[0], v0[1]); w.y = cvt_pk_bf16(v0[2], v0[3]); w.z = cvt_pk_bf16(v1[0], v1[1]); w.w = cvt_pk_bf16(v1[2], v1[3]);
                        *(u32x4*)(rowp + bj * HALF) = w; }
                } else { const int pi = posidx_of_row(row);
                    const f32x4 cs = *(const f32x4*)(COS + pi * 16 + 4 * fq), sn = *(const f32x4*)(SIN + pi * 16 + 4 * fq);
#pragma unroll
                    for (int bj = 0; bj < 2; ++bj) { const f32x4 x1 = acc[ai][bj][m][0] * sc, x2 = acc[ai][bj][m][1] * sc;
                        const f32x4 o1 = x1 * cs - x2 * sn, o2 = x1 * sn + x2 * cs;
                        bf16_t* hp = QR + (size_t)row * 512 + ((u.pn - 4) * 8 + 4 * bj + wc) * 32 + 4 * fq;
                        u32x2 w1, w2; w1.x = cvt_pk_bf16(o1[0], o1[1]); w1.y = cvt_pk_bf16(o1[2], o1[3]); w2.x = cvt_pk_bf16(o2[0], o2[1]); w2.y = cvt_pk_bf16(o2[2], o2[3]);
                        *(u32x2*)hp = w1; *(u32x2*)(hp + 16) = w2; } }
            }
    }
};

template <class Epi, class Sched, bool ALIGN_EPI = false, bool SP2 = false>
__device__ __forceinline__ void gemm_phase(PG8_LAS unsigned char* lds, const Gemm g, const Sched& S, const Epi& E) {
    int tid_ = threadIdx.x; asm volatile("" : "+v"(tid_));
    const int tid = tid_, wid = __builtin_amdgcn_readfirstlane(tid >> 6), lane = tid & 63, wr = wid >> 2, wc = wid & 3, fr = lane & 15, fq = lane >> 4;
    const int K = g.K, nt = K / BK;
    unsigned voffA[2], voffB[2];
#pragma unroll
    for (int i = 0; i < 2; ++i) { int R, C; stage_rc(tid * 16 + i * 8192, R, C); const int Rb = Epi::PERM ? ((R & ~31) + perm32(R & 31)) : R;
        voffA[i] = (unsigned)(R * K + C) * 2u; voffB[i] = (unsigned)(Rb * K + C) * 2u; }
    const size_t kstep = (size_t)(BK * 2);
    const size_t hstep = (size_t)HALF * K * 2;
    const size_t tstep = 2 * hstep;
    const unsigned ldsw = (unsigned)wid * 1024u;
    const int aoff = lds_byte(wr * 64 + fr, fq * 8), boff = lds_byte(wc * 32 + fr, fq * 8);
#define PG8_SA(b, h) (((b) * 2 + (h)) * HTB)
#define PG8_SB(b, h) ((4 + (b) * 2 + (h)) * HTB)
#define PG8_STAGE(bufoff, gbase, voff) do { _Pragma("unroll") for (int _i = 0; _i < 2; ++_i) \
        __builtin_amdgcn_global_load_lds((const unsigned*)((const char*)(gbase) + (voff)[_i]), (PG8_LAS unsigned*)(lds + (bufoff) + ldsw + _i * 8192), 16, 0, 0); } while (0)
#define PG8_LDA(dst, b, h) do { _Pragma("unroll") for (int m = 0; m < 4; ++m) _Pragma("unroll") for (int k = 0; k < 2; ++k) dst[m][k] = *(const PG8_LAS bf16x8*)(lds + PG8_SA(b, h) + aoff + m * 2048 + k * 1024); } while (0)
#define PG8_LDB(dst, b, h) do { _Pragma("unroll") for (int n = 0; n < 2; ++n) _Pragma("unroll") for (int k = 0; k < 2; ++k) dst[n][k] = *(const PG8_LAS bf16x8*)(lds + PG8_SB(b, h) + boff + n * 2048 + k * 1024); } while (0)
#define PG8_MMA(ai, bj, At, Bt) do { __builtin_amdgcn_s_setprio(1); _Pragma("unroll") for (int m = 0; m < 4; ++m) _Pragma("unroll") for (int n = 0; n < 2; ++n) _Pragma("unroll") for (int k = 0; k < 2; ++k) \
        acc[ai][bj][m][n] = __builtin_amdgcn_mfma_f32_16x16x32_bf16(Bt[n][k], At[m][k], acc[ai][bj][m][n], 0, 0, 0); __builtin_amdgcn_s_setprio(0); } while (0)
#define PG8_WAIT_V(n) asm volatile("s_waitcnt vmcnt(" #n ")" ::: "memory")
#define PG8_WAIT_L(n) asm volatile("s_waitcnt lgkmcnt(" #n ")" ::: "memory")
#define PG8_BAR __builtin_amdgcn_s_barrier()
#define PG8_SCHED __builtin_amdgcn_sched_barrier(0)
    Unit cur, nxt; int ui = 0;
    if (!S.next(0, cur)) return;
    f32x4 acc[2][2][4][2];
#pragma unroll
    for (int a = 0; a < 2; ++a)
#pragma unroll
        for (int b = 0; b < 2; ++b)
#pragma unroll
            for (int m = 0; m < 4; ++m)
#pragma unroll
                for (int n = 0; n < 2; ++n) acc[a][b][m][n] = (f32x4){0.f, 0.f, 0.f, 0.f};
    bf16x8 At[4][2], B0[2][2], B1[2][2];
    const char* cA = (const char*)g.A + (size_t)cur.pm * tstep; const char* cB = (const char*)g.Bt + (size_t)cur.pn * tstep;
    S.a_ready(cur);
    if constexpr (SP2) {
        PG8_STAGE(PG8_SB(0, 0), cB, voffB); PG8_STAGE(PG8_SB(0, 1), cB + hstep, voffB); PG8_STAGE(PG8_SA(0, 0), cA, voffA); PG8_STAGE(PG8_SA(0, 1), cA + hstep, voffA);
        if (wr == 1) PG8_BAR;
        PG8_WAIT_V(2); PG8_BAR;
        PG8_STAGE(PG8_SB(1, 0), cB + kstep, voffB); PG8_STAGE(PG8_SA(1, 0), cA + kstep, voffA); PG8_STAGE(PG8_SB(1, 1), cB + hstep + kstep, voffB);
        PG8_WAIT_V(6); PG8_BAR;
    } else {
        PG8_STAGE(PG8_SB(0, 0), cB, voffB); PG8_STAGE(PG8_SA(0, 0), cA, voffA); PG8_STAGE(PG8_SB(0, 1), cB + hstep, voffB); PG8_STAGE(PG8_SA(0, 1), cA + hstep, voffA);
        if (wr == 1) PG8_BAR;
        PG8_WAIT_V(4); PG8_BAR;
        PG8_STAGE(PG8_SB(1, 0), cB + kstep, voffB); PG8_STAGE(PG8_SA(1, 0), cA + kstep, voffA); PG8_STAGE(PG8_SB(1, 1), cB + hstep + kstep, voffB);
        PG8_WAIT_V(6); PG8_BAR;
    }
    for (;;) {
        const bool has_next = S.next(ui + 1, nxt);
        const char* nA = has_next ? (const char*)g.A + (size_t)nxt.pm * tstep : cA; const char* nB = has_next ? (const char*)g.Bt + (size_t)nxt.pn * tstep : cB;
        for (int t = 0; t < nt; t += 2) {
            const bool last = (t == nt - 2);
            const char* a1 = cA + (size_t)(t + 1) * kstep;
            const char* a2 = last ? nA : cA + (size_t)(t + 2) * kstep; const char* b2 = last ? nB : cB + (size_t)(t + 2) * kstep;
            const char* a3 = a2 + kstep; const char* b3 = b2 + kstep;
            if (last && has_next) S.a_ready(nxt);
            if constexpr (SP2) {
            PG8_LDB(B0, 0, 0); PG8_LDB(B1, 0, 1); PG8_SCHED; PG8_LDA(At, 0, 0); PG8_STAGE(PG8_SA(1, 1), a1 + hstep, voffA);
            PG8_WAIT_V(8); PG8_WAIT_L(0); PG8_BAR; PG8_MMA(0, 0, At, B0); PG8_MMA(0, 1, At, B1); PG8_BAR; PG8_SCHED;
            PG8_LDA(At, 0, 1); PG8_STAGE(PG8_SB(0, 0), b2, voffB); PG8_STAGE(PG8_SB(0, 1), b2 + hstep, voffB); PG8_STAGE(PG8_SA(0, 0), a2, voffA);
            PG8_WAIT_V(8); PG8_WAIT_L(0); PG8_BAR; PG8_MMA(1, 0, At, B0); PG8_MMA(1, 1, At, B1); PG8_BAR; PG8_SCHED;
            PG8_LDB(B0, 1, 0); PG8_LDB(B1, 1, 1); PG8_SCHED; PG8_LDA(At, 1, 0); PG8_STAGE(PG8_SA(0, 1), a2 + hstep, voffA);
            PG8_WAIT_V(8); PG8_WAIT_L(0); PG8_BAR; PG8_MMA(0, 0, At, B0); PG8_MMA(0, 1, At, B1); PG8_BAR; PG8_SCHED;
            PG8_LDA(At, 1, 1); PG8_STAGE(PG8_SB(1, 0), b3, voffB); PG8_STAGE(PG8_SB(1, 1), b3 + hstep, voffB); PG8_STAGE(PG8_SA(1, 0), a3, voffA);
            PG8_WAIT_V(8); PG8_WAIT_L(0); PG8_BAR; PG8_MMA(1, 0, At, B0); PG8_MMA(1, 1, At, B1); PG8_BAR; PG8_SCHED;
            } else {
            PG8_LDB(B0, 0, 0); PG8_SCHED; PG8_LDA(At, 0, 0); PG8_STAGE(PG8_SA(1, 1), a1 + hstep, voffA);
            PG8_WAIT_L(8); PG8_BAR; PG8_WAIT_L(0); PG8_MMA(0, 0, At, B0); PG8_BAR; PG8_SCHED;
            PG8_LDB(B1, 0, 1); PG8_STAGE(PG8_SB(0, 0), b2, voffB);
            PG8_BAR; PG8_WAIT_L(0); PG8_MMA(0, 1, At, B1); PG8_BAR;
            PG8_LDA(At, 0, 1); PG8_STAGE(PG8_SA(0, 0), a2, voffA);
            PG8_BAR; PG8_WAIT_L(0); PG8_MMA(1, 0, At, B0); PG8_BAR; PG8_SCHED;
            PG8_STAGE(PG8_SB(0, 1), b2 + hstep, voffB);
            PG8_WAIT_V(6); PG8_BAR; PG8_MMA(1, 1, At, B1); PG8_BAR;
            PG8_LDB(B0, 1, 0); PG8_SCHED; PG8_LDA(At, 1, 0); PG8_STAGE(PG8_SA(0, 1), a2 + hstep, voffA);
            PG8_WAIT_L(8); PG8_BAR; PG8_WAIT_L(0); PG8_MMA(0, 0, At, B0); PG8_BAR; PG8_SCHED;
            PG8_LDB(B1, 1, 1); PG8_STAGE(PG8_SB(1, 0), b3, voffB);
            PG8_BAR; PG8_WAIT_L(0); PG8_MMA(0, 1, At, B1); PG8_BAR;
            PG8_LDA(At, 1, 1); PG8_STAGE(PG8_SA(1, 0), a3, voffA);
            PG8_BAR; PG8_WAIT_L(0); PG8_MMA(1, 0, At, B0); PG8_BAR; PG8_SCHED;
            PG8_STAGE(PG8_SB(1, 1), b3 + hstep, voffB);
            PG8_WAIT_V(6); PG8_BAR; PG8_MMA(1, 1, At, B1); PG8_BAR;
            }
        }
        if constexpr (ALIGN_EPI) { if (wr == 0) PG8_BAR; }
        if constexpr (!Epi::AFTER_DRAIN) { E(acc, cur, wr, wc, fr, fq); S.done(cur); }
        if (!has_next) break;
#pragma unroll
        for (int a = 0; a < 2; ++a)
#pragma unroll
            for (int b = 0; b < 2; ++b)
#pragma unroll
                for (int m = 0; m < 4; ++m)
#pragma unroll
                    for (int n = 0; n < 2; ++n) acc[a][b][m][n] = (f32x4){0.f, 0.f, 0.f, 0.f};
        cur = nxt; cA = nA; cB = nB; ++ui;
        if constexpr (ALIGN_EPI) { if (wr == 1) PG8_BAR; }
    }
    PG8_WAIT_V(0);
    if constexpr (!ALIGN_EPI) { if (wr == 0) PG8_BAR; }
    PG8_BAR;
    if constexpr (Epi::AFTER_DRAIN) { E.fused(acc, cur, wr, wc, fr, fq, lds, wid, lane); S.done(cur); }
#undef PG8_SA
#undef PG8_SB
#undef PG8_STAGE
#undef PG8_LDA
#undef PG8_LDB
#undef PG8_MMA
#undef PG8_WAIT_V
#undef PG8_WAIT_L
#undef PG8_BAR
#undef PG8_SCHED
}
}
#define GAS __attribute__((address_space(1)))
#define LAS __attribute__((address_space(3)))
typedef unsigned short bf16;
typedef unsigned v4u __attribute__((ext_vector_type(4)));
typedef float f32x4 __attribute__((ext_vector_type(4)));
typedef short bf16x8 __attribute__((ext_vector_type(8)));
typedef GAS unsigned gu32;
typedef GAS unsigned long long gu64;
#define RLX_AGENT __ATOMIC_RELAXED, __HIP_MEMORY_SCOPE_AGENT
#define LDS_WAIT() asm volatile("s_waitcnt lgkmcnt(0)" ::: "memory")
#define VM_WAIT() asm volatile("s_waitcnt vmcnt(0)" ::: "memory")
__device__ __forceinline__ unsigned long long rt() { return __builtin_amdgcn_s_memrealtime(); }
__device__ __forceinline__ unsigned f2bf(float f) { unsigned u = __builtin_bit_cast(unsigned, f); return (u + 0x7fffu + ((u >> 16) & 1u)) >> 16; }
__device__ __forceinline__ unsigned pk2(float lo, float hi) { return f2bf(lo) | (f2bf(hi) << 16); }

#define XB_TMO      128
#define XB_XCNT(j)  (256  + 64 * (j))
#define XB_XSUB(j)  (1280 + 64 * (j))
#define XB_XGEN(j)  (2304 + 64 * (j))
#define XB_TOP      3328
#define XB_TOPGEN   3392
#define XCD_BAR_WORDS 3456
#define XB_SPIN_CAP (1u << 18)

__device__ __forceinline__ unsigned xb_ld(unsigned* p)              { return __hip_atomic_load(p, __ATOMIC_RELAXED, __HIP_MEMORY_SCOPE_AGENT); }
__device__ __forceinline__ unsigned xb_add(unsigned* p, unsigned v) { return __hip_atomic_fetch_add(p, v, __ATOMIC_RELAXED, __HIP_MEMORY_SCOPE_AGENT); }
__device__ __forceinline__ unsigned xb_xcc_id() { return (unsigned)__builtin_amdgcn_s_getreg((3 << 11) | 20) & 0xFu; }
#define XB_SPIN(cond, bar) do { unsigned _sp = 0; while (cond) { __builtin_amdgcn_s_sleep(1); \
    if ((++_sp & 255u) == 0u) { if (xb_ld(&(bar)[XB_TMO])) break; if (_sp > XB_SPIN_CAP) { atomicAdd(&(bar)[XB_TMO], 1u); break; } } } } while (0)

struct XcdBarrier {
    unsigned* bar; unsigned x;
    volatile LAS unsigned* st;
};

__device__ __forceinline__ XcdBarrier xcd_barrier_post(unsigned* bar, volatile LAS unsigned* st) {
    XcdBarrier b; b.bar = bar; b.x = xb_xcc_id(); b.st = st;
    if (threadIdx.x == 0) (void)xb_add(&bar[XB_XCNT(b.x)], 1u);
    return b;
}
__device__ __forceinline__ void xcd_barrier_complete(unsigned* bar, unsigned x, unsigned& nloc, unsigned& nx) {
    const unsigned G = gridDim.x * gridDim.y * gridDim.z;
    unsigned sum, cnt, mine, sp = 0u;
    for (;;) {
        sum = 0u; cnt = 0u; mine = 0u;
#pragma unroll
        for (unsigned j = 0; j < 16; ++j) { const unsigned c = xb_ld(&bar[XB_XCNT(j)]); sum += c; cnt += (c > 0u) ? 1u : 0u; mine = (j == x) ? c : mine; }
        if (sum == G) break;
        __builtin_amdgcn_s_sleep(1);
        if ((++sp & 255u) == 0u) { if (xb_ld(&bar[XB_TMO])) break; if (sp > XB_SPIN_CAP) { atomicAdd(&bar[XB_TMO], 1u); break; } }
    }
    nloc = mine > 0u ? mine : 1u; nx = cnt > 0u ? cnt : 1u;
}

__device__ __forceinline__ void xcd_barrier(const XcdBarrier& b) {
    asm volatile("s_waitcnt vmcnt(0)" ::: "memory");
    __syncthreads();
    if (threadIdx.x == 0) {
        unsigned* bar = b.bar;
        __builtin_amdgcn_s_waitcnt(0);
        unsigned nloc = b.st[0], nx = b.st[1];
        if (nloc == 0u) { xcd_barrier_complete(bar, b.x, nloc, nx); b.st[0] = nloc; b.st[1] = nx; }
        const unsigned old = xb_add(&bar[XB_XSUB(b.x)], 1u);
        const unsigned gen = old / nloc;
        if (old + 1u == (gen + 1u) * nloc) {
            __builtin_amdgcn_fence(__ATOMIC_RELEASE, "agent");
            asm volatile("s_waitcnt vmcnt(0)" ::: "memory");
            const unsigned og = xb_add(&bar[XB_TOP], 1u);
            const unsigned tg = og / nx;
            if (og + 1u == (tg + 1u) * nx) xb_add(&bar[XB_TOPGEN], 1u);
            else XB_SPIN(xb_ld(&bar[XB_TOPGEN]) == tg, bar);
            __builtin_amdgcn_fence(__ATOMIC_ACQUIRE, "agent");
            xb_add(&bar[XB_XGEN(b.x)], 1u);
            asm volatile("s_waitcnt vmcnt(0)" ::: "memory");
        } else {
            XB_SPIN(xb_ld(&bar[XB_XGEN(b.x)]) == gen, bar);
            __builtin_amdgcn_fence(__ATOMIC_ACQUIRE, "agent");
            asm volatile("s_waitcnt vmcnt(0)" ::: "memory");
        }
    }
    __syncthreads();
}

constexpr size_t MiB = 1u << 20;
constexpr size_t WS_CTL = 0, CTL_ZERO_BYTES = 64 * 1024;
constexpr int CW_BAR = 1024;
constexpr size_t WS_COS = 1 * MiB;
constexpr size_t WS_SIN = WS_COS + 512 * 1024;
constexpr size_t WS_WIN  = 2 * MiB;
constexpr size_t WS_WOC  = WS_WIN + 16 * MiB;
constexpr size_t WS_WA0  = WS_WOC + 4 * MiB;
constexpr size_t WS_WA1  = WS_WA0 + 4 * MiB;
constexpr size_t WS_WUKV = WS_WA1 + 3 * MiB;
constexpr size_t WS_WUQ  = WS_WUKV + 1 * MiB;
constexpr size_t WS_WOM  = WS_WUQ + 3 * MiB;
constexpr size_t WS_ACT  = 40 * MiB;
constexpr size_t SZ_F32R = (size_t)NROWS * 1024 * 4, SZ_BFR = (size_t)NROWS * 1024 * 2;
constexpr size_t WS_X    = WS_ACT;
constexpr size_t WS_XH   = WS_X + SZ_F32R;
constexpr size_t WS_V1   = WS_XH + SZ_BFR;
constexpr size_t WS_GZ   = WS_V1 + SZ_BFR;
constexpr size_t WS_G    = WS_GZ + SZ_BFR;
constexpr size_t WS_MB   = WS_G + SZ_BFR;
constexpr size_t WS_CKR  = WS_MB + SZ_BFR;
constexpr size_t WS_CB   = WS_CKR + (size_t)NROWS * 512 * 4;
constexpr size_t WS_KRB  = WS_CB + (size_t)NROWS * 256 * 2;
constexpr size_t WS_KN   = WS_KRB + (size_t)NROWS * 32 * 2;
constexpr size_t WS_VV   = WS_KN + SZ_BFR;
constexpr size_t WS_QL   = WS_VV + SZ_BFR;
constexpr size_t WS_SSQ  = WS_QL + (size_t)NROWS * 512 * 2;
constexpr size_t WS_SZ   = WS_SSQ + (size_t)NROWS * 8 * 4;
constexpr size_t WS_QN   = WS_SZ + SZ_BFR;
constexpr size_t WS_QR   = WS_QN + SZ_BFR;
constexpr size_t WS_OG   = WS_QR + (size_t)NROWS * 512 * 2;
constexpr size_t WS_PART = WS_OG + SZ_BFR;
constexpr size_t WS_PML  = WS_PART + (size_t)DECB * 4 * 64 * 256 * 4;
constexpr size_t WS_QABS = WS_PML + (size_t)DECB * 4 * 2 * 64 * 4;
constexpr size_t WS_END  = WS_QABS + (size_t)DECB * 64 * 288 * 2;
static_assert(WS_WOM + 4 * MiB <= WS_ACT && WS_END < 1024 * MiB, "d_ws map");

constexpr size_t O_YP = 0, O_YS = O_YP + (size_t)NB * SEQ * DM, O_CKP = O_YS + (size_t)NSAMP * DM, O_KRP = O_CKP + (size_t)NB * TTOT * KVL,
                 O_CVP = O_KRP + (size_t)NB * TTOT * QKR, O_CKS = O_CVP + (size_t)2 * NB * 2 * DM, O_KRS = O_CKS + (size_t)NSAMP * KVL,
                 O_CVS = O_KRS + (size_t)NSAMP * QKR, O_END = O_CVS + (size_t)2 * DECB * 2 * DM;

constexpr int RING_BYTES = 131072;
constexpr int LDSCTL_OFF = RING_BYTES;
constexpr int LDS_BYTES = 147456;
constexpr int NWAVES = 8;

struct Args {
    const float* x_prompt; const float* x_sample; const float* cache_ckv; const float* cache_krope; const float* state_conv; const int* page_table;
    const float* meta; const float* pre_g; const float* post_g; const float* w_in_conv; const float* conv_w; const float* w_out_conv;
    const float* kv_norm_g; const float* w_dkv; const float* kv_lat_g; const float* w_uk; const float* w_uv; const float* w_in_mla;
    const float* q_norm_g; const float* w_uq; const float* w_out_mla;
    float* out; unsigned char* ws;
};

typedef unsigned short bf16;
typedef short bf16x8 __attribute__((ext_vector_type(8)));
typedef float f32x4 __attribute__((ext_vector_type(4)));
typedef float f32x8 __attribute__((ext_vector_type(8)));
typedef float f32x16 __attribute__((ext_vector_type(16)));
typedef unsigned u32x4 __attribute__((ext_vector_type(4)));
typedef unsigned u32x2 __attribute__((ext_vector_type(2)));
typedef short s16x4 __attribute__((ext_vector_type(4)));
#define LDS_WAIT() asm volatile("s_waitcnt lgkmcnt(0)" ::: "memory")
#define VM_WAIT() asm volatile("s_waitcnt vmcnt(0)" ::: "memory")
#define SBAR() __builtin_amdgcn_sched_barrier(0)
__device__ __forceinline__ unsigned cvtpk(float lo, float hi) { unsigned r; asm volatile("v_cvt_pk_bf16_f32 %0, %1, %2" : "=v"(r) : "v"(lo), "v"(hi)); return r; }
__device__ __forceinline__ float bf2f(unsigned short b) { return __uint_as_float((unsigned)b << 16); }
__device__ __forceinline__ float bflo(unsigned w) { return __uint_as_float(w << 16); }
__device__ __forceinline__ float bfhi(unsigned w) { return __uint_as_float(w & 0xffff0000u); }
__device__ __forceinline__ float wave_sum(float v, int lane) {
#pragma unroll
    for (int o = 1; o < 64; o <<= 1) v += shfl_xor_f(v, o, lane);
    return v;
}

template <class DestRow>
__device__ __forceinline__ void transpose_item(const float* __restrict__ W, int K, int N, const float* __restrict__ gain, bf16* WT, const DestRow& dest, LAS float* scr, int item, int lane) {
    const int nblk = N / 32, kb = item / nblk, nb = item % nblk, k0 = 64 * kb, n0 = 32 * nb;
#pragma unroll 8
    for (int i = 0; i < 32; ++i) { const int kk = 2 * i + (lane >> 5); float w = W[(size_t)(k0 + kk) * N + n0 + (lane & 31)]; if (gain) w *= gain[k0 + kk]; scr[kk * 33 + (lane & 31)] = w; }
    LDS_WAIT(); asm volatile("" ::: "memory");
    const int c = lane & 7;
#pragma unroll
    for (int j = 0; j < 4; ++j) { const int n = (lane >> 3) + 8 * j; const LAS float* s = scr + (8 * c) * 33 + n;
        u32x4 o; o.x = cvtpk(s[0 * 33], s[1 * 33]); o.y = cvtpk(s[2 * 33], s[3 * 33]); o.z = cvtpk(s[4 * 33], s[5 * 33]); o.w = cvtpk(s[6 * 33], s[7 * 33]);
        *(u32x4*)(WT + (size_t)dest(n0 + n) * K + k0 + 8 * c) = o; }
    LDS_WAIT(); asm volatile("" ::: "memory");
}
struct DestIdent { int off; __device__ __forceinline__ int operator()(int n) const { return off + n; } };
struct DestConvIn {
    __device__ __forceinline__ int operator()(int n) const { const int p = n >> 10, ch = n & 1023, cl = ch & 63; return (ch >> 6) * 256 + (p >> 1) * 128 + (cl >> 4) * 32 + ((cl >> 2) & 3) * 8 + (p & 1) * 4 + (cl & 3); } };
struct DestUq {
    __device__ __forceinline__ int operator()(int n) const { const int h = n / 96, t = n - h * 96; if (t < 64) return h * 64 + t; const int el = t - 64, i = el & 15;
        return 1024 + (h >> 3) * 256 + ((h & 7) >> 2) * 128 + (h & 3) * 32 + (i >> 2) * 8 + (el >> 4) * 4 + (i & 3); } };

__device__ __forceinline__ void xhat_row_store(const f32x4 (&v)[4], bf16* orow, int lane) {
    float s = 0.f;
#pragma unroll
    for (int j = 0; j < 4; ++j) s += (v[j].x * v[j].x + v[j].y * v[j].y) + (v[j].z * v[j].z + v[j].w * v[j].w);
    const float r = 1.0f / sqrtf(wave_sum(s, lane) * (1.0f / 1024.0f) + RMS_EPS);
    u32x2* o8 = (u32x2*)orow + lane;
#pragma unroll
    for (int j = 0; j < 4; ++j) { u32x2 w; w.x = cvtpk(v[j].x * r, v[j].y * r); w.y = cvtpk(v[j].z * r, v[j].w * r); o8[64 * j] = w; }
}

__device__ __forceinline__ void p0_prologue(const Args& A, LAS unsigned char* lds, int gw, int NGW, int wave, int lane) {
    unsigned char* ws = A.ws;
    LAS float* scr = (LAS float*)(lds + wave * 8704);
    constexpr int I_WIN = (1024 / 64) * (4096 / 32), I_SQ = (1024 / 64) * (1024 / 32), I_DKV = (1024 / 64) * (288 / 32), I_INM = (1024 / 64) * (1536 / 32),
                  I_UKV = (256 / 64) * (1024 / 32), I_UQ = (512 / 64) * (1536 / 32);
    constexpr int NITEMS = 2 * I_WIN + 2 * I_SQ + I_DKV + 2 * I_INM + 2 * I_UKV + 2 * I_UQ + 2 * I_SQ;
    for (int it = gw; it < NITEMS; it += NGW) {
        int r = it;
        if (r < 2 * I_WIN) { const int l = r / I_WIN; transpose_item(A.w_in_conv + (size_t)l * 1024 * 4096, 1024, 4096, A.pre_g + l * 1024, (bf16*)(ws + WS_WIN) + (size_t)l * 4096 * 1024, DestConvIn{}, scr, r % I_WIN, lane); continue; } r -= 2 * I_WIN;
        if (r < 2 * I_SQ) { const int l = r / I_SQ; transpose_item(A.w_out_conv + (size_t)l * 1024 * 1024, 1024, 1024, nullptr, (bf16*)(ws + WS_WOC) + (size_t)l * 1024 * 1024, DestIdent{0}, scr, r % I_SQ, lane); continue; } r -= 2 * I_SQ;
        if (r < I_DKV) { transpose_item(A.w_dkv, 1024, 288, A.kv_norm_g, (bf16*)(ws + WS_WA0), DestIdent{0}, scr, r, lane); continue; } r -= I_DKV;
        if (r < 2 * I_INM) { const int j = r / I_INM; transpose_item(A.w_in_mla + (size_t)j * 1024 * 1536, 1024, 1536, A.pre_g + (2 + j) * 1024, (bf16*)(ws + (j ? WS_WA1 : WS_WA0)), DestIdent{j ? 0 : 512}, scr, r % I_INM, lane); continue; } r -= 2 * I_INM;
        if (r < 2 * I_UKV) { const int j = r / I_UKV; transpose_item(j ? A.w_uv : A.w_uk, 256, 1024, nullptr, (bf16*)(ws + WS_WUKV), DestIdent{j * 1024}, scr, r % I_UKV, lane); continue; } r -= 2 * I_UKV;
        if (r < 2 * I_UQ) { const int j = r / I_UQ; transpose_item(A.w_uq + (size_t)j * 512 * 1536, 512, 1536, A.q_norm_g + j * 512, (bf16*)(ws + WS_WUQ) + (size_t)j * 1536 * 512, DestUq{}, scr, r % I_UQ, lane); continue; } r -= 2 * I_UQ;
        { const int j = r / I_SQ; transpose_item(A.w_out_mla + (size_t)j * 1024 * 1024, 1024, 1024, nullptr, (bf16*)(ws + WS_WOM) + (size_t)j * 1024 * 1024, DestIdent{0}, scr, r % I_SQ, lane); }
    }
    for (int i = gw * 64 + lane; i < 224 * 128; i += NGW * 64) ((u32x4*)((bf16*)(ws + WS_WA0) + 288 * 1024))[i] = (u32x4){0u, 0u, 0u, 0u};
    for (int i = gw * 64 + lane; i < NPOS * 16; i += NGW * 64) { const int p = i >> 4, e = i & 15; const float pos = (float)(p < TTOT ? p : PAST + (p - TTOT));
        const float inv = powf(10000.0f, -(float)e / 16.0f); const float ang = pos * inv; ((float*)(ws + WS_COS))[i] = cosf(ang); ((float*)(ws + WS_SIN))[i] = sinf(ang); }
    for (int row = gw; row < NROWS; row += NGW) {
        const float* src = row < NMAIN ? A.x_prompt + (size_t)row * 1024 : (row < META0 ? A.x_sample + (size_t)(row - SAMP0) * 1024 : (row < META0 + NMETA ? A.meta + (size_t)(row - META0) * 1024 : nullptr));
        f32x4 v[4];
#pragma unroll
        for (int j = 0; j < 4; ++j) v[j] = src ? ((const f32x4*)src)[lane + 64 * j] : (f32x4){0.f, 0.f, 0.f, 0.f};
        f32x4* xo = (f32x4*)((float*)(ws + WS_X) + (size_t)row * 1024) + lane;
#pragma unroll
        for (int j = 0; j < 4; ++j) xo[64 * j] = v[j];
        xhat_row_store(v, (bf16*)(ws + WS_XH) + (size_t)row * 1024, lane);
    }
}

__device__ __forceinline__ void conv_phase(const Args& A, int layer, int gw, int NGW, int lane) {
    unsigned char* ws = A.ws; const bf16* V = (const bf16*)(ws + WS_V1); const bf16* GZ = (const bf16*)(ws + WS_GZ); bf16* G = (bf16*)(ws + WS_G);
    const float* cw = A.conv_w + (size_t)layer * 3 * 1024;
    for (int row = gw; row < NROWS; row += NGW) {
        int r1, r2; const float* s1 = nullptr; const float* s2 = nullptr;
        if (row < NMAIN) { const int i = row & (SEQ - 1); r1 = i >= 1 ? row - 1 : META0 + 15; r2 = i >= 2 ? row - 2 : META0 + 14 + i; }
        else if (row < META0) { const int s = row - SAMP0, b = s >> 2, l = s & 3; const float* st = A.state_conv + ((size_t)layer * DECB + b) * 2 * 1024;
            if (l >= 1) r1 = row - 1; else { r1 = -2; s1 = st + 1024; }
            if (l >= 2) r2 = row - 2; else { r2 = -2; s2 = st + l * 1024; } }
        else if (row < META0 + NMETA) { const int j = row - META0; r1 = j >= 1 ? row - 1 : -1; r2 = j >= 2 ? row - 2 : -1; }
        else { r1 = -1; r2 = -1; }
#pragma unroll
        for (int half = 0; half < 2; ++half) { const int c0 = half * 512 + lane * 8;
            const u32x4 v0 = *(const u32x4*)(V + (size_t)row * 1024 + c0), gz = *(const u32x4*)(GZ + (size_t)row * 1024 + c0);
            float a1[8], a2[8];
            if (r1 >= 0) { const u32x4 t = *(const u32x4*)(V + (size_t)r1 * 1024 + c0);
#pragma unroll
                for (int k = 0; k < 4; ++k) { a1[2 * k] = bflo(t[k]); a1[2 * k + 1] = bfhi(t[k]); } }
            else if (r1 == -2) { const f32x4 t0 = *(const f32x4*)(s1 + c0), t1 = *(const f32x4*)(s1 + c0 + 4);
#pragma unroll
                for (int k = 0; k < 4; ++k) { a1[k] = t0[k]; a1[4 + k] = t1[k]; } }
            else {
#pragma unroll
                for (int k = 0; k < 8; ++k) a1[k] = 0.f; }
            if (r2 >= 0) { const u32x4 t = *(const u32x4*)(V + (size_t)r2 * 1024 + c0);
#pragma unroll
                for (int k = 0; k < 4; ++k) { a2[2 * k] = bflo(t[k]); a2[2 * k + 1] = bfhi(t[k]); } }
            else if (r2 == -2) { const f32x4 t0 = *(const f32x4*)(s2 + c0), t1 = *(const f32x4*)(s2 + c0 + 4);
#pragma unroll
                for (int k = 0; k < 4; ++k) { a2[k] = t0[k]; a2[4 + k] = t1[k]; } }
            else {
#pragma unroll
                for (int k = 0; k < 8; ++k) a2[k] = 0.f; }
            float w0[8], w1[8], w2[8], vc[8], gg[8];
#pragma unroll
            for (int k = 0; k < 2; ++k) { const f32x4 t0 = *(const f32x4*)(cw + c0 + 4 * k), t1 = *(const f32x4*)(cw + 1024 + c0 + 4 * k), t2 = *(const f32x4*)(cw + 2048 + c0 + 4 * k);
#pragma unroll
                for (int e = 0; e < 4; ++e) { w0[4 * k + e] = t0[e]; w1[4 * k + e] = t1[e]; w2[4 * k + e] = t2[e]; } }
#pragma unroll
            for (int k = 0; k < 4; ++k) { vc[2 * k] = bflo(v0[k]); vc[2 * k + 1] = bfhi(v0[k]); gg[2 * k] = bflo(gz[k]); gg[2 * k + 1] = bfhi(gz[k]); }
            float o[8];
#pragma unroll
            for (int k = 0; k < 8; ++k) o[k] = gg[k] * (w0[k] * a2[k] + w1[k] * a1[k] + w2[k] * vc[k]);
            u32x4 w; w.x = cvtpk(o[0], o[1]); w.y = cvtpk(o[2], o[3]); w.z = cvtpk(o[4], o[5]); w.w = cvtpk(o[6], o[7]);
            *(u32x4*)(G + (size_t)row * 1024 + c0) = w;
            float* dst = nullptr;
            if (row < NMAIN) { const int i = row & (SEQ - 1), b = row >> 12; if (i >= SEQ - 2) dst = A.out + O_CVP + (((size_t)layer * NB + b) * 2 + (i - (SEQ - 2))) * 1024; }
            else if (row < META0) { const int s = row - SAMP0, b = s >> 2, l = s & 3; if (l >= 2) dst = A.out + O_CVS + (((size_t)layer * DECB + b) * 2 + (l - 2)) * 1024; }
            if (dst) { *(f32x4*)(dst + c0) = (f32x4){vc[0], vc[1], vc[2], vc[3]}; *(f32x4*)(dst + c0 + 4) = (f32x4){vc[4], vc[5], vc[6], vc[7]}; }
        }
    }
}

__device__ __forceinline__ void norm_phase(const Args& A, int layer, int gw, int NGW, int lane) {
    unsigned char* ws = A.ws; const bf16* MB = (const bf16*)(ws + WS_MB); float* X = (float*)(ws + WS_X); const float* pg = A.post_g + (size_t)layer * 1024;
    f32x4 g[4];
#pragma unroll
    for (int j = 0; j < 4; ++j) g[j] = ((const f32x4*)pg)[lane + 64 * j];
    for (int row = gw; row < NROWS; row += NGW) {
        f32x4 m[4], x[4]; float s = 0.f;
#pragma unroll
        for (int j = 0; j < 4; ++j) { const u32x2 w = ((const u32x2*)(MB + (size_t)row * 1024))[lane + 64 * j]; m[j] = (f32x4){bflo(w.x), bfhi(w.x), bflo(w.y), bfhi(w.y)};
            x[j] = ((const f32x4*)(X + (size_t)row * 1024))[lane + 64 * j]; s += (m[j].x * m[j].x + m[j].y * m[j].y) + (m[j].z * m[j].z + m[j].w * m[j].w); }
        const float r = 1.0f / sqrtf(wave_sum(s, lane) * (1.0f / 1024.0f) + RMS_EPS);
#pragma unroll
        for (int j = 0; j < 4; ++j) x[j] = x[j] + m[j] * r * g[j];
        if (layer == 3) { if (row < META0) {
#pragma unroll
                for (int j = 0; j < 4; ++j) ((f32x4*)(A.out + (size_t)row * 1024))[lane + 64 * j] = x[j]; } }
        else {
#pragma unroll
            for (int j = 0; j < 4; ++j) ((f32x4*)(X + (size_t)row * 1024))[lane + 64 * j] = x[j];
            xhat_row_store(x, (bf16*)(ws + WS_XH) + (size_t)row * 1024, lane);
        }
    }
}

__device__ __forceinline__ void latent_phase(const Args& A, int gw, int NGW, int lane) {
    unsigned char* ws = A.ws; const float* CKR = (const float*)(ws + WS_CKR); bf16* CB = (bf16*)(ws + WS_CB); bf16* KRB = (bf16*)(ws + WS_KRB);
    const float* COS = (const float*)(ws + WS_COS); const float* SIN = (const float*)(ws + WS_SIN);
    const f32x4 g = ((const f32x4*)A.kv_lat_g)[lane];
    for (int row = gw; row < NROWS; row += NGW) {
        const f32x4 c = ((const f32x4*)(CKR + (size_t)row * 512))[lane];
        const float r = 1.0f / sqrtf(wave_sum((c.x * c.x + c.y * c.y) + (c.z * c.z + c.w * c.w), lane) * (1.0f / 256.0f) + RMS_EPS);
        const f32x4 cn = c * r * g;
        u32x2 w; w.x = cvtpk(cn.x, cn.y); w.y = cvtpk(cn.z, cn.w); ((u32x2*)(CB + (size_t)row * 256))[lane] = w;
        const int pi = pg8::posidx_of_row(row);
        float o1 = 0.f, o2 = 0.f;
        if (lane < 16) { const float x1 = CKR[(size_t)row * 512 + 256 + lane], x2 = CKR[(size_t)row * 512 + 272 + lane], cs = COS[pi * 16 + lane], sn = SIN[pi * 16 + lane];
            o1 = x1 * cs - x2 * sn; o2 = x1 * sn + x2 * cs;
            KRB[(size_t)row * 32 + lane] = (bf16)(cvtpk(o1, o1) & 0xffffu); KRB[(size_t)row * 32 + 16 + lane] = (bf16)(cvtpk(o2, o2) & 0xffffu); }
        if (row < NMAIN) { const int b = row >> 12, i = row & (SEQ - 1); const size_t t = (size_t)b * TTOT + NMETA + i;
            ((f32x4*)(A.out + O_CKP + t * KVL))[lane] = cn; if (lane < 16) { A.out[O_KRP + t * QKR + lane] = o1; A.out[O_KRP + t * QKR + 16 + lane] = o2; } }
        else if (row < META0) { const size_t t = row - SAMP0; ((f32x4*)(A.out + O_CKS + t * KVL))[lane] = cn; if (lane < 16) { A.out[O_KRS + t * QKR + lane] = o1; A.out[O_KRS + t * QKR + 16 + lane] = o2; } }
        else if (row < META0 + NMETA) { const int j = row - META0;
#pragma unroll
            for (int b = 0; b < NB; ++b) { const size_t t = (size_t)b * TTOT + j; ((f32x4*)(A.out + O_CKP + t * KVL))[lane] = cn; if (lane < 16) { A.out[O_KRP + t * QKR + lane] = o1; A.out[O_KRP + t * QKR + 16 + lane] = o2; } } }
    }
}

namespace ap {
constexpr int NW = 8, QBLK = 32, KVBLK = 64;
constexpr int SHM_K = 64 * 256, SHM_V = 64 * 64 * 2;
constexpr int OFF_V = 0, OFF_K = 2 * SHM_V, OFF_WS = OFF_K + 2 * SHM_K, LDS_BYTES_AP = OFF_WS + NW * 64 * 4;
constexpr float THR = 8.0f;
#define KSWZ(row, colB) ((row) * 256 + ((colB) ^ (((row) & 7) << 4)))
__device__ __forceinline__ int crow(int r, int hi) { return (r & 3) + 8 * (r >> 2) + 4 * hi; }
__device__ __forceinline__ void partialSM(f32x16& p0, f32x16& p1, float& m_reg, float& mn, float& alpha) {
    float pmax = p0[0];
#pragma unroll
    for (int r = 1; r < 16; ++r) pmax = fmaxf(pmax, p0[r]);
#pragma unroll
    for (int r = 0; r < 16; ++r) pmax = fmaxf(pmax, p1[r]);
    { auto rr = __builtin_amdgcn_permlane32_swap(__float_as_uint(pmax), __float_as_uint(pmax), false, false); pmax = fmaxf(__uint_as_float(rr[0]), __uint_as_float(rr[1])); }
    if (__builtin_expect(__all(pmax - m_reg <= THR), 1)) { mn = m_reg; alpha = 1.f; }
    else { mn = fmaxf(m_reg, pmax); alpha = __builtin_amdgcn_exp2f(m_reg - mn); m_reg = mn; }
#pragma unroll
    for (int r = 0; r < 16; ++r) p0[r] = p0[r] - mn;
#pragma unroll
    for (int r = 0; r < 16; ++r) p1[r] = p1[r] - mn;
#pragma unroll
    for (int r = 0; r < 16; ++r) p0[r] = __builtin_amdgcn_exp2f(p0[r]);
}
__device__ __forceinline__ void finishSM(f32x16& p0, f32x16& p1, float alpha, float& l_reg, bf16x8& pa0, bf16x8& pa1, bf16x8& pa2, bf16x8& pa3) {
#pragma unroll
    for (int r = 0; r < 16; ++r) p1[r] = __builtin_amdgcn_exp2f(p1[r]);
    float ps = 0;
#pragma unroll
    for (int r = 0; r < 16; ++r) ps += p0[r];
#pragma unroll
    for (int r = 0; r < 16; ++r) ps += p1[r];
    { auto rr = __builtin_amdgcn_permlane32_swap(__float_as_uint(ps), __float_as_uint(ps), false, false); ps = __uint_as_float(rr[0]) + __uint_as_float(rr[1]); }
    l_reg = l_reg * alpha + ps;
#define PK4(P, BASE, OUT) do { unsigned a0 = cvtpk(P[BASE + 0], P[BASE + 1]), a1 = cvtpk(P[BASE + 2], P[BASE + 3]);   \
    unsigned b0 = cvtpk(P[BASE + 4], P[BASE + 5]), b1 = cvtpk(P[BASE + 6], P[BASE + 7]);                              \
    auto r0 = __builtin_amdgcn_permlane32_swap(a0, b0, false, false); auto r1 = __builtin_amdgcn_permlane32_swap(a1, b1, false, false); \
    u32x4 w = {r0[0], r1[0], r0[1], r1[1]}; OUT = *reinterpret_cast<bf16x8*>(&w); } while (0)
    PK4(p0, 0, pa0); PK4(p0, 8, pa1); PK4(p1, 0, pa2); PK4(p1, 8, pa3);
}
__device__ __forceinline__ void qkt(f32x16& p0, f32x16& p1, const char* Ks, const bf16x8* qr, int r32, int hi) {
    p0 = f32x16{}; p1 = f32x16{};
#pragma unroll
    for (int d0 = 0; d0 < 6; ++d0) { const int cb = (d0 * 16 + hi * 8) * 2;
        const bf16x8 b0 = *reinterpret_cast<const bf16x8*>(Ks + KSWZ(r32, cb));
        const bf16x8 b1 = *reinterpret_cast<const bf16x8*>(Ks + KSWZ(32 + r32, cb));
        p0 = __builtin_amdgcn_mfma_f32_32x32x16_bf16(b0, qr[d0], p0, 0, 0, 0);
        p1 = __builtin_amdgcn_mfma_f32_32x32x16_bf16(b1, qr[d0], p1, 0, 0, 0); }
}
__device__ __forceinline__ void mask_tile(f32x16& p0, f32x16& p1, int lim, int hi) {
#pragma unroll
    for (int r = 0; r < 16; ++r) { const int kv = crow(r, hi); if (kv > lim) p0[r] = -INFINITY; if (kv + 32 > lim) p1[r] = -INFINITY; }
}
__device__ __forceinline__ int v_st(int k, int c) { const int kk = (k & ~0xC) | ((k & 4) << 1) | ((k & 8) >> 1); return ((kk >> 3) * 2 + (c >> 5)) * 512 + ((kk & 7) * 32 + (c & 31)) * 2; }
__device__ __forceinline__ int v_rd_base(int lane) { return ((lane & 3) << 3) | (((lane >> 2) & 3) << 6) | (((lane >> 4) & 1) << 5) | (((lane >> 5) & 1) << 8); }
constexpr int v_rd_off(int d0, int ks, int half) { return d0 * 512 + ks * 2048 + half * 1024; }
template <int OFF> __device__ __forceinline__ s16x4 tr_read(int vb) { s16x4 r; asm volatile("ds_read_b64_tr_b16 %0, %1 offset:%2" : "=&v"(r) : "v"(vb), "i"(OFF) : "memory"); return r; }
template <int D0> __device__ __forceinline__ void pv_one(f32x16& od, int vb, bf16x8 pa0, bf16x8 pa1, bf16x8 pa2, bf16x8 pa3) {
    const s16x4 l0 = tr_read<v_rd_off(D0, 0, 0)>(vb), h0 = tr_read<v_rd_off(D0, 0, 1)>(vb), l1 = tr_read<v_rd_off(D0, 1, 0)>(vb), h1 = tr_read<v_rd_off(D0, 1, 1)>(vb);
    const s16x4 l2 = tr_read<v_rd_off(D0, 2, 0)>(vb), h2 = tr_read<v_rd_off(D0, 2, 1)>(vb), l3 = tr_read<v_rd_off(D0, 3, 0)>(vb), h3 = tr_read<v_rd_off(D0, 3, 1)>(vb);
    asm volatile("s_waitcnt lgkmcnt(0)" ::: "memory"); SBAR();
#define PKV(L, H) (bf16x8){L[0], L[1], L[2], L[3], H[0], H[1], H[2], H[3]}
    od = __builtin_amdgcn_mfma_f32_32x32x16_bf16(pa0, PKV(l0, h0), od, 0, 0, 0);
    od = __builtin_amdgcn_mfma_f32_32x32x16_bf16(pa1, PKV(l1, h1), od, 0, 0, 0);
    od = __builtin_amdgcn_mfma_f32_32x32x16_bf16(pa2, PKV(l2, h2), od, 0, 0, 0);
    od = __builtin_amdgcn_mfma_f32_32x32x16_bf16(pa3, PKV(l3, h3), od, 0, 0, 0);
}
__device__ __forceinline__ void pv_all(f32x16* o, int vb, bf16x8 pa0, bf16x8 pa1, bf16x8 pa2, bf16x8 pa3) { pv_one<0>(o[0], vb, pa0, pa1, pa2, pa3); pv_one<1>(o[1], vb, pa0, pa1, pa2, pa3); }

__device__ __forceinline__ void attn_unit(const bf16* __restrict__ QN, const bf16* __restrict__ QR, const bf16* __restrict__ KN, const bf16* __restrict__ KRB, const bf16* __restrict__ VV,
                                          const bf16* __restrict__ SZ, bf16* __restrict__ OG, int b, int h, int qb, bool meta, char* lds) {
    int tid_ = threadIdx.x; asm volatile("" : "+v"(tid_));
    const int tid = tid_, wid = tid >> 6, lane = tid & 63, r32 = lane & 31, hi = lane >> 5;
    char* V_lds = lds + OFF_V; char* K_lds = lds + OFF_K;
    float* wsf = (float*)(lds + OFF_WS) + wid * 64; float* li_l = wsf; float* al_l = wsf + 32;
    float m_reg = -1e30f, l_reg = 0; f32x16 o[2] = {}; bf16x8 qr[6];
    const int qrow0 = meta ? META0 : b * SEQ + qb * 256;
    const int qrow = qrow0 + wid * QBLK + r32;
    const int qloc = qb * 256 + wid * QBLK + r32;
#pragma unroll
    for (int d0 = 0; d0 < 4; ++d0) qr[d0] = *reinterpret_cast<const bf16x8*>(QN + (size_t)qrow * 1024 + h * 64 + d0 * 16 + hi * 8);
#pragma unroll
    for (int d0 = 0; d0 < 2; ++d0) qr[4 + d0] = *reinterpret_cast<const bf16x8*>(QR + (size_t)qrow * 512 + h * 32 + d0 * 16 + hi * 8);
    const int NT = meta ? 1 : 4 * qb + 5;
    const int sr = tid >> 3, sc = (tid & 7) * 8, rr = (tid & 255) >> 2, rc = (tid & 3) * 8;
    const int vst = v_st(sr, sc), kst = KSWZ(sr, sc * 2), rst = KSWZ(rr, 128 + rc * 2);
    const int vb0 = (int)(uintptr_t)V_lds + v_rd_base(lane);
    struct { bf16x8 kn, kr, vs; } st_[2];
#define TROW(t) ((t) == 0 ? META0 : b * SEQ + ((t) - 1) * KVBLK)
#define SLOAD(i, t) do { const int row0_ = TROW(t); st_[i].kn = *reinterpret_cast<const bf16x8*>(KN + (size_t)(row0_ + sr) * 1024 + h * 64 + sc); \
    st_[i].vs = *reinterpret_cast<const bf16x8*>(VV + (size_t)(row0_ + sr) * 1024 + h * 64 + sc); st_[i].kr = *reinterpret_cast<const bf16x8*>(KRB + (size_t)(row0_ + rr) * 32 + rc); } while (0)
#define SWRITE(bf, i) do { *(bf16x8*)(V_lds + (bf) * SHM_V + vst) = st_[i].vs; *(bf16x8*)(K_lds + (bf) * SHM_K + kst) = st_[i].kn; *(bf16x8*)(K_lds + (bf) * SHM_K + rst) = st_[i].kr; } while (0)
#define RESC(a) do { if (__any((a) < 1.f)) { if (hi == 0) al_l[r32] = (a); asm volatile("s_waitcnt lgkmcnt(0)" ::: "memory"); \
    _Pragma("unroll") for (int d = 0; d < 2; ++d) _Pragma("unroll") for (int r = 0; r < 16; ++r) o[d][r] *= al_l[crow(r, hi)]; } } while (0)
#define MASK(P0, P1, t) do { if ((t) == 0) { const int lim_ = meta ? (wid * QBLK + r32 < 15 ? wid * QBLK + r32 : 15) : 15; mask_tile(P0, P1, lim_, hi); } \
    else if ((t) > NT - 5) { mask_tile(P0, P1, qloc - ((t) - 1) * KVBLK, hi); } } while (0)
    f32x16 pA0, pA1, pB0, pB1; float mnA, mnB, alA, alB; bf16x8 pa0, pa1, pa2, pa3;
    SLOAD(0, 0); asm volatile("s_waitcnt vmcnt(0)" ::: "memory"); SWRITE(0, 0); __syncthreads();
    qkt(pA0, pA1, K_lds, qr, r32, hi); MASK(pA0, pA1, 0); partialSM(pA0, pA1, m_reg, mnA, alA);
    if (NT > 1) { SLOAD(1, 1); SLOAD(0, 2); asm volatile("s_waitcnt vmcnt(3)" ::: "memory"); SWRITE(1, 1); }
    __syncthreads();
    for (int j = 1; j + 1 < NT; j += 2) {
        SBAR(); qkt(pB0, pB1, K_lds + SHM_K, qr, r32, hi); MASK(pB0, pB1, j);
        finishSM(pA0, pA1, alA, l_reg, pa0, pa1, pa2, pa3); SBAR();
        if (j + 2 < NT) SLOAD(1, j + 2); SBAR();
        pv_all(o, vb0, pa0, pa1, pa2, pa3); partialSM(pB0, pB1, m_reg, mnB, alB);
        __syncthreads(); SWRITE(0, 0);
        RESC(alB); __syncthreads();
        SBAR(); qkt(pA0, pA1, K_lds, qr, r32, hi); MASK(pA0, pA1, j + 1);
        finishSM(pB0, pB1, alB, l_reg, pa0, pa1, pa2, pa3); SBAR();
        if (j + 3 < NT) SLOAD(0, j + 3); SBAR();
        pv_all(o, vb0 + SHM_V, pa0, pa1, pa2, pa3); partialSM(pA0, pA1, m_reg, mnA, alA);
        __syncthreads(); if (j + 2 < NT) SWRITE(1, 1);
        RESC(alA); __syncthreads();
    }
    finishSM(pA0, pA1, alA, l_reg, pa0, pa1, pa2, pa3); SBAR();
    pv_all(o, vb0, pa0, pa1, pa2, pa3);
    if (hi == 0) li_l[r32] = l_reg; asm volatile("s_waitcnt lgkmcnt(0)" ::: "memory");
#pragma unroll
    for (int r = 0; r < 16; ++r) { const int orow = qrow0 + wid * QBLK + crow(r, hi); const float rl = __builtin_amdgcn_rcpf(li_l[crow(r, hi)]);
#pragma unroll
        for (int d0 = 0; d0 < 2; ++d0) { const size_t idx = (size_t)orow * 1024 + h * 64 + d0 * 32 + r32;
            const float v = o[d0][r] * rl * bf2f(SZ[idx]); OG[idx] = (bf16)(cvtpk(v, v) & 0xffffu); } }
    __syncthreads();
#undef TROW
#undef SLOAD
#undef SWRITE
#undef RESC
#undef MASK
}
}

namespace as {
constexpr int IMG_HALF = 16384, IMG_ROPE = 32768, IMG_BYTES = 36864;
constexpr int OFF_Q = 0, OFF_K0 = IMG_BYTES, OFF_WS = OFF_K0 + 2 * IMG_BYTES, LDS_BYTES_AS = OFF_WS + 8 * 64 * 4;
constexpr float THR = 8.0f;
__device__ __forceinline__ unsigned off_a(unsigned row, unsigned ch) { return 2048u * (row >> 3) + 512u * (ch >> 2) + 64u * (row & 7) + 16u * ((ch & 3) ^ ((row >> 2) & 3)); }
__device__ __forceinline__ unsigned off_rope(unsigned row, unsigned ch) { return IMG_ROPE + 64u * row + 16u * (ch ^ ((row >> 2) & 3)); }
__device__ __forceinline__ unsigned img_off(unsigned row, unsigned c8) { return c8 < 32 ? (c8 >> 4) * IMG_HALF + off_a(row, c8 & 15) : off_rope(row, c8 - 32); }
__device__ __forceinline__ s16x4 tr_read_dyn(unsigned addr) { s16x4 r; asm volatile("ds_read_b64_tr_b16 %0, %1" : "=&v"(r) : "v"(addr) : "memory"); return r; }

__device__ __forceinline__ void attn_s_unit(const Args& A, int b, int s, char* lds) {
    unsigned char* ws = A.ws;
    int tid_ = threadIdx.x; asm volatile("" : "+v"(tid_));
    const int tid = tid_, wid = __builtin_amdgcn_readfirstlane(tid >> 6), lane = tid & 63, r32 = lane & 31, hi = lane >> 5;
    const int qg = wid & 1, kh = (wid >> 1) & 1, chh = wid >> 2;
    const int* pt = A.page_table + (size_t)b * NPAGES + s * 32;
    float* wsf = (float*)(lds + OFF_WS) + wid * 64;
    struct Stage { f32x8 c[4]; f32x4 r; } sA, sB;
    const int crow_ = tid >> 5, cc8 = tid & 31;
    const int rrow_ = tid >> 3, rc4 = tid & 7;
#define TLOAD(S, t) do { const int pg_ = pt[(t) >> 1]; const size_t k0_ = (size_t)pg_ * PAGE + ((t) & 1) * 64; \
    _Pragma("unroll") for (int i_ = 0; i_ < 4; ++i_) S.c[i_] = __builtin_nontemporal_load((const f32x8*)(A.cache_ckv + (k0_ + 16 * i_ + crow_) * KVL + cc8 * 8)); \
    S.r = __builtin_nontemporal_load((const f32x4*)(A.cache_krope + (k0_ + rrow_) * QKR + rc4 * 4)); } while (0)
#define TWRITE(bufoff, S) do { _Pragma("unroll") for (int i_ = 0; i_ < 4; ++i_) { u32x4 w_; w_.x = cvtpk(S.c[i_][0], S.c[i_][1]); w_.y = cvtpk(S.c[i_][2], S.c[i_][3]); w_.z = cvtpk(S.c[i_][4], S.c[i_][5]); w_.w = cvtpk(S.c[i_][6], S.c[i_][7]); \
        *(u32x4*)(lds + (bufoff) + img_off(16 * i_ + crow_, cc8)) = w_; } \
    { u32x2 w_; w_.x = cvtpk(S.r[0], S.r[1]); w_.y = cvtpk(S.r[2], S.r[3]); *(u32x2*)(lds + (bufoff) + off_rope(rrow_, rc4 >> 1) + (rc4 & 1) * 8) = w_; } } while (0)
    TLOAD(sA, 0); TLOAD(sB, 1);
    {
        const bf16* QN = (const bf16*)(ws + WS_QN); const bf16* QR = (const bf16*)(ws + WS_QR); const bf16* WUK = (const bf16*)(ws + WS_WUKV);
        bf16* QABS = (bf16*)(ws + WS_QABS) + (size_t)b * 64 * 288;
        const int h = tid >> 5, cg = tid & 31;
        float acc[4][8];
#pragma unroll
        for (int l = 0; l < 4; ++l)
#pragma unroll
            for (int k = 0; k < 8; ++k) acc[l][k] = 0.f;
        const size_t qrow0 = (size_t)(SAMP0 + b * 4);
        for (int d = 0; d < 64; d += 2) {
            const u32x4 w0 = *(const u32x4*)(WUK + (size_t)(h * 64 + d) * 256 + cg * 8), w1 = *(const u32x4*)(WUK + (size_t)(h * 64 + d + 1) * 256 + cg * 8);
#pragma unroll
            for (int l = 0; l < 4; ++l) { const unsigned qq = *(const unsigned*)(QN + (qrow0 + l) * 1024 + h * 64 + d); const float q0 = bflo(qq), q1 = bfhi(qq);
#pragma unroll
                for (int k = 0; k < 4; ++k) { acc[l][2 * k] += q0 * bflo(w0[k]) + q1 * bflo(w1[k]); acc[l][2 * k + 1] += q0 * bfhi(w0[k]) + q1 * bfhi(w1[k]); } }
        }
#pragma unroll
        for (int l = 0; l < 4; ++l) { u32x4 w; w.x = cvtpk(acc[l][0], acc[l][1]); w.y = cvtpk(acc[l][2], acc[l][3]); w.z = cvtpk(acc[l][4], acc[l][5]); w.w = cvtpk(acc[l][6], acc[l][7]);
            *(u32x4*)(lds + OFF_Q + img_off(l * 16 + h, cg)) = w; if (s == 0) *(u32x4*)(QABS + (size_t)(l * 16 + h) * 288 + cg * 8) = w; }
        if (tid < 256) { const int q = tid >> 2, c = tid & 3; const u32x4 w = *(const u32x4*)(QR + (qrow0 + (q >> 4)) * 512 + (q & 15) * 32 + c * 8);
            *(u32x4*)(lds + OFF_Q + off_rope(q, c)) = w; if (s == 0) *(u32x4*)(QABS + (size_t)q * 288 + 256 + c * 8) = w; }
    }
    unsigned kaddr[2], qaddr[2], kraddr, qraddr;
    { const unsigned krow = kh * 32 + r32, qrow = qg * 32 + r32;
#pragma unroll
      for (int od = 0; od < 2; ++od) { kaddr[od] = off_a(krow, 2 * od + hi); qaddr[od] = OFF_Q + off_a(qrow, 2 * od + hi); }
      kraddr = off_rope(krow, hi); qraddr = OFF_Q + off_rope(qrow, hi); }
    const unsigned kr2 = IMG_ROPE + 64u * (kh * 32 + r32) + 16u * ((2 + hi) ^ (((kh * 32 + r32) >> 2) & 3)), qr2 = OFF_Q + IMG_ROPE + 64u * (qg * 32 + r32) + 16u * ((2 + hi) ^ (((qg * 32 + r32) >> 2) & 3));
    unsigned vaddr[2];
    { const unsigned blk = (lane >> 4) & 1, q = (lane & 15) >> 2, p = lane & 3;
#pragma unroll
      for (int t = 0; t < 2; ++t) vaddr[t] = chh * IMG_HALF + off_a(32 * kh + 8 * hi + 4 * t + q, 2 * blk + (p >> 1)) + 8 * (p & 1); }
    float m_reg = -1e30f, l_reg = 0.f; f32x16 o[4] = {};
    const unsigned ldsb = (unsigned)(uintptr_t)lds;
#define COMPUTE(bufoff) do { f32x16 p = f32x16{}; \
    _Pragma("unroll") for (int d0 = 0; d0 < 16; ++d0) { const unsigned ko = (bufoff) + kaddr[d0 & 1] + 512 * ((d0 & 7) >> 1) + IMG_HALF * (d0 >> 3), qo = qaddr[d0 & 1] + 512 * ((d0 & 7) >> 1) + IMG_HALF * (d0 >> 3); \
        const bf16x8 kf = *(const bf16x8*)(lds + ko), qf = *(const bf16x8*)(lds + qo); p = __builtin_amdgcn_mfma_f32_32x32x16_bf16(kf, qf, p, 0, 0, 0); if ((d0 & 1) == 1) SBAR(); } \
    { const bf16x8 kf = *(const bf16x8*)(lds + (bufoff) + kraddr), qf = *(const bf16x8*)(lds + qraddr); p = __builtin_amdgcn_mfma_f32_32x32x16_bf16(kf, qf, p, 0, 0, 0); } \
    { const bf16x8 kf = *(const bf16x8*)(lds + (bufoff) + kr2), qf = *(const bf16x8*)(lds + qr2); p = __builtin_amdgcn_mfma_f32_32x32x16_bf16(kf, qf, p, 0, 0, 0); } \
    float pmax = p[0]; _Pragma("unroll") for (int r = 1; r < 16; ++r) pmax = fmaxf(pmax, p[r]); \
    { auto rr = __builtin_amdgcn_permlane32_swap(__float_as_uint(pmax), __float_as_uint(pmax), false, false); pmax = fmaxf(__uint_as_float(rr[0]), __uint_as_float(rr[1])); } \
    float alpha = 1.f; \
    if (!__all(pmax - m_reg <= THR)) { const float mn = fmaxf(m_reg, pmax); alpha = __builtin_amdgcn_exp2f(m_reg - mn); m_reg = mn; \
        if (hi == 0) wsf[r32] = alpha; asm volatile("s_waitcnt lgkmcnt(0)" ::: "memory"); \
        _Pragma("unroll") for (int n = 0; n < 4; ++n) _Pragma("unroll") for (int r = 0; r < 16; ++r) o[n][r] *= wsf[ap::crow(r, hi)]; } \
    float ps = 0.f; _Pragma("unroll") for (int r = 0; r < 16; ++r) { p[r] = __builtin_amdgcn_exp2f(p[r] - m_reg); ps += p[r]; } \
    { auto rr = __builtin_amdgcn_permlane32_swap(__float_as_uint(ps), __float_as_uint(ps), false, false); ps = __uint_as_float(rr[0]) + __uint_as_float(rr[1]); } \
    l_reg = l_reg * alpha + ps; \
    bf16x8 pa0, pa1; PK4(p, 0, pa0); PK4(p, 8, pa1); \
    _Pragma("unroll") for (int nt = 0; nt < 4; ++nt) { \
        const s16x4 a0 = tr_read_dyn(ldsb + (bufoff) + vaddr[0] + 512 * nt), a1 = tr_read_dyn(ldsb + (bufoff) + vaddr[1] + 512 * nt); \
        const s16x4 b0 = tr_read_dyn(ldsb + (bufoff) + vaddr[0] + 512 * nt + 4096), b1 = tr_read_dyn(ldsb + (bufoff) + vaddr[1] + 512 * nt + 4096); \
        asm volatile("s_waitcnt lgkmcnt(0)" ::: "memory"); SBAR(); \
        o[nt] = __builtin_amdgcn_mfma_f32_32x32x16_bf16(pa0, ((bf16x8){a0[0], a0[1], a0[2], a0[3], a1[0], a1[1], a1[2], a1[3]}), o[nt], 0, 0, 0); \
        o[nt] = __builtin_amdgcn_mfma_f32_32x32x16_bf16(pa1, ((bf16x8){b0[0], b0[1], b0[2], b0[3], b1[0], b1[1], b1[2], b1[3]}), o[nt], 0, 0, 0); } } while (0)
    TWRITE(OFF_K0, sA); TLOAD(sA, 2); __syncthreads();
    for (int t = 0; t < 64; t += 2) {
        SBAR(); COMPUTE(OFF_K0); SBAR();
        TWRITE(OFF_K0 + IMG_BYTES, sB); if (t + 3 < 64) TLOAD(sB, t + 3);
        __syncthreads();
        SBAR(); COMPUTE(OFF_K0 + IMG_BYTES); SBAR();
        if (t + 2 < 64) { TWRITE(OFF_K0, sA); if (t + 4 < 64) TLOAD(sA, t + 4); }
        __syncthreads();
    }
    { const int part = s * 2 + kh; float* PO = (float*)(ws + WS_PART) + ((size_t)(b * 4 + part) * 64) * 256; float* PML = (float*)(ws + WS_PML) + (size_t)(b * 4 + part) * 128;
#pragma unroll
      for (int nt = 0; nt < 4; ++nt)
#pragma unroll
          for (int r = 0; r < 16; ++r) PO[(size_t)(qg * 32 + ap::crow(r, hi)) * 256 + chh * 128 + nt * 32 + r32] = o[nt][r];
      if (chh == 0 && hi == 0) { PML[qg * 32 + r32] = m_reg; PML[64 + qg * 32 + r32] = l_reg; } }
    __syncthreads();
#undef TLOAD
#undef TWRITE
#undef COMPUTE
}
#undef PK4
#undef PKV
#undef KSWZ
}

__device__ __forceinline__ void comb_unit(const Args& A, int b, int l, char* lds) {
    int tid_ = threadIdx.x; asm volatile("" : "+v"(tid_));
    unsigned char* ws = A.ws; const int tid = tid_, h = tid >> 5, j = tid & 31, q = l * 16 + h;
    const bf16* QABS = (const bf16*)(ws + WS_QABS) + ((size_t)b * 64 + q) * 288; const bf16* CB = (const bf16*)(ws + WS_CB); const bf16* KRB = (const bf16*)(ws + WS_KRB);
    const float* PO = (const float*)(ws + WS_PART) + ((size_t)b * 4 * 64 + q) * 256; const float* PML = (const float*)(ws + WS_PML) + (size_t)b * 4 * 128;
    float* olds = (float*)lds;
    float qv[8], qrv[8];
    { const u32x4 w = *(const u32x4*)(QABS + j * 8);
#pragma unroll
      for (int k = 0; k < 4; ++k) { qv[2 * k] = bflo(w[k]); qv[2 * k + 1] = bfhi(w[k]); }
      u32x4 wr = (u32x4){0u, 0u, 0u, 0u}; if (j < 4) wr = *(const u32x4*)(QABS + 256 + j * 8);
#pragma unroll
      for (int k = 0; k < 4; ++k) { qrv[2 * k] = bflo(wr[k]); qrv[2 * k + 1] = bfhi(wr[k]); } }
    float sc[4], cn[4][8];
#pragma unroll
    for (int jn = 0; jn < 4; ++jn) { const size_t row = (size_t)(SAMP0 + b * 4 + jn); const u32x4 w = *(const u32x4*)(CB + row * 256 + j * 8); float d = 0.f;
#pragma unroll
        for (int k = 0; k < 4; ++k) { cn[jn][2 * k] = bflo(w[k]); cn[jn][2 * k + 1] = bfhi(w[k]); d += qv[2 * k] * cn[jn][2 * k] + qv[2 * k + 1] * cn[jn][2 * k + 1]; }
        if (j < 4) { const u32x4 wr = *(const u32x4*)(KRB + row * 32 + j * 8);
#pragma unroll
            for (int k = 0; k < 4; ++k) d += qrv[2 * k] * bflo(wr[k]) + qrv[2 * k + 1] * bfhi(wr[k]); }
#pragma unroll
        for (int o = 1; o < 32; o <<= 1) d = d + shfl_xor_f(d, o, tid & 63);
        sc[jn] = jn <= l ? d : -INFINITY; }
    float mp[4], lp[4], M = -INFINITY;
#pragma unroll
    for (int p = 0; p < 4; ++p) { mp[p] = PML[p * 128 + q]; lp[p] = PML[p * 128 + 64 + q]; M = fmaxf(M, mp[p]); }
#pragma unroll
    for (int jn = 0; jn < 4; ++jn) M = fmaxf(M, sc[jn]);
    float L = 0.f, acc[8];
#pragma unroll
    for (int k = 0; k < 8; ++k) acc[k] = 0.f;
#pragma unroll
    for (int p = 0; p < 4; ++p) { const float w = __builtin_amdgcn_exp2f(mp[p] - M); L += w * lp[p]; const f32x4 a = *(const f32x4*)(PO + (size_t)p * 64 * 256 + j * 8), c = *(const f32x4*)(PO + (size_t)p * 64 * 256 + j * 8 + 4);
#pragma unroll
        for (int k = 0; k < 4; ++k) { acc[k] += w * a[k]; acc[4 + k] += w * c[k]; } }
#pragma unroll
    for (int jn = 0; jn < 4; ++jn) { const float w = __builtin_amdgcn_exp2f(sc[jn] - M); L += w;
#pragma unroll
        for (int k = 0; k < 8; ++k) acc[k] += w * cn[jn][k]; }
    const float rl = 1.0f / L;
    *(f32x4*)(olds + h * 256 + j * 8) = (f32x4){acc[0] * rl, acc[1] * rl, acc[2] * rl, acc[3] * rl}; *(f32x4*)(olds + h * 256 + j * 8 + 4) = (f32x4){acc[4] * rl, acc[5] * rl, acc[6] * rl, acc[7] * rl};
    __syncthreads();
    const bf16* WUV = (const bf16*)(ws + WS_WUKV) + (size_t)(1024 + h * 64 + 2 * j) * 256;
    float o0 = 0.f, o1 = 0.f;
    for (int c = 0; c < 256; c += 8) { const u32x4 w0 = *(const u32x4*)(WUV + c), w1 = *(const u32x4*)(WUV + 256 + c); const f32x4 x0 = *(const f32x4*)(olds + h * 256 + c), x1 = *(const f32x4*)(olds + h * 256 + c + 4);
        o0 += x0[0] * bflo(w0[0]) + x0[1] * bfhi(w0[0]) + x0[2] * bflo(w0[1]) + x0[3] * bfhi(w0[1]) + x1[0] * bflo(w0[2]) + x1[1] * bfhi(w0[2]) + x1[2] * bflo(w0[3]) + x1[3] * bfhi(w0[3]);
        o1 += x0[0] * bflo(w1[0]) + x0[1] * bfhi(w1[0]) + x0[2] * bflo(w1[1]) + x0[3] * bfhi(w1[1]) + x1[0] * bflo(w1[2]) + x1[1] * bfhi(w1[2]) + x1[2] * bflo(w1[3]) + x1[3] * bfhi(w1[3]); }
    const size_t orow = (size_t)(SAMP0 + b * 4 + l) * 1024 + h * 64 + 2 * j;
    const unsigned z = *(const unsigned*)((const bf16*)(ws + WS_SZ) + orow);
    *(unsigned*)((bf16*)(ws + WS_OG) + orow) = cvtpk(o0 * bflo(z), o1 * bfhi(z));
    __syncthreads();
}
#ifndef EN_P0
#define EN_P0 1
#endif
#ifndef EN_G1
#define EN_G1 1
#endif
#ifndef EN_CONV
#define EN_CONV 1
#endif
#ifndef EN_G4
#define EN_G4 1
#endif
#ifndef EN_LAT
#define EN_LAT 1
#endif
#ifndef EN_G5
#define EN_G5 1
#endif
#ifndef EN_G6
#define EN_G6 1
#endif
#ifndef EN_AP
#define EN_AP 1
#endif
#ifndef EN_AS
#define EN_AS 1
#endif
#ifndef EN_COMB
#define EN_COMB 1
#endif
#ifndef EN_GOUT
#define EN_GOUT 1
#endif
#ifndef EN_NORM
#define EN_NORM 1
#endif

__global__ void __launch_bounds__(NWAVES * 64, 2) yoco_fwd(Args args) {
    extern __shared__ __attribute__((aligned(16))) unsigned char lds[];
    LAS unsigned char* ldsl = (LAS unsigned char*)lds;
    const int tid = threadIdx.x, wave = __builtin_amdgcn_readfirstlane(tid >> 6);
#define LANE_OPAQUE() int lane = threadIdx.x & 63; asm volatile("" : "+v"(lane))
    const int G = gridDim.x; const int bx = blockIdx.x; const int vcu = (G % 8 == 0) ? (bx % 8) * (G / 8) + bx / 8 : bx;
    const int gw = vcu * NWAVES + wave, NGW = G * NWAVES;
    unsigned char* ws = args.ws;
    if (tid < 4) ((LAS unsigned*)(ldsl + LDSCTL_OFF))[tid] = 0u;
    __syncthreads();
    XcdBarrier bar = xcd_barrier_post((unsigned*)(ws + WS_CTL) + CW_BAR, (volatile LAS unsigned*)(ldsl + LDSCTL_OFF));

#define GRID_BAR() do { XcdBarrier b_ = bar; b_.x = __builtin_amdgcn_readfirstlane(b_.x); asm volatile("" : "+s"(b_.bar), "+s"(b_.x)); xcd_barrier(b_); } while (0)
#if EN_P0
    { LANE_OPAQUE(); p0_prologue(args, ldsl, gw, NGW, wave, lane); }
#endif
    GRID_BAR();

    bf16* XH = (bf16*)(ws + WS_XH);
#pragma unroll 1
    for (int l = 0; l < 4; ++l) {
        if (l < 2) {
            { pg8::Gemm g{XH, (const bf16*)(ws + WS_WIN) + (size_t)l * 4096 * 1024, NROWS, 4096, 1024}; pg8::StaticOrder S; S.init(NROWS, 4096, G, bx);
              pg8::EpiConvSplit E{(bf16*)(ws + WS_V1), (bf16*)(ws + WS_GZ)};
#if EN_G1
              pg8::gemm_phase<pg8::EpiConvSplit, pg8::StaticOrder, true, true>(ldsl, g, S, E);
#endif
 }
            GRID_BAR();
#if EN_CONV
            { LANE_OPAQUE(); conv_phase(args, l, gw, NGW, lane); }
#endif
            GRID_BAR();
        } else {
            const int j = l - 2;
            { pg8::Gemm g{XH, (const bf16*)(ws + (j ? WS_WA1 : WS_WA0)), NROWS, j ? 1536 : 2048, 1024}; pg8::StaticOrder S; S.init(NROWS, j ? 1536 : 2048, G, bx);
              pg8::EpiMlaIn E{(float*)(ws + WS_CKR), (bf16*)(ws + WS_QL), (float*)(ws + WS_SSQ), (bf16*)(ws + WS_SZ), j ? 0 : 2};
#if EN_G4
              pg8::gemm_phase<pg8::EpiMlaIn, pg8::StaticOrder, true, true>(ldsl, g, S, E);
#endif
 }
            GRID_BAR();
            if (j == 0) {
#if EN_LAT
                { LANE_OPAQUE(); latent_phase(args, gw, NGW, lane); }
#endif
                GRID_BAR();
                { pg8::Gemm g{(const bf16*)(ws + WS_CB), (const bf16*)(ws + WS_WUKV), NROWS, 2048, 256}; pg8::StaticOrder S; S.init(NROWS, 2048, G, bx);
                  pg8::EpiBf16 E{(bf16*)(ws + WS_KN), 1024, 1024, (size_t)(WS_VV - WS_KN) / 2};
#if EN_G5
                  pg8::gemm_phase<pg8::EpiBf16, pg8::StaticOrder, true, true>(ldsl, g, S, E);
#endif
 }
            }
            { pg8::Gemm g{(const bf16*)(ws + WS_QL), (const bf16*)(ws + WS_WUQ) + (size_t)j * 1536 * 512, NROWS, 1536, 512}; pg8::StaticOrder S; S.init(NROWS, 1536, G, bx);
              pg8::EpiQUp E{(bf16*)(ws + WS_QN), (bf16*)(ws + WS_QR), (const float*)(ws + WS_SSQ), (const float*)(ws + WS_COS), (const float*)(ws + WS_SIN)};
#if EN_G6
              pg8::gemm_phase<pg8::EpiQUp, pg8::StaticOrder, true, true>(ldsl, g, S, E);
#endif
 }
            GRID_BAR();
            {
                const bf16* QN = (const bf16*)(ws + WS_QN); const bf16* QR = (const bf16*)(ws + WS_QR); const bf16* KN = (const bf16*)(ws + WS_KN); const bf16* KRB = (const bf16*)(ws + WS_KRB);
                const bf16* VV = (const bf16*)(ws + WS_VV); const bf16* SZ = (const bf16*)(ws + WS_SZ); bf16* OG = (bf16*)(ws + WS_OG);
#if EN_AP
                for (int u = vcu; u < 256 + 16; u += G) {
                    if (u < 256) { const int bh = u >> 2, s = u & 3;
#pragma unroll 1
                        for (int k = 0; k < 4; ++k) { const int qb = (k == 0) ? s : (k == 1) ? 15 - s : (k == 2) ? 4 + s : 11 - s;
                            ap::attn_unit(QN, QR, KN, KRB, VV, SZ, OG, bh >> 4, bh & 15, qb, false, (char*)lds); } }
                    else ap::attn_unit(QN, QR, KN, KRB, VV, SZ, OG, 0, u - 256, 0, true, (char*)lds);
                }
#endif
#if EN_AS
                for (int u = vcu; u < 2 * DECB; u += G) as::attn_s_unit(args, u >> 1, u & 1, (char*)lds);
#endif
            }
            GRID_BAR();
#if EN_COMB
            for (int u = vcu; u < NSAMP; u += G) comb_unit(args, u >> 2, u & 3, (char*)lds);
#endif
            GRID_BAR();
        }
        { pg8::Gemm g{(const bf16*)(ws + (l < 2 ? WS_G : WS_OG)), (const bf16*)(ws + (l < 2 ? WS_WOC : WS_WOM)) + (size_t)(l & 1) * 1024 * 1024, NROWS, 1024, 1024}; pg8::StaticOrder S; S.init(NROWS, 1024, G, bx);
          pg8::EpiBf16 E{(bf16*)(ws + WS_MB), 1024, 0, 0};
#if EN_GOUT
          pg8::gemm_phase<pg8::EpiBf16, pg8::StaticOrder, true, true>(ldsl, g, S, E);
#endif
 }
        GRID_BAR();
#if EN_NORM
        { LANE_OPAQUE(); norm_phase(args, l, gw, NGW, lane); }
#endif
        if (l < 3) GRID_BAR();
    }
}

extern "C" void kernel_launch(void* const* d_in, const int* in_sizes, int n_in, void* d_out, int out_size, void* d_ws, size_t ws_size, hipStream_t stream) {
    static int grid = 0;
    if (grid == 0) {
        if (n_in != 21 || out_size != (int)O_END || ws_size < WS_END) { fprintf(stderr, "kernel_launch: unexpected shapes: n_in %d out %d (want %zu) ws %zu (want >= %zu)\n", n_in, out_size, (size_t)O_END, ws_size, (size_t)WS_END); grid = -1; return; }
        int dev = 0, cus = 0, per_cu = 0;
        if (hipGetDevice(&dev) != hipSuccess || hipDeviceGetAttribute(&cus, hipDeviceAttributeMultiprocessorCount, dev) != hipSuccess) { grid = -1; return; }
        if (hipFuncSetAttribute((const void*)yoco_fwd, hipFuncAttributeMaxDynamicSharedMemorySize, LDS_BYTES) != hipSuccess) { fprintf(stderr, "kernel_launch: hipFuncSetAttribute failed\n"); grid = -1; return; }
        if (hipOccupancyMaxActiveBlocksPerMultiprocessor(&per_cu, (const void*)yoco_fwd, NWAVES * 64, LDS_BYTES) != hipSuccess || per_cu < 1) { fprintf(stderr, "kernel_launch: occupancy query says %d blocks per CU\n", per_cu); }
        (void)hipGetLastError();
        grid = cus;
    }
    if (grid < 0) return;
    if (hipMemsetAsync((char*)d_ws + WS_CTL, 0, CTL_ZERO_BYTES, stream) != hipSuccess) return;
    Args a{};
    a.x_prompt = (const float*)d_in[0]; a.x_sample = (const float*)d_in[1]; a.cache_ckv = (const float*)d_in[2]; a.cache_krope = (const float*)d_in[3]; a.state_conv = (const float*)d_in[4];
    a.page_table = (const int*)d_in[5]; a.meta = (const float*)d_in[6]; a.pre_g = (const float*)d_in[7]; a.post_g = (const float*)d_in[8]; a.w_in_conv = (const float*)d_in[9];
    a.conv_w = (const float*)d_in[10]; a.w_out_conv = (const float*)d_in[11]; a.kv_norm_g = (const float*)d_in[12]; a.w_dkv = (const float*)d_in[13]; a.kv_lat_g = (const float*)d_in[14];
    a.w_uk = (const float*)d_in[15]; a.w_uv = (const float*)d_in[16]; a.w_in_mla = (const float*)d_in[17]; a.q_norm_g = (const float*)d_in[18]; a.w_uq = (const float*)d_in[19]; a.w_out_mla = (const float*)d_in[20];
    a.out = (float*)d_out; a.ws = (unsigned char*)d_ws;
    hipLaunchKernelGGL(yoco_fwd, dim3(grid), dim3(NWAVES * 64), LDS_BYTES, stream, a);
    const hipError_t le = hipPeekAtLastError();
    if (le != hipSuccess) fprintf(stderr, "kernel_launch: launch failed: %s\n", hipGetErrorName(le));
}
```

```cpp
#include <hip/hip_runtime.h>
#include <hip/hip_bf16.h>
#include <cstdio>
#include <cstdint>
#include <cmath>

constexpr int DM = 1024, NB = 4, SEQ = 4096, NMETA = 16, TTOT = SEQ + NMETA;
constexpr int DECB = 128, DECS = 4, PAST = 8192, PAGE = 128, NPAGES = PAST / PAGE;
constexpr int NH = 16, QKN = 64, QKR = 32, VH = 64, QLORA = 512, KVL = 256;
constexpr int NMAIN = NB * SEQ;
constexpr int SAMP0 = NMAIN, NSAMP = DECB * DECS;
constexpr int META0 = SAMP0 + NSAMP;
constexpr int NROWS = META0 + 256;
constexpr int NPOS = TTOT + DECS;
constexpr float RMS_EPS = 1e-6f;
constexpr int AS_SPLITS = 2, AS_PAGES = NPAGES / AS_SPLITS;
constexpr float QSCALE = 0.10206207261596575f * 1.4426950408889634f;

__device__ __forceinline__ float shfl_xor_f(float v, int mask, int lane) { return __int_as_float(__builtin_amdgcn_ds_bpermute((lane ^ mask) << 2, __float_as_int(v))); }

__device__ __forceinline__ int lane_fresh() { int l; asm volatile("v_mbcnt_lo_u32_b32 %0, -1, 0\n\tv_mbcnt_hi_u32_b32 %0, -1, %0" : "=v"(l)); return l & 63; }

namespace pg8 {
#define PG8_LAS __attribute__((address_space(3)))
typedef unsigned short bf16_t;
typedef short bf16x8 __attribute__((ext_vector_type(8)));
typedef float f32x4 __attribute__((ext_vector_type(4)));
typedef unsigned u32x4 __attribute__((ext_vector_type(4)));
constexpr int BM = 256, BK = 64, HALF = 128, HTB = HALF * BK * 2  , STAGE_BYTES = 8 * HTB, NXCD = 8, WGM = 8;

__host__ __device__ __forceinline__ int lds_byte(int r, int c) { const int st = (r >> 4) * 2 + (c >> 5), rr = r & 15, cc = c & 31, ob = rr * 64 + cc * 2; return st * 1024 + (ob ^ (((ob >> 9) & 1) << 5)); }
__host__ __device__ __forceinline__ void stage_rc(int b, int& R, int& C) { const int st = b / 1024, sb = b % 1024, swz = sb ^ (((sb >> 9) & 1) << 5); R = (st >> 1) * 16 + swz / 64; C = (st & 1) * 32 + (swz % 64) / 2; }
__host__ __device__ __forceinline__ int perm32(int rho) { const int n = rho >> 4, i = rho & 15; return 8 * (i >> 2) + 4 * n + (i & 3); }

struct Unit { int pm, pn; int koff = 0; };
struct Gemm { const bf16_t* A; const bf16_t* Bt; int M, N, K; int ld = 0; };

struct StaticOrder {
    int nM, nN, nwg, G, c;
    __host__ __device__ void init(int M, int N, int G_, int c_) { nM = M / BM; nN = N / BM; nwg = nM * nN; G = G_; c = c_; }
    __host__ __device__ bool next(int i, Unit& u) const {
        const long L = (long)i * G + c; if (L >= nwg) return false;
        int wgid = (int)L; { const int q = nwg / NXCD, r = nwg % NXCD, xcd = wgid % NXCD, off = wgid / NXCD; wgid = (xcd < r ? xcd * (q + 1) : r * (q + 1) + (xcd - r) * q) + off; }
        const int nig = WGM * nN, gid = wgid / nig, fm = gid * WGM, gsz = (nM - fm) < WGM ? (nM - fm) : WGM;
        u.pm = fm + ((wgid % nig) % gsz); u.pn = (wgid % nig) / gsz; return true;
    }
    __device__ __forceinline__ void a_ready(const Unit&) const {}
    __device__ __forceinline__ void done(const Unit&) const {}
};


template <int R> struct RepOrder {
    StaticOrder base; int cnt;
    __host__ __device__ void init(int M, int N, int G_, int c_) { base.init(M, N, G_, c_); cnt = (base.nwg - c_ + G_ - 1) / G_; if (cnt < 0) cnt = 0; }
    __host__ __device__ bool next(int i, Unit& u) const { if (i >= R * cnt) return false; return base.next(i % cnt, u); }
    __device__ __forceinline__ void a_ready(const Unit&) const {}
    __device__ __forceinline__ void done(const Unit&) const {}
};

template <int S> struct SplitKSmallOrder {
    int nN, G, c, ksub;
    __host__ __device__ void init(int N, int K, int G_, int c_) { nN = N / BM; G = G_; c = c_; ksub = K / S; }
    __host__ __device__ bool next(int i, Unit& u) const { const long L = (long)i * G + c; if (L >= 3L * nN * S) return false; const int r = (int)(L / S); u.koff = (int)(L % S) * ksub; u.pm = 64 + r % 3; u.pn = r / 3; return true; }
    __device__ __forceinline__ void a_ready(const Unit&) const {}
    __device__ __forceinline__ void done(const Unit&) const {}
};

typedef float f32x2_t __attribute__((ext_vector_type(2))); typedef __bf16 bf16x2_t __attribute__((ext_vector_type(2)));
__device__ __forceinline__ unsigned cvt_pk_bf16(float lo, float hi) { f32x2_t v = {lo, hi}; bf16x2_t b = __builtin_convertvector(v, bf16x2_t); return __builtin_bit_cast(unsigned, b); }
typedef unsigned u32x2 __attribute__((ext_vector_type(2)));
__device__ __forceinline__ float sigmoidf_fast(float z) { return __builtin_amdgcn_rcpf(1.0f + __builtin_amdgcn_exp2f(-1.4426950408889634f * z)); }

struct EpiBf16 {
    static constexpr bool PERM = true, AFTER_DRAIN = false;
    bf16_t* O; int ldc; int split_cols; size_t split_stride;
    __device__ __forceinline__ void operator()(const f32x4 (&acc)[2][2][4][2], const Unit& u, int wr, int wc, int fr, int fq) const {
        const int row0 = u.pm * BM + wr * 64 + fr; int colt = u.pn * BM; bf16_t* base = O;
        if (split_cols && colt >= split_cols) { base += split_stride; colt -= split_cols; }
        const int col0 = colt + wc * 32 + 8 * fq;
#pragma unroll
        for (int ai = 0; ai < 2; ++ai)
#pragma unroll
            for (int m = 0; m < 4; ++m) { bf16_t* rowp = base + (size_t)(row0 + ai * HALF + m * 16) * ldc + col0;
#pragma unroll
                for (int bj = 0; bj < 2; ++bj) { const f32x4 v0 = acc[ai][bj][m][0], v1 = acc[ai][bj][m][1];
                    u32x4 w; w.x = cvt_pk_bf16(v0[0], v0[1]); w.y = cvt_pk_bf16(v0[2], v0[3]); w.z = cvt_pk_bf16(v1[0], v1[1]); w.w = cvt_pk_bf16(v1[2], v1[3]);
                    *(u32x4*)(rowp + bj * HALF) = w; } }
    }
};

struct EpiConvSplit {
    static constexpr bool PERM = true, AFTER_DRAIN = false;
    bf16_t* V; bf16_t* GZ; const float* RS;
    __device__ __forceinline__ void operator()(const f32x4 (&acc)[2][2][4][2], const Unit& u, int wr, int wc, int fr, int fq) const {
        const int row0 = u.pm * BM + wr * 64 + fr, ch0 = u.pn * 64 + wc * 16 + fq * 4;
#pragma unroll
        for (int ai = 0; ai < 2; ++ai)
#pragma unroll
            for (int m = 0; m < 4; ++m) { const size_t off = (size_t)(row0 + ai * HALF + m * 16) * 1024 + ch0;
                const float rs = RS[row0 + ai * HALF + m * 16];
                const f32x4 bg = acc[ai][0][m][0] * rs, cg = acc[ai][0][m][1] * rs, uu = acc[ai][1][m][0] * rs, zz = acc[ai][1][m][1] * rs;
                const f32x4 v = cg * uu; f32x4 g;
#pragma unroll
                for (int e = 0; e < 4; ++e) g[e] = bg[e] * zz[e] * sigmoidf_fast(zz[e]);
                u32x2 wv, wg; wv.x = cvt_pk_bf16(v[0], v[1]); wv.y = cvt_pk_bf16(v[2], v[3]); wg.x = cvt_pk_bf16(g[0], g[1]); wg.y = cvt_pk_bf16(g[2], g[3]);
                *(u32x2*)(V + off) = wv; *(u32x2*)(GZ + off) = wg; }
    }
};

struct EpiMlaIn {
    static constexpr bool PERM = true, AFTER_DRAIN = false;
    float* CKR; bf16_t* QL; float* SSQ; bf16_t* SZ; int nck; const float* RS;
    __device__ __forceinline__ void operator()(const f32x4 (&acc)[2][2][4][2], const Unit& u, int wr, int wc, int fr, int fq) const {
        const int row0 = u.pm * BM + wr * 64 + fr; const int t = u.pn - nck;
        if (t < 0) {
            const int col0 = u.pn * BM + wc * 32 + 8 * fq;
#pragma unroll
            for (int ai = 0; ai < 2; ++ai)
#pragma unroll
                for (int m = 0; m < 4; ++m) { float* rowp = CKR + (size_t)(row0 + ai * HALF + m * 16) * 512 + col0; const float rs = RS[row0 + ai * HALF + m * 16];
#pragma unroll
                    for (int bj = 0; bj < 2; ++bj) { *(f32x4*)(rowp + bj * HALF) = acc[ai][bj][m][0] * rs; *(f32x4*)(rowp + bj * HALF + 4) = acc[ai][bj][m][1] * rs; } }
        } else if (t < 2) {
            const int col0 = t * BM + wc * 32 + 8 * fq;
#pragma unroll
            for (int ai = 0; ai < 2; ++ai)
#pragma unroll
                for (int m = 0; m < 4; ++m) { const int row = row0 + ai * HALF + m * 16; bf16_t* rowp = QL + (size_t)row * 512 + col0; float s = 0.f; const float rs = RS[row];
#pragma unroll
                    for (int bj = 0; bj < 2; ++bj) { const f32x4 v0 = acc[ai][bj][m][0] * rs, v1 = acc[ai][bj][m][1] * rs;
                        s += (v0[0] * v0[0] + v0[1] * v0[1]) + (v0[2] * v0[2] + v0[3] * v0[3]) + (v1[0] * v1[0] + v1[1] * v1[1]) + (v1[2] * v1[2] + v1[3] * v1[3]);
                        u32x4 w; w.x = cvt_pk_bf16(v0[0], v0[1]); w.y = cvt_pk_bf16(v0[2], v0[3]); w.z = cvt_pk_bf16(v1[0], v1[1]); w.w = cvt_pk_bf16(v1[2], v1[3]);
                        *(u32x4*)(rowp + bj * HALF) = w; }
                    { const int ln = fq * 16 + fr; s += shfl_xor_f(s, 16, ln); s += shfl_xor_f(s, 32, ln); }
                    if (fq == 0) SSQ[(size_t)row * 8 + t * 4 + wc] = s; }
        } else {
            const int col0 = (t - 2) * BM + wc * 32 + 8 * fq;
#pragma unroll
            for (int ai = 0; ai < 2; ++ai)
#pragma unroll
                for (int m = 0; m < 4; ++m) { bf16_t* rowp = SZ + (size_t)(row0 + ai * HALF + m * 16) * 1024 + col0; const float rs = RS[row0 + ai * HALF + m * 16];
#pragma unroll
                    for (int bj = 0; bj < 2; ++bj) { f32x4 v0 = acc[ai][bj][m][0] * rs, v1 = acc[ai][bj][m][1] * rs;
#pragma unroll
                        for (int e = 0; e < 4; ++e) { v0[e] = v0[e] * sigmoidf_fast(v0[e]); v1[e] = v1[e] * sigmoidf_fast(v1[e]); }
                        u32x4 w; w.x = cvt_pk_bf16(v0[0], v0[1]); w.y = cvt_pk_bf16(v0[2], v0[3]); w.z = cvt_pk_bf16(v1[0], v1[1]); w.w = cvt_pk_bf16(v1[2], v1[3]);
                        *(u32x4*)(rowp + bj * HALF) = w; } }
        }
    }
};

__device__ __forceinline__ int posidx_of_row(int row) {
    return row < NMAIN ? (row & (SEQ - 1)) + NMETA : (row < META0 ? TTOT + ((row - SAMP0) & 3) : (row < META0 + NMETA ? row - META0 : 0));
}
struct EpiQUp {
    static constexpr bool PERM = true, AFTER_DRAIN = false;
    bf16_t* QN; bf16_t* QR; const float* SSQ; const float* COS; const float* SIN;
    __device__ __forceinline__ void operator()(const f32x4 (&acc)[2][2][4][2], const Unit& u, int wr, int wc, int fr, int fq) const {
        const int row0 = u.pm * BM + wr * 64 + fr;
#pragma unroll
        for (int ai = 0; ai < 2; ++ai)
#pragma unroll
            for (int m = 0; m < 4; ++m) { const int row = row0 + ai * HALF + m * 16;
                const f32x4 s0 = *(const f32x4*)(SSQ + (size_t)row * 8), s1 = *(const f32x4*)(SSQ + (size_t)row * 8 + 4);
                const float ss = ((s0[0] + s0[1]) + (s0[2] + s0[3])) + ((s1[0] + s1[1]) + (s1[2] + s1[3]));
                const float sc = QSCALE / sqrtf(ss * (1.0f / 512.0f) + RMS_EPS);
                if (u.pn < 4) { bf16_t* rowp = QN + (size_t)row * 1024 + u.pn * BM + wc * 32 + 8 * fq;
#pragma unroll
                    for (int bj = 0; bj < 2; ++bj) { const f32x4 v0 = acc[ai][bj][m][0] * sc, v1 = acc[ai][bj][m][1] * sc;
                        u32x4 w; w.x = cvt_pk_bf16(v0[0], v0[1]); w.y = cvt_pk_bf16(v0[2], v0[3]); w.z = cvt_pk_bf16(v1[0], v1[1]); w.w = cvt_pk_bf16(v1[2], v1[3]);
                        *(u32x4*)(rowp + bj * HALF) = w; }
                } else { const int pi = posidx_of_row(row);
                    const f32x4 cs = *(const f32x4*)(COS + pi * 16 + 4 * fq), sn = *(const f32x4*)(SIN + pi * 16 + 4 * fq);
#pragma unroll
                    for (int bj = 0; bj < 2; ++bj) { const f32x4 x1 = acc[ai][bj][m][0] * sc, x2 = acc[ai][bj][m][1] * sc;
                        const f32x4 o1 = x1 * cs - x2 * sn, o2 = x1 * sn + x2 * cs;
                        bf16_t* hp = QR + (size_t)row * 512 + ((u.pn - 4) * 8 + 4 * bj + wc) * 32 + 4 * fq;
                        u32x2 w1, w2; w1.x = cvt_pk_bf16(o1[0], o1[1]); w1.y = cvt_pk_bf16(o1[2], o1[3]); w2.x = cvt_pk_bf16(o2[0], o2[1]); w2.y = cvt_pk_bf16(o2[2], o2[3]);
                        *(u32x2*)hp = w1; *(u32x2*)(hp + 16) = w2; } }
            }
    }
};


struct EpiPartF32 {
    static constexpr bool PERM = true, AFTER_DRAIN = false;
    float* P; int ksub;
    __device__ __forceinline__ void operator()(const f32x4 (&acc)[2][2][4][2], const Unit& u, int wr, int wc, int fr, int fq) const {
        float* base = P + ((size_t)(u.koff / ksub) * 768 + (size_t)(u.pm - 64) * BM + wr * 64 + fr) * 1024 + u.pn * BM + wc * 32 + 8 * fq;
#pragma unroll
        for (int ai = 0; ai < 2; ++ai)
#pragma unroll
            for (int m = 0; m < 4; ++m) { float* rowp = base + (size_t)(ai * HALF + m * 16) * 1024;
#pragma unroll
                for (int bj = 0; bj < 2; ++bj) { *(f32x4*)(rowp + bj * HALF) = acc[ai][bj][m][0]; *(f32x4*)(rowp + bj * HALF + 4) = acc[ai][bj][m][1]; } }
    }
};
template <class Epi, class Sched, bool ALIGN_EPI = false, bool SP2 = false>
__device__ __forceinline__ void gemm_phase(PG8_LAS unsigned char* lds, const Gemm g, const Sched& S, const Epi& E, const int wave) {
    int wave_ = wave; asm volatile("" : "+s"(wave_)); wave_ &= 7;
    const int lane = lane_fresh(), tid = wave_ * 64 + lane, wid = wave_, wr = wid >> 2, wc = wid & 3, fr = lane & 15, fq = lane >> 4;
    const int K = g.K, nt = K / BK, ld = g.ld ? g.ld : g.K;
    unsigned voffA[2], voffB[2];
#pragma unroll
    for (int i = 0; i < 2; ++i) { int R, C; stage_rc(tid * 16 + i * 8192, R, C); const int Rb = Epi::PERM ? ((R & ~31) + perm32(R & 31)) : R;
        voffA[i] = (unsigned)(R * ld + C) * 2u; voffB[i] = (unsigned)(Rb * ld + C) * 2u; }
    const size_t kstep = (size_t)(BK * 2);
    const size_t hstep = (size_t)HALF * ld * 2;
    const size_t tstep = 2 * hstep;
    const unsigned ldsw = (unsigned)wid * 1024u;
    const int aoff = lds_byte(wr * 64 + fr, fq * 8), boff = lds_byte(wc * 32 + fr, fq * 8);
#define PG8_SA(b, h) (((b) * 2 + (h)) * HTB)
#define PG8_SB(b, h) ((4 + (b) * 2 + (h)) * HTB)
#define PG8_STAGE(bufoff, gbase, voff) do { _Pragma("unroll") for (int _i = 0; _i < 2; ++_i) \
        __builtin_amdgcn_global_load_lds((const unsigned*)((const char*)(gbase) + (voff)[_i]), (PG8_LAS unsigned*)(lds + (bufoff) + ldsw + _i * 8192), 16, 0, 0); } while (0)
#define PG8_LDA(dst, b, h) do { _Pragma("unroll") for (int m = 0; m < 4; ++m) _Pragma("unroll") for (int k = 0; k < 2; ++k) dst[m][k] = *(const PG8_LAS bf16x8*)(lds + PG8_SA(b, h) + aoff + m * 2048 + k * 1024); } while (0)
#define PG8_LDB(dst, b, h) do { _Pragma("unroll") for (int n = 0; n < 2; ++n) _Pragma("unroll") for (int k = 0; k < 2; ++k) dst[n][k] = *(const PG8_LAS bf16x8*)(lds + PG8_SB(b, h) + boff + n * 2048 + k * 1024); } while (0)
#define PG8_MMA(ai, bj, At, Bt) do { __builtin_amdgcn_s_setprio(1); _Pragma("unroll") for (int m = 0; m < 4; ++m) _Pragma("unroll") for (int n = 0; n < 2; ++n) _Pragma("unroll") for (int k = 0; k < 2; ++k) \
        acc[ai][bj][m][n] = __builtin_amdgcn_mfma_f32_16x16x32_bf16(Bt[n][k], At[m][k], acc[ai][bj][m][n], 0, 0, 0); __builtin_amdgcn_s_setprio(0); } while (0)
#define PG8_WAIT_V(n) asm volatile("s_waitcnt vmcnt(" #n ")" ::: "memory")
#define PG8_WAIT_L(n) asm volatile("s_waitcnt lgkmcnt(" #n ")" ::: "memory")
#define PG8_BAR __builtin_amdgcn_s_barrier()
#define PG8_SCHED __builtin_amdgcn_sched_barrier(0)
    Unit cur, nxt; int ui = 0;
    if (!S.next(0, cur)) return;
    f32x4 acc[2][2][4][2];
    float zf_ = 0.f; asm volatile("" : "+v"(zf_));
#pragma unroll
    for (int a = 0; a < 2; ++a)
#pragma unroll
        for (int b = 0; b < 2; ++b)
#pragma unroll
            for (int m = 0; m < 4; ++m)
#pragma unroll
                for (int n = 0; n < 2; ++n) acc[a][b][m][n] = (f32x4){zf_, zf_, zf_, zf_};
    bf16x8 At[4][2], B0[2][2], B1[2][2];
    const char* cA = (const char*)g.A + (size_t)cur.pm * tstep + (size_t)cur.koff * 2; const char* cB = (const char*)g.Bt + (size_t)cur.pn * tstep + (size_t)cur.koff * 2;
    S.a_ready(cur);
    if constexpr (SP2) {
        PG8_STAGE(PG8_SB(0, 0), cB, voffB); PG8_STAGE(PG8_SB(0, 1), cB + hstep, voffB); PG8_STAGE(PG8_SA(0, 0), cA, voffA); PG8_STAGE(PG8_SA(0, 1), cA + hstep, voffA);
        if (wr == 1) PG8_BAR;
        PG8_WAIT_V(2); PG8_BAR;
        PG8_STAGE(PG8_SB(1, 0), cB + kstep, voffB); PG8_STAGE(PG8_SA(1, 0), cA + kstep, voffA); PG8_STAGE(PG8_SB(1, 1), cB + hstep + kstep, voffB);
        PG8_WAIT_V(6); PG8_BAR;
    } else {
        PG8_STAGE(PG8_SB(0, 0), cB, voffB); PG8_STAGE(PG8_SA(0, 0), cA, voffA); PG8_STAGE(PG8_SB(0, 1), cB + hstep, voffB); PG8_STAGE(PG8_SA(0, 1), cA + hstep, voffA);
        if (wr == 1) PG8_BAR;
        PG8_WAIT_V(4); PG8_BAR;
        PG8_STAGE(PG8_SB(1, 0), cB + kstep, voffB); PG8_STAGE(PG8_SA(1, 0), cA + kstep, voffA); PG8_STAGE(PG8_SB(1, 1), cB + hstep + kstep, voffB);
        PG8_WAIT_V(6); PG8_BAR;
    }
    for (;;) {
        const bool has_next = S.next(ui + 1, nxt);
        const char* nA = has_next ? (const char*)g.A + (size_t)nxt.pm * tstep + (size_t)nxt.koff * 2 : cA; const char* nB = has_next ? (const char*)g.Bt + (size_t)nxt.pn * tstep + (size_t)nxt.koff * 2 : cB;
        for (int t = 0; t < nt; t += 2) {
            const bool last = (t == nt - 2);
            const char* a1 = cA + (size_t)(t + 1) * kstep;
            const char* a2 = last ? nA : cA + (size_t)(t + 2) * kstep; const char* b2 = last ? nB : cB + (size_t)(t + 2) * kstep;
            const char* a3 = a2 + kstep; const char* b3 = b2 + kstep;
            if (last && has_next) S.a_ready(nxt);
            if constexpr (SP2) {
            PG8_LDB(B0, 0, 0); PG8_LDB(B1, 0, 1); PG8_SCHED; PG8_LDA(At, 0, 0); PG8_STAGE(PG8_SA(1, 1), a1 + hstep, voffA);
            PG8_WAIT_V(8); PG8_WAIT_L(0); PG8_BAR; PG8_MMA(0, 0, At, B0); PG8_MMA(0, 1, At, B1); PG8_BAR; PG8_SCHED;
            PG8_LDA(At, 0, 1); PG8_STAGE(PG8_SB(0, 0), b2, voffB); PG8_STAGE(PG8_SB(0, 1), b2 + hstep, voffB); PG8_STAGE(PG8_SA(0, 0), a2, voffA);
            PG8_WAIT_V(8); PG8_WAIT_L(0); PG8_BAR; PG8_MMA(1, 0, At, B0); PG8_MMA(1, 1, At, B1); PG8_BAR; PG8_SCHED;
            PG8_LDB(B0, 1, 0); PG8_LDB(B1, 1, 1); PG8_SCHED; PG8_LDA(At, 1, 0); PG8_STAGE(PG8_SA(0, 1), a2 + hstep, voffA);
            PG8_WAIT_V(8); PG8_WAIT_L(0); PG8_BAR; PG8_MMA(0, 0, At, B0); PG8_MMA(0, 1, At, B1); PG8_BAR; PG8_SCHED;
            PG8_LDA(At, 1, 1); PG8_STAGE(PG8_SB(1, 0), b3, voffB); PG8_STAGE(PG8_SB(1, 1), b3 + hstep, voffB); PG8_STAGE(PG8_SA(1, 0), a3, voffA);
            PG8_WAIT_V(8); PG8_WAIT_L(0); PG8_BAR; PG8_MMA(1, 0, At, B0); PG8_MMA(1, 1, At, B1); PG8_BAR; PG8_SCHED;
            } else {
            PG8_LDB(B0, 0, 0); PG8_SCHED; PG8_LDA(At, 0, 0); PG8_STAGE(PG8_SA(1, 1), a1 + hstep, voffA);
            PG8_WAIT_L(8); PG8_BAR; PG8_WAIT_L(0); PG8_MMA(0, 0, At, B0); PG8_BAR; PG8_SCHED;
            PG8_LDB(B1, 0, 1); PG8_STAGE(PG8_SB(0, 0), b2, voffB);
            PG8_BAR; PG8_WAIT_L(0); PG8_MMA(0, 1, At, B1); PG8_BAR;
            PG8_LDA(At, 0, 1); PG8_STAGE(PG8_SA(0, 0), a2, voffA);
            PG8_BAR; PG8_WAIT_L(0); PG8_MMA(1, 0, At, B0); PG8_BAR; PG8_SCHED;
            PG8_STAGE(PG8_SB(0, 1), b2 + hstep, voffB);
            PG8_WAIT_V(6); PG8_BAR; PG8_MMA(1, 1, At, B1); PG8_BAR;
            PG8_LDB(B0, 1, 0); PG8_SCHED; PG8_LDA(At, 1, 0); PG8_STAGE(PG8_SA(0, 1), a2 + hstep, voffA);
            PG8_WAIT_L(8); PG8_BAR; PG8_WAIT_L(0); PG8_MMA(0, 0, At, B0); PG8_BAR; PG8_SCHED;
            PG8_LDB(B1, 1, 1); PG8_STAGE(PG8_SB(1, 0), b3, voffB);
            PG8_BAR; PG8_WAIT_L(0); PG8_MMA(0, 1, At, B1); PG8_BAR;
            PG8_LDA(At, 1, 1); PG8_STAGE(PG8_SA(1, 0), a3, voffA);
            PG8_BAR; PG8_WAIT_L(0); PG8_MMA(1, 0, At, B0); PG8_BAR; PG8_SCHED;
            PG8_STAGE(PG8_SB(1, 1), b3 + hstep, voffB);
            PG8_WAIT_V(6); PG8_BAR; PG8_MMA(1, 1, At, B1); PG8_BAR;
            }
        }
        if constexpr (ALIGN_EPI) { if (wr == 0) PG8_BAR; }
        if constexpr (!Epi::AFTER_DRAIN) { const int ln_ = lane_fresh(); const int fr_ = ln_ & 15, fq_ = ln_ >> 4;
            E(acc, cur, wr, wc, fr_, fq_); S.done(cur); }
        if (!has_next) break;
        float zg_ = 0.f; asm volatile("" : "+v"(zg_));
#pragma unroll
        for (int a = 0; a < 2; ++a)
#pragma unroll
            for (int b = 0; b < 2; ++b)
#pragma unroll
                for (int m = 0; m < 4; ++m)
#pragma unroll
                    for (int n = 0; n < 2; ++n) acc[a][b][m][n] = (f32x4){zg_, zg_, zg_, zg_};
        cur = nxt; cA = nA; cB = nB; ++ui;
        if constexpr (ALIGN_EPI) { if (wr == 1) PG8_BAR; }
    }
    PG8_WAIT_V(0);
    if constexpr (!ALIGN_EPI) { if (wr == 0) PG8_BAR; }
    PG8_BAR;
    if constexpr (Epi::AFTER_DRAIN) { E.fused(acc, cur, wr, wc, fr, fq, lds, wid, lane); S.done(cur); }
#undef PG8_SA
#undef PG8_SB
#undef PG8_STAGE
#undef PG8_LDA
#undef PG8_LDB
#undef PG8_MMA
#undef PG8_WAIT_V
#undef PG8_WAIT_L
#undef PG8_BAR
#undef PG8_SCHED
}
}
#define GAS __attribute__((address_space(1)))
#define LAS __attribute__((address_space(3)))
typedef unsigned short bf16;
typedef unsigned v4u __attribute__((ext_vector_type(4)));
typedef float f32x4 __attribute__((ext_vector_type(4)));
typedef short bf16x8 __attribute__((ext_vector_type(8)));
typedef GAS unsigned gu32;
typedef GAS unsigned long long gu64;
#define RLX_AGENT __ATOMIC_RELAXED, __HIP_MEMORY_SCOPE_AGENT
#define LDS_WAIT() asm volatile("s_waitcnt lgkmcnt(0)" ::: "memory")
#define VM_WAIT() asm volatile("s_waitcnt vmcnt(0)" ::: "memory")
__device__ __forceinline__ unsigned long long rt() { return __builtin_amdgcn_s_memrealtime(); }
__device__ __forceinline__ unsigned f2bf(float f) { unsigned u = __builtin_bit_cast(unsigned, f); return (u + 0x7fffu + ((u >> 16) & 1u)) >> 16; }
__device__ __forceinline__ unsigned pk2(float lo, float hi) { return f2bf(lo) | (f2bf(hi) << 16); }

#define XB_TMO      128
#define XB_XCNT(j)  (256  + 64 * (j))
#define XB_XSUB(j)  (1280 + 64 * (j))
#define XB_XGEN(j)  (2304 + 64 * (j))
#define XB_TOP      3328
#define XB_TOPGEN   3392
#define XCD_BAR_WORDS 3456
#define XB_SPIN_CAP (1u << 18)

__device__ __forceinline__ unsigned xb_ld(unsigned* p)              { return __hip_atomic_load(p, __ATOMIC_RELAXED, __HIP_MEMORY_SCOPE_AGENT); }
__device__ __forceinline__ unsigned xb_add(unsigned* p, unsigned v) { return __hip_atomic_fetch_add(p, v, __ATOMIC_RELAXED, __HIP_MEMORY_SCOPE_AGENT); }
__device__ __forceinline__ unsigned xb_xcc_id() { return (unsigned)__builtin_amdgcn_s_getreg((3 << 11) | 20) & 0xFu; }
#define XB_SPIN(cond, bar) do { unsigned _sp = 0; while (cond) { __builtin_amdgcn_s_sleep(1); \
    if ((++_sp & 255u) == 0u) { if (xb_ld(&(bar)[XB_TMO])) break; if (_sp > XB_SPIN_CAP) { atomicAdd(&(bar)[XB_TMO], 1u); break; } } } } while (0)

struct XcdBarrier {
    unsigned* bar; unsigned x;
    volatile LAS unsigned* st;
};

__device__ __forceinline__ XcdBarrier xcd_barrier_post(unsigned* bar, volatile LAS unsigned* st, const bool is_t0) {
    XcdBarrier b; b.bar = bar; b.x = xb_xcc_id(); b.st = st;
    if (is_t0) (void)xb_add(&bar[XB_XCNT(b.x)], 1u);
    return b;
}
__device__ __forceinline__ void xcd_barrier_complete(unsigned* bar, unsigned x, unsigned& nloc, unsigned& nx) {
    const unsigned G = gridDim.x * gridDim.y * gridDim.z;
    unsigned sum, cnt, mine, sp = 0u;
    for (;;) {
        sum = 0u; cnt = 0u; mine = 0u;
#pragma unroll
        for (unsigned j = 0; j < 16; ++j) { const unsigned c = xb_ld(&bar[XB_XCNT(j)]); sum += c; cnt += (c > 0u) ? 1u : 0u; mine = (j == x) ? c : mine; }
        if (sum == G) break;
        __builtin_amdgcn_s_sleep(1);
        if ((++sp & 255u) == 0u) { if (xb_ld(&bar[XB_TMO])) break; if (sp > XB_SPIN_CAP) { atomicAdd(&bar[XB_TMO], 1u); break; } }
    }
    nloc = mine > 0u ? mine : 1u; nx = cnt > 0u ? cnt : 1u;
}

__device__ __forceinline__ void xcd_barrier(const XcdBarrier& b, const bool is_t0) {
    asm volatile("s_waitcnt vmcnt(0)" ::: "memory");
    __syncthreads();
    if (is_t0) {
        unsigned* bar = b.bar;
        __builtin_amdgcn_s_waitcnt(0);
        unsigned nloc = b.st[0], nx = b.st[1];
        if (nloc == 0u) { xcd_barrier_complete(bar, b.x, nloc, nx); b.st[0] = nloc; b.st[1] = nx; }
        const unsigned old = xb_add(&bar[XB_XSUB(b.x)], 1u);
        const unsigned gen = old / nloc;
        if (old + 1u == (gen + 1u) * nloc) {
            __builtin_amdgcn_fence(__ATOMIC_RELEASE, "agent");
            asm volatile("s_waitcnt vmcnt(0)" ::: "memory");
            const unsigned og = xb_add(&bar[XB_TOP], 1u);
            const unsigned tg = og / nx;
            if (og + 1u == (tg + 1u) * nx) xb_add(&bar[XB_TOPGEN], 1u);
            else XB_SPIN(xb_ld(&bar[XB_TOPGEN]) == tg, bar);
            __builtin_amdgcn_fence(__ATOMIC_ACQUIRE, "agent");
            xb_add(&bar[XB_XGEN(b.x)], 1u);
            asm volatile("s_waitcnt vmcnt(0)" ::: "memory");
        } else {
            XB_SPIN(xb_ld(&bar[XB_XGEN(b.x)]) == gen, bar);
            __builtin_amdgcn_fence(__ATOMIC_ACQUIRE, "agent");
            asm volatile("s_waitcnt vmcnt(0)" ::: "memory");
        }
    }
    __syncthreads();
}

constexpr size_t MiB = 1u << 20;
constexpr size_t WS_CTL = 0, CTL_ZERO_BYTES = 64 * 1024;
constexpr int CW_BAR = 1024;
constexpr int CW_Q = 8192;
constexpr size_t WS_COS = 1 * MiB;
constexpr size_t WS_SIN = WS_COS + 512 * 1024;
constexpr size_t WS_WIN  = 2 * MiB;
constexpr size_t WS_WOC  = WS_WIN + 16 * MiB;
constexpr size_t WS_WA0  = WS_WOC + 4 * MiB;
constexpr size_t WS_WA1  = WS_WA0 + 4 * MiB;
constexpr size_t WS_WUKV = WS_WA1 + 3 * MiB;
constexpr size_t WS_WUQ  = WS_WUKV + 1 * MiB;
constexpr size_t WS_WOM  = WS_WUQ + 3 * MiB;
constexpr size_t WS_WUKB = WS_WOM + 4 * MiB;
constexpr size_t WS_ACT  = 40 * MiB;
constexpr size_t SZ_F32R = (size_t)NROWS * 1024 * 4, SZ_BFR = (size_t)NROWS * 1024 * 2;
constexpr size_t WS_X    = WS_ACT;
constexpr size_t WS_XH   = WS_X + SZ_F32R;
constexpr size_t WS_V1   = WS_XH + SZ_BFR;
constexpr size_t WS_GZ   = WS_V1 + SZ_BFR;
constexpr size_t WS_G    = WS_GZ + SZ_BFR;
constexpr size_t WS_MB   = WS_G + SZ_BFR;
constexpr size_t WS_CKR  = WS_MB + SZ_BFR;
constexpr size_t WS_CB   = WS_CKR + (size_t)NROWS * 512 * 4;
constexpr size_t WS_KRB  = WS_CB + (size_t)NROWS * 256 * 2;
constexpr size_t WS_KN   = WS_KRB + (size_t)NROWS * 32 * 2;
constexpr size_t WS_VV   = WS_KN + SZ_BFR;
constexpr size_t WS_QL   = WS_VV + SZ_BFR;
constexpr size_t WS_SSQ  = WS_QL + (size_t)NROWS * 512 * 2;
constexpr size_t WS_SZ   = WS_SSQ + (size_t)NROWS * 8 * 4;
constexpr size_t WS_QN   = WS_SZ + SZ_BFR;
constexpr size_t WS_QR   = WS_QN + SZ_BFR;
constexpr size_t WS_OG   = WS_QR + (size_t)NROWS * 512 * 2;
constexpr size_t WS_PART = WS_OG + SZ_BFR;
constexpr size_t WS_PML  = WS_PART + (size_t)DECB * 4 * 64 * 256 * 4;
constexpr size_t WS_QABS = WS_PML + (size_t)DECB * 4 * 2 * 64 * 4;
constexpr int GOUT_SPLITK = 8;
constexpr size_t WS_PARTG = WS_QABS + (size_t)DECB * 64 * 288 * 2;
constexpr size_t WS_END  = WS_PARTG + (size_t)GOUT_SPLITK * 768 * 1024 * 4;
static_assert(WS_WUKB + 1 * MiB <= WS_ACT && WS_END < 1024 * MiB, "d_ws map");

constexpr size_t O_YP = 0, O_YS = O_YP + (size_t)NB * SEQ * DM, O_CKP = O_YS + (size_t)NSAMP * DM, O_KRP = O_CKP + (size_t)NB * TTOT * KVL,
                 O_CVP = O_KRP + (size_t)NB * TTOT * QKR, O_CKS = O_CVP + (size_t)2 * NB * 2 * DM, O_KRS = O_CKS + (size_t)NSAMP * KVL,
                 O_CVS = O_KRS + (size_t)NSAMP * QKR, O_END = O_CVS + (size_t)2 * DECB * 2 * DM;

#ifndef TAIL_CONV
#define TAIL_CONV 1
#endif
constexpr size_t WS_RS = WS_XH;
constexpr int RING_BYTES = 131072;
constexpr int LDS_BYTES = 163840;
constexpr int LDSCTL_OFF = LDS_BYTES - 64;
constexpr int NWAVES = 8;

struct Args {
    const float* x_prompt; const float* x_sample; const float* cache_ckv; const float* cache_krope; const float* state_conv; const int* page_table;
    const float* meta; const float* pre_g; const float* post_g; const float* w_in_conv; const float* conv_w; const float* w_out_conv;
    const float* kv_norm_g; const float* w_dkv; const float* kv_lat_g; const float* w_uk; const float* w_uv; const float* w_in_mla;
    const float* q_norm_g; const float* w_uq; const float* w_out_mla;
    float* out; unsigned char* ws;
};

typedef unsigned short bf16;
typedef short bf16x8 __attribute__((ext_vector_type(8)));
typedef float f32x4 __attribute__((ext_vector_type(4)));
typedef float f32x8 __attribute__((ext_vector_type(8)));
typedef float f32x16 __attribute__((ext_vector_type(16)));
typedef unsigned u32x4 __attribute__((ext_vector_type(4)));
typedef unsigned u32x2 __attribute__((ext_vector_type(2)));
typedef short s16x4 __attribute__((ext_vector_type(4)));
#define LDS_WAIT() asm volatile("s_waitcnt lgkmcnt(0)" ::: "memory")
#define VM_WAIT() asm volatile("s_waitcnt vmcnt(0)" ::: "memory")
#define SBAR() __builtin_amdgcn_sched_barrier(0)
typedef float f32x2_t __attribute__((ext_vector_type(2))); typedef __bf16 bf16x2_t __attribute__((ext_vector_type(2)));
__device__ __forceinline__ unsigned cvtpk(float lo, float hi) { f32x2_t v = {lo, hi}; bf16x2_t b = __builtin_convertvector(v, bf16x2_t); return __builtin_bit_cast(unsigned, b); }
__device__ __forceinline__ float bf2f(unsigned short b) { return __uint_as_float((unsigned)b << 16); }
__device__ __forceinline__ float bflo(unsigned w) { return __uint_as_float(w << 16); }
__device__ __forceinline__ float bfhi(unsigned w) { return __uint_as_float(w & 0xffff0000u); }
__device__ __forceinline__ float wave_sum(float v, int lane) {
#pragma unroll
    for (int o = 1; o < 64; o <<= 1) v += shfl_xor_f(v, o, lane);
    return v;
}

template <class DestRow>
__device__ __forceinline__ void transpose_item(const float* __restrict__ W, int K, int N, const float* __restrict__ gain, bf16* WT, const DestRow& dest, LAS float* scr, int item, int lane) {
    const int nblk = N / 32, kb = item / nblk, nb = item % nblk, k0 = 64 * kb, n0 = 32 * nb;
#pragma unroll 8
    for (int i = 0; i < 32; ++i) { const int kk = 2 * i + (lane >> 5); float w = W[(size_t)(k0 + kk) * N + n0 + (lane & 31)]; if (gain) w *= gain[k0 + kk]; scr[kk * 33 + (lane & 31)] = w; }
    LDS_WAIT(); asm volatile("" ::: "memory");
    const int c = lane & 7;
#pragma unroll
    for (int j = 0; j < 4; ++j) { const int n = (lane >> 3) + 8 * j; const LAS float* s = scr + (8 * c) * 33 + n;
        u32x4 o; o.x = cvtpk(s[0 * 33], s[1 * 33]); o.y = cvtpk(s[2 * 33], s[3 * 33]); o.z = cvtpk(s[4 * 33], s[5 * 33]); o.w = cvtpk(s[6 * 33], s[7 * 33]);
        *(u32x4*)(WT + (size_t)dest(n0 + n) * K + k0 + 8 * c) = o; }
    LDS_WAIT(); asm volatile("" ::: "memory");
}
struct DestIdent { int off; __device__ __forceinline__ int operator()(int n) const { return off + n; } };
struct DestConvIn {
    __device__ __forceinline__ int operator()(int n) const { const int p = n >> 10, ch = n & 1023, cl = ch & 63; return (ch >> 6) * 256 + (p >> 1) * 128 + (cl >> 4) * 32 + ((cl >> 2) & 3) * 8 + (p & 1) * 4 + (cl & 3); } };
struct DestUq {
    __device__ __forceinline__ int operator()(int n) const { const int h = n / 96, t = n - h * 96; if (t < 64) return h * 64 + t; const int el = t - 64, i = el & 15;
        return 1024 + (h >> 3) * 256 + ((h & 7) >> 2) * 128 + (h & 3) * 32 + (i >> 2) * 8 + (el >> 4) * 4 + (i & 3); } };

__device__ __forceinline__ void x_row_store(const f32x4 (&v)[4], bf16* xrow, float* rs, int lane) {
    float s = 0.f;
#pragma unroll
    for (int j = 0; j < 4; ++j) s += (v[j].x * v[j].x + v[j].y * v[j].y) + (v[j].z * v[j].z + v[j].w * v[j].w);
    const float r = 1.0f / sqrtf(wave_sum(s, lane) * (1.0f / 1024.0f) + RMS_EPS);
    u32x2* o8 = (u32x2*)xrow + lane;
#pragma unroll
    for (int j = 0; j < 4; ++j) { u32x2 w; w.x = cvtpk(v[j].x, v[j].y); w.y = cvtpk(v[j].z, v[j].w); o8[64 * j] = w; }
    if (lane == 0) *rs = r;
}

template <class DestRow>
__device__ __forceinline__ void transpose_item64(const float* __restrict__ W, int K, int N, const float* __restrict__ gain, bf16* WT, const DestRow& dest, LAS float* scr, int item, int lane) {
    const int nblk = N / 64, kb = item / nblk, nb = item % nblk, k0 = 64 * kb, n0 = 64 * nb;
    float wv[64];
#pragma unroll
    for (int i = 0; i < 64; ++i) wv[i] = W[(size_t)(k0 + i) * N + n0 + lane];
#pragma unroll
    for (int i = 0; i < 64; ++i) { float w = wv[i]; if (gain) w *= gain[k0 + i]; scr[i * 65 + lane] = w; }
    LDS_WAIT(); asm volatile("" ::: "memory");
#pragma unroll
    for (int jj = 0; jj < 8; ++jj) { const int p = lane + 64 * jj, n = p >> 3, c = p & 7; const LAS float* s = scr + (8 * c) * 65 + n;
        u32x4 o; o.x = cvtpk(s[0 * 65], s[1 * 65]); o.y = cvtpk(s[2 * 65], s[3 * 65]); o.z = cvtpk(s[4 * 65], s[5 * 65]); o.w = cvtpk(s[6 * 65], s[7 * 65]);
        *(u32x4*)(WT + (size_t)dest(n0 + n) * K + k0 + 8 * c) = o; }
    LDS_WAIT(); asm volatile("" ::: "memory");
}
__device__ __forceinline__ void convert_set(const Args& A, const int set, LAS unsigned char* lds, int iw, int nw, int wave, int lane) {
    unsigned char* ws = A.ws;
    LAS float* scr = (LAS float*)(lds + wave * 16640);
    constexpr int I_WIN = 16 * 64, I_SQ = 16 * 16, I_DKV = (1024 / 64) * (288 / 32), I_INM = 16 * 24, I_UKV = 4 * 16, I_UQ = 8 * 24;
    if (set == 0 || set == 1) { const int l = set;
        for (int it = iw; it < I_WIN + I_SQ; it += nw) {
            if (it < I_WIN) transpose_item64(A.w_in_conv + (size_t)l * 1024 * 4096, 1024, 4096, A.pre_g + l * 1024, (bf16*)(ws + WS_WIN) + (size_t)l * 4096 * 1024, DestConvIn{}, scr, it, lane);
            else transpose_item64(A.w_out_conv + (size_t)l * 1024 * 1024, 1024, 1024, nullptr, (bf16*)(ws + WS_WOC) + (size_t)l * 1024 * 1024, DestIdent{0}, scr, it - I_WIN, lane); }
    } else if (set == 2) {
        for (int it = iw; it < I_DKV + 2 * I_INM; it += nw) {
            if (it < I_DKV) transpose_item(A.w_dkv, 1024, 288, A.kv_norm_g, (bf16*)(ws + WS_WA0), DestIdent{0}, scr, it, lane);
            else { const int r = it - I_DKV, j = r / I_INM; transpose_item64(A.w_in_mla + (size_t)j * 1024 * 1536, 1024, 1536, A.pre_g + (2 + j) * 1024, (bf16*)(ws + (j ? WS_WA1 : WS_WA0)), DestIdent{j ? 0 : 512}, scr, r % I_INM, lane); } }
        { unsigned z_ = 0u; asm volatile("" : "+v"(z_));
          for (int i = iw * 64 + lane; i < 224 * 128; i += nw * 64) ((u32x4*)((bf16*)(ws + WS_WA0) + 288 * 1024))[i] = (u32x4){z_, z_, z_, z_}; }
    } else if (set == 3) {
        for (int it = iw; it < 2 * I_UKV + 2 * I_UQ; it += nw) {
            if (it < 2 * I_UKV) { const int j = it / I_UKV; transpose_item64(j ? A.w_uv : A.w_uk, 256, 1024, nullptr, (bf16*)(ws + WS_WUKV), DestIdent{j * 1024}, scr, it % I_UKV, lane); }
            else { const int r = it - 2 * I_UKV, j = r / I_UQ; transpose_item64(A.w_uq + (size_t)j * 512 * 1536, 512, 1536, A.q_norm_g + j * 512, (bf16*)(ws + WS_WUQ) + (size_t)j * 1536 * 512, DestUq{}, scr, r % I_UQ, lane); } }
        for (int i = iw * 64 + lane; i < 256 * 1024 / 8; i += nw * 64) { const f32x4 a = ((const f32x4*)A.w_uk)[2 * i], b = ((const f32x4*)A.w_uk)[2 * i + 1];
            u32x4 w; w.x = cvtpk(a.x, a.y); w.y = cvtpk(a.z, a.w); w.z = cvtpk(b.x, b.y); w.w = cvtpk(b.z, b.w); ((u32x4*)(ws + WS_WUKB))[i] = w; }
    } else {
        for (int it = iw; it < 2 * I_SQ; it += nw) { const int j = it / I_SQ; transpose_item64(A.w_out_mla + (size_t)j * 1024 * 1024, 1024, 1024, nullptr, (bf16*)(ws + WS_WOM) + (size_t)j * 1024 * 1024, DestIdent{0}, scr, it % I_SQ, lane); }
    }
}

__device__ __forceinline__ void p0_prologue(const Args& A, LAS unsigned char* lds, int gw, int NGW, int wave, int lane) {
    unsigned char* ws = A.ws;
    convert_set(A, 0, lds, gw, NGW, wave, lane);
#if !TAIL_CONV
    convert_set(A, 1, lds, gw, NGW, wave, lane); convert_set(A, 2, lds, gw, NGW, wave, lane); convert_set(A, 3, lds, gw, NGW, wave, lane); convert_set(A, 4, lds, gw, NGW, wave, lane);
#endif
    for (int i = gw * 64 + lane; i < NPOS * 16; i += NGW * 64) { const int p = i >> 4, e = i & 15; const float pos = (float)(p < TTOT ? p : PAST + (p - TTOT));
        const float inv = powf(10000.0f, -(float)e / 16.0f); const float ang = pos * inv; ((float*)(ws + WS_COS))[i] = cosf(ang); ((float*)(ws + WS_SIN))[i] = sinf(ang); }
    for (int row0 = gw; row0 < NROWS; row0 += 4 * NGW) {
        f32x4 v[4][4];
#pragma unroll
        for (int k = 0; k < 4; ++k) { const int row = row0 + k * NGW < NROWS ? row0 + k * NGW : row0;
            const float* src = row < NMAIN ? A.x_prompt + (size_t)row * 1024 : (row < META0 ? A.x_sample + (size_t)(row - SAMP0) * 1024 : (row < META0 + NMETA ? A.meta + (size_t)(row - META0) * 1024 : nullptr));
#pragma unroll
            for (int j = 0; j < 4; ++j) v[k][j] = src ? ((const f32x4*)src)[lane + 64 * j] : (f32x4){0.f, 0.f, 0.f, 0.f}; }
#pragma unroll
        for (int k = 0; k < 4; ++k) { const int row = row0 + k * NGW; if (row < NROWS) {
            x_row_store(v[k], (bf16*)(ws + WS_X) + (size_t)row * 1024, (float*)(ws + WS_RS) + row, lane); } }
    }
}

__device__ __forceinline__ void conv_phase(const Args& A, int layer, int gw, int NGW, int lane) {
    unsigned char* ws = A.ws; const bf16* V = (const bf16*)(ws + WS_V1); const bf16* GZ = (const bf16*)(ws + WS_GZ); bf16* G = (bf16*)(ws + WS_G);
    const float* cw = A.conv_w + (size_t)layer * 3 * 1024;
    const int c0 = (gw & 1) * 512 + lane * 8, gr = gw >> 1, NGR = NGW >> 1;
    float w0[8], w1[8], w2[8];
#pragma unroll
    for (int k = 0; k < 2; ++k) { const f32x4 t0 = *(const f32x4*)(cw + c0 + 4 * k), t1 = *(const f32x4*)(cw + 1024 + c0 + 4 * k), t2 = *(const f32x4*)(cw + 2048 + c0 + 4 * k);
#pragma unroll
        for (int e = 0; e < 4; ++e) { w0[4 * k + e] = t0[e]; w1[4 * k + e] = t1[e]; w2[4 * k + e] = t2[e]; } }
    for (int row0 = gr; row0 < NROWS; row0 += 4 * NGR) {
        u32x4 v0[4], gz[4]; float a1[4][8], a2[4][8];
#pragma unroll
        for (int q = 0; q < 4; ++q) { const int row = row0 + q * NGR < NROWS ? row0 + q * NGR : row0;
            int r1, r2; const float* s1 = nullptr; const float* s2 = nullptr;
            if (row < NMAIN) { const int i = row & (SEQ - 1); r1 = i >= 1 ? row - 1 : META0 + 15; r2 = i >= 2 ? row - 2 : META0 + 14 + i; }
            else if (row < META0) { const int s = row - SAMP0, b = s >> 2, l = s & 3; const float* st = A.state_conv + ((size_t)layer * DECB + b) * 2 * 1024;
                if (l >= 1) r1 = row - 1; else { r1 = -2; s1 = st + 1024; }
                if (l >= 2) r2 = row - 2; else { r2 = -2; s2 = st + l * 1024; } }
            else if (row < META0 + NMETA) { const int j = row - META0; r1 = j >= 1 ? row - 1 : -1; r2 = j >= 2 ? row - 2 : -1; }
            else { r1 = -1; r2 = -1; }
            v0[q] = *(const u32x4*)(V + (size_t)row * 1024 + c0); gz[q] = *(const u32x4*)(GZ + (size_t)row * 1024 + c0);
            if (r1 >= 0) { const u32x4 t = *(const u32x4*)(V + (size_t)r1 * 1024 + c0);
#pragma unroll
                for (int k = 0; k < 4; ++k) { a1[q][2 * k] = bflo(t[k]); a1[q][2 * k + 1] = bfhi(t[k]); } }
            else if (r1 == -2) { const f32x4 t0 = *(const f32x4*)(s1 + c0), t1 = *(const f32x4*)(s1 + c0 + 4);
#pragma unroll
                for (int k = 0; k < 4; ++k) { a1[q][k] = t0[k]; a1[q][4 + k] = t1[k]; } }
            else {
#pragma unroll
                for (int k = 0; k < 8; ++k) a1[q][k] = 0.f; }
            if (r2 >= 0) { const u32x4 t = *(const u32x4*)(V + (size_t)r2 * 1024 + c0);
#pragma unroll
                for (int k = 0; k < 4; ++k) { a2[q][2 * k] = bflo(t[k]); a2[q][2 * k + 1] = bfhi(t[k]); } }
            else if (r2 == -2) { const f32x4 t0 = *(const f32x4*)(s2 + c0), t1 = *(const f32x4*)(s2 + c0 + 4);
#pragma unroll
                for (int k = 0; k < 4; ++k) { a2[q][k] = t0[k]; a2[q][4 + k] = t1[k]; } }
            else {
#pragma unroll
                for (int k = 0; k < 8; ++k) a2[q][k] = 0.f; } }
#pragma unroll
        for (int q = 0; q < 4; ++q) { const int row = row0 + q * NGR; if (row < NROWS) {
            float vc[8], gg[8], o[8];
#pragma unroll
            for (int k = 0; k < 4; ++k) { vc[2 * k] = bflo(v0[q][k]); vc[2 * k + 1] = bfhi(v0[q][k]); gg[2 * k] = bflo(gz[q][k]); gg[2 * k + 1] = bfhi(gz[q][k]); }
#pragma unroll
            for (int k = 0; k < 8; ++k) o[k] = gg[k] * (w0[k] * a2[q][k] + w1[k] * a1[q][k] + w2[k] * vc[k]);
            u32x4 w; w.x = cvtpk(o[0], o[1]); w.y = cvtpk(o[2], o[3]); w.z = cvtpk(o[4], o[5]); w.w = cvtpk(o[6], o[7]);
            *(u32x4*)(G + (size_t)row * 1024 + c0) = w;
            float* dst = nullptr;
            if (row < NMAIN) { const int i = row & (SEQ - 1), b = row >> 12; if (i >= SEQ - 2) dst = A.out + O_CVP + (((size_t)layer * NB + b) * 2 + (i - (SEQ - 2))) * 1024; }
            else if (row < META0) { const int s = row - SAMP0, b = s >> 2, l = s & 3; if (l >= 2) dst = A.out + O_CVS + (((size_t)layer * DECB + b) * 2 + (l - 2)) * 1024; }
            if (dst) { *(f32x4*)(dst + c0) = (f32x4){vc[0], vc[1], vc[2], vc[3]}; *(f32x4*)(dst + c0 + 4) = (f32x4){vc[4], vc[5], vc[6], vc[7]}; }
        } }
    }
}

__device__ __forceinline__ void norm_row_finish(const Args& A, int layer, int row, const f32x4 (&m)[4], const u32x2 (&xw)[4], const f32x4 (&g)[4], int lane) {
    unsigned char* ws = A.ws; float s = 0.f;
#pragma unroll
    for (int j = 0; j < 4; ++j) s += (m[j].x * m[j].x + m[j].y * m[j].y) + (m[j].z * m[j].z + m[j].w * m[j].w);
    const float r = 1.0f / sqrtf(wave_sum(s, lane) * (1.0f / 1024.0f) + RMS_EPS);
    f32x4 xn[4];
#pragma unroll
    for (int j = 0; j < 4; ++j) xn[j] = (f32x4){bflo(xw[j].x), bfhi(xw[j].x), bflo(xw[j].y), bfhi(xw[j].y)} + m[j] * r * g[j];
    if (layer == 3) { if (row < META0) {
#pragma unroll
            for (int j = 0; j < 4; ++j) ((f32x4*)(A.out + (size_t)row * 1024))[lane + 64 * j] = xn[j]; } }
    else x_row_store(xn, (bf16*)(ws + WS_X) + (size_t)row * 1024, (float*)(ws + WS_RS) + row, lane);
}
__device__ __forceinline__ void norm_phase(const Args& A, int layer, int gw, int NGW, int lane) {
    unsigned char* ws = A.ws; const bf16* MB = (const bf16*)(ws + WS_MB); const bf16* X = (const bf16*)(ws + WS_X); const float* pg = A.post_g + (size_t)layer * 1024;
    f32x4 g[4];
#pragma unroll
    for (int j = 0; j < 4; ++j) g[j] = ((const f32x4*)pg)[lane + 64 * j];
    for (int row0 = gw; row0 < NMAIN; row0 += 8 * NGW) {
        u32x2 mw[8][4], xw[8][4];
#pragma unroll
        for (int k = 0; k < 8; ++k) { const int row = row0 + k * NGW < NMAIN ? row0 + k * NGW : row0;
#pragma unroll
            for (int j = 0; j < 4; ++j) { mw[k][j] = ((const u32x2*)(MB + (size_t)row * 1024))[lane + 64 * j]; xw[k][j] = ((const u32x2*)(X + (size_t)row * 1024))[lane + 64 * j]; } }
#pragma unroll
        for (int k = 0; k < 8; ++k) { const int row = row0 + k * NGW; if (row < NMAIN) {
            f32x4 m[4];
#pragma unroll
            for (int j = 0; j < 4; ++j) m[j] = (f32x4){bflo(mw[k][j].x), bfhi(mw[k][j].x), bflo(mw[k][j].y), bfhi(mw[k][j].y)};
            norm_row_finish(A, layer, row, m, xw[k], g, lane); } }
    }
    const float* PG = (const float*)(ws + WS_PARTG);
    for (int row = NMAIN + gw; row < NROWS; row += NGW) {
        u32x2 xw[4]; f32x4 m[4];
#pragma unroll
        for (int j = 0; j < 4; ++j) xw[j] = ((const u32x2*)(X + (size_t)row * 1024))[lane + 64 * j];
#pragma unroll
        for (int s2 = 0; s2 < GOUT_SPLITK; s2 += 2) { f32x4 t0[4], t1[4];
#pragma unroll
            for (int j = 0; j < 4; ++j) { t0[j] = ((const f32x4*)(PG + ((size_t)s2 * 768 + (row - NMAIN)) * 1024))[lane + 64 * j]; t1[j] = ((const f32x4*)(PG + ((size_t)(s2 + 1) * 768 + (row - NMAIN)) * 1024))[lane + 64 * j]; }
#pragma unroll
            for (int j = 0; j < 4; ++j) m[j] = s2 == 0 ? t0[j] + t1[j] : m[j] + (t0[j] + t1[j]); }
        norm_row_finish(A, layer, row, m, xw, g, lane);
    }
}

__device__ __forceinline__ void latent_phase(const Args& A, int gw, int NGW, int lane) {
    unsigned char* ws = A.ws; const float* CKR = (const float*)(ws + WS_CKR); bf16* CB = (bf16*)(ws + WS_CB); bf16* KRB = (bf16*)(ws + WS_KRB);
    const float* COS = (const float*)(ws + WS_COS); const float* SIN = (const float*)(ws + WS_SIN);
    const f32x4 g = ((const f32x4*)A.kv_lat_g)[lane];
    for (int row0 = gw; row0 < NROWS; row0 += 4 * NGW) {
        f32x4 cc[4]; float x1[4], x2[4], cs[4], sn[4];
#pragma unroll
        for (int k = 0; k < 4; ++k) { const int row = row0 + k * NGW < NROWS ? row0 + k * NGW : row0; const int pi = pg8::posidx_of_row(row); const int l16 = lane & 15;
            cc[k] = ((const f32x4*)(CKR + (size_t)row * 512))[lane]; x1[k] = CKR[(size_t)row * 512 + 256 + l16]; x2[k] = CKR[(size_t)row * 512 + 272 + l16]; cs[k] = COS[pi * 16 + l16]; sn[k] = SIN[pi * 16 + l16]; }
#pragma unroll
        for (int k = 0; k < 4; ++k) { const int row = row0 + k * NGW; if (row < NROWS) {
            const f32x4 c = cc[k];
            const float r = 1.0f / sqrtf(wave_sum((c.x * c.x + c.y * c.y) + (c.z * c.z + c.w * c.w), lane) * (1.0f / 256.0f) + RMS_EPS);
            const f32x4 cn = c * r * g;
            u32x2 w; w.x = cvtpk(cn.x, cn.y); w.y = cvtpk(cn.z, cn.w); ((u32x2*)(CB + (size_t)row * 256))[lane] = w;
            const float o1 = x1[k] * cs[k] - x2[k] * sn[k], o2 = x1[k] * sn[k] + x2[k] * cs[k];
            if (lane < 16) { KRB[(size_t)row * 32 + lane] = (bf16)(cvtpk(o1, o1) & 0xffffu); KRB[(size_t)row * 32 + 16 + lane] = (bf16)(cvtpk(o2, o2) & 0xffffu); }
            if (row < NMAIN) { const int b = row >> 12, i = row & (SEQ - 1); const size_t t = (size_t)b * TTOT + NMETA + i;
                ((f32x4*)(A.out + O_CKP + t * KVL))[lane] = cn; if (lane < 16) { A.out[O_KRP + t * QKR + lane] = o1; A.out[O_KRP + t * QKR + 16 + lane] = o2; } }
            else if (row < META0) { const size_t t = row - SAMP0; ((f32x4*)(A.out + O_CKS + t * KVL))[lane] = cn; if (lane < 16) { A.out[O_KRS + t * QKR + lane] = o1; A.out[O_KRS + t * QKR + 16 + lane] = o2; } }
            else if (row < META0 + NMETA) { const int j = row - META0;
#pragma unroll
                for (int b = 0; b < NB; ++b) { const size_t t = (size_t)b * TTOT + j; ((f32x4*)(A.out + O_CKP + t * KVL))[lane] = cn; if (lane < 16) { A.out[O_KRP + t * QKR + lane] = o1; A.out[O_KRP + t * QKR + 16 + lane] = o2; } } }
        } }
    }
}

namespace ap {
constexpr int NW = 8, QBLK = 32, KVBLK = 64;
constexpr int SHM_K = 64 * 256, SHM_V = 64 * 64 * 2;
constexpr int OFF_V = 0, OFF_K = 2 * SHM_V, OFF_WS = OFF_K + 2 * SHM_K, LDS_BYTES_AP = OFF_WS + NW * 64 * 4;
constexpr float THR = 8.0f;
#define KSWZ(row, colB) ((row) * 256 + ((colB) ^ (((row) & 7) << 4)))
__device__ __forceinline__ int crow(int r, int hi) { return (r & 3) + 8 * (r >> 2) + 4 * hi; }
__device__ __forceinline__ void partialSM(f32x16& p0, f32x16& p1, float& m_reg, float& mn, float& alpha) {
    float pmax = p0[0];
#pragma unroll
    for (int r = 1; r < 16; ++r) pmax = fmaxf(pmax, p0[r]);
#pragma unroll
    for (int r = 0; r < 16; ++r) pmax = fmaxf(pmax, p1[r]);
    { auto rr = __builtin_amdgcn_permlane32_swap(__float_as_uint(pmax), __float_as_uint(pmax), false, false); pmax = fmaxf(__uint_as_float(rr[0]), __uint_as_float(rr[1])); }
    if (__builtin_expect(__all(pmax - m_reg <= THR), 1)) { mn = m_reg; alpha = 1.f; }
    else { mn = fmaxf(m_reg, pmax); alpha = __builtin_amdgcn_exp2f(m_reg - mn); m_reg = mn; }
#pragma unroll
    for (int r = 0; r < 16; ++r) p0[r] = p0[r] - mn;
#pragma unroll
    for (int r = 0; r < 16; ++r) p1[r] = p1[r] - mn;
#pragma unroll
    for (int r = 0; r < 16; ++r) p0[r] = __builtin_amdgcn_exp2f(p0[r]);
}
__device__ __forceinline__ void finishSM(f32x16& p0, f32x16& p1, float alpha, float& l_reg, bf16x8& pa0, bf16x8& pa1, bf16x8& pa2, bf16x8& pa3) {
#pragma unroll
    for (int r = 0; r < 16; ++r) p1[r] = __builtin_amdgcn_exp2f(p1[r]);
    float ps = 0;
#pragma unroll
    for (int r = 0; r < 16; ++r) ps += p0[r];
#pragma unroll
    for (int r = 0; r < 16; ++r) ps += p1[r];
    { auto rr = __builtin_amdgcn_permlane32_swap(__float_as_uint(ps), __float_as_uint(ps), false, false); ps = __uint_as_float(rr[0]) + __uint_as_float(rr[1]); }
    l_reg = l_reg * alpha + ps;
#define PK4(P, BASE, OUT) do { unsigned a0 = cvtpk(P[BASE + 0], P[BASE + 1]), a1 = cvtpk(P[BASE + 2], P[BASE + 3]);   \
    unsigned b0 = cvtpk(P[BASE + 4], P[BASE + 5]), b1 = cvtpk(P[BASE + 6], P[BASE + 7]);                              \
    auto r0 = __builtin_amdgcn_permlane32_swap(a0, b0, false, false); auto r1 = __builtin_amdgcn_permlane32_swap(a1, b1, false, false); \
    u32x4 w = {r0[0], r1[0], r0[1], r1[1]}; OUT = *reinterpret_cast<bf16x8*>(&w); } while (0)
    PK4(p0, 0, pa0); PK4(p0, 8, pa1); PK4(p1, 0, pa2); PK4(p1, 8, pa3);
}
__device__ __forceinline__ void qkt(f32x16& p0, f32x16& p1, const char* Ks, const bf16x8* qr, int r32, int hi) {
    p0 = f32x16{}; p1 = f32x16{};
#pragma unroll
    for (int d0 = 0; d0 < 6; ++d0) { const int cb = (d0 * 16 + hi * 8) * 2;
        const bf16x8 b0 = *reinterpret_cast<const bf16x8*>(Ks + KSWZ(r32, cb));
        const bf16x8 b1 = *reinterpret_cast<const bf16x8*>(Ks + KSWZ(32 + r32, cb));
        p0 = __builtin_amdgcn_mfma_f32_32x32x16_bf16(b0, qr[d0], p0, 0, 0, 0);
        p1 = __builtin_amdgcn_mfma_f32_32x32x16_bf16(b1, qr[d0], p1, 0, 0, 0); }
}
__device__ __forceinline__ void mask_tile(f32x16& p0, f32x16& p1, int lim, int hi) {
#pragma unroll
    for (int r = 0; r < 16; ++r) { const int kv = crow(r, hi); if (kv > lim) p0[r] = -INFINITY; if (kv + 32 > lim) p1[r] = -INFINITY; }
}
__device__ __forceinline__ int v_st(int k, int c) { const int kk = (k & ~0xC) | ((k & 4) << 1) | ((k & 8) >> 1); return ((kk >> 3) * 2 + (c >> 5)) * 512 + ((kk & 7) * 32 + (c & 31)) * 2; }
__device__ __forceinline__ int v_rd_base(int lane) { return ((lane & 3) << 3) | (((lane >> 2) & 3) << 6) | (((lane >> 4) & 1) << 5) | (((lane >> 5) & 1) << 8); }
constexpr int v_rd_off(int d0, int ks, int half) { return d0 * 512 + ks * 2048 + half * 1024; }
template <int OFF> __device__ __forceinline__ s16x4 tr_read(int vb) { s16x4 r; asm volatile("ds_read_b64_tr_b16 %0, %1 offset:%2" : "=&v"(r) : "v"(vb), "i"(OFF) : "memory"); return r; }
template <int D0> __device__ __forceinline__ void pv_one(f32x16& od, int vb, bf16x8 pa0, bf16x8 pa1, bf16x8 pa2, bf16x8 pa3) {
    const s16x4 l0 = tr_read<v_rd_off(D0, 0, 0)>(vb), h0 = tr_read<v_rd_off(D0, 0, 1)>(vb), l1 = tr_read<v_rd_off(D0, 1, 0)>(vb), h1 = tr_read<v_rd_off(D0, 1, 1)>(vb);
    const s16x4 l2 = tr_read<v_rd_off(D0, 2, 0)>(vb), h2 = tr_read<v_rd_off(D0, 2, 1)>(vb), l3 = tr_read<v_rd_off(D0, 3, 0)>(vb), h3 = tr_read<v_rd_off(D0, 3, 1)>(vb);
    asm volatile("s_waitcnt lgkmcnt(0)" ::: "memory"); SBAR();
#define PKV(L, H) (bf16x8){L[0], L[1], L[2], L[3], H[0], H[1], H[2], H[3]}
    od = __builtin_amdgcn_mfma_f32_32x32x16_bf16(pa0, PKV(l0, h0), od, 0, 0, 0);
    od = __builtin_amdgcn_mfma_f32_32x32x16_bf16(pa1, PKV(l1, h1), od, 0, 0, 0);
    od = __builtin_amdgcn_mfma_f32_32x32x16_bf16(pa2, PKV(l2, h2), od, 0, 0, 0);
    od = __builtin_amdgcn_mfma_f32_32x32x16_bf16(pa3, PKV(l3, h3), od, 0, 0, 0);
}
__device__ __forceinline__ void pv_all(f32x16* o, int vb, bf16x8 pa0, bf16x8 pa1, bf16x8 pa2, bf16x8 pa3) { pv_one<0>(o[0], vb, pa0, pa1, pa2, pa3); pv_one<1>(o[1], vb, pa0, pa1, pa2, pa3); }

__device__ __forceinline__ void attn_unit(const bf16* __restrict__ QN, const bf16* __restrict__ QR, const bf16* __restrict__ KN, const bf16* __restrict__ KRB, const bf16* __restrict__ VV,
                                          const bf16* __restrict__ SZ, bf16* __restrict__ OG, int b, int h, int qb, bool meta, char* lds, const int wave) {
    const int lane = lane_fresh(), wid = wave, tid = wave * 64 + lane, r32 = lane & 31, hi = lane >> 5;
    char* V_lds = lds + OFF_V; char* K_lds = lds + OFF_K;
    float* wsf = (float*)(lds + OFF_WS) + wid * 64; float* li_l = wsf; float* al_l = wsf + 32;
    float m_reg = -1e30f, l_reg = 0; f32x16 o[2] = {}; bf16x8 qr[6];
    const int qrow0 = meta ? META0 : b * SEQ + qb * 256;
    const int qrow = qrow0 + wid * QBLK + r32;
    const int qloc = qb * 256 + wid * QBLK + r32;
#pragma unroll
    for (int d0 = 0; d0 < 4; ++d0) qr[d0] = *reinterpret_cast<const bf16x8*>(QN + (size_t)qrow * 1024 + h * 64 + d0 * 16 + hi * 8);
#pragma unroll
    for (int d0 = 0; d0 < 2; ++d0) qr[4 + d0] = *reinterpret_cast<const bf16x8*>(QR + (size_t)qrow * 512 + h * 32 + d0 * 16 + hi * 8);
    const int NT = meta ? 1 : 4 * qb + 5;
    const int sr = tid >> 3, sc = (tid & 7) * 8, rr = (tid & 255) >> 2, rc = (tid & 3) * 8;
    const int vst = v_st(sr, sc), kst = KSWZ(sr, sc * 2), rst = KSWZ(rr, 128 + rc * 2);
    const int vb0 = (int)(uintptr_t)V_lds + v_rd_base(lane);
    struct { bf16x8 kn, kr, vs; } st_[2];
#define TROW(t) ((t) == 0 ? META0 : b * SEQ + ((t) - 1) * KVBLK)
#define SLOAD(i, t) do { const int t_ = (t) < NT ? (t) : NT - 1; const int row0_ = TROW(t_); st_[i].kn = *reinterpret_cast<const bf16x8*>(KN + (size_t)(row0_ + sr) * 1024 + h * 64 + sc); \
    st_[i].vs = *reinterpret_cast<const bf16x8*>(VV + (size_t)(row0_ + sr) * 1024 + h * 64 + sc); st_[i].kr = *reinterpret_cast<const bf16x8*>(KRB + (size_t)(row0_ + rr) * 32 + rc); } while (0)
#define SWRITE(bf, i) do { *(bf16x8*)(V_lds + (bf) * SHM_V + vst) = st_[i].vs; *(bf16x8*)(K_lds + (bf) * SHM_K + kst) = st_[i].kn; *(bf16x8*)(K_lds + (bf) * SHM_K + rst) = st_[i].kr; } while (0)
#define RESC(a) do { if (__any((a) < 1.f)) { if (hi == 0) al_l[r32] = (a); asm volatile("s_waitcnt lgkmcnt(0)" ::: "memory"); \
    _Pragma("unroll") for (int d = 0; d < 2; ++d) _Pragma("unroll") for (int r = 0; r < 16; ++r) o[d][r] *= al_l[crow(r, hi)]; } } while (0)
#define MASK(P0, P1, t) do { if ((t) == 0) { const int lim_ = meta ? (wid * QBLK + r32 < 15 ? wid * QBLK + r32 : 15) : 15; mask_tile(P0, P1, lim_, hi); } \
    else if ((t) > NT - 5) { mask_tile(P0, P1, qloc - ((t) - 1) * KVBLK, hi); } } while (0)
    f32x16 pA0, pA1, pB0, pB1; float mnA, mnB, alA, alB; bf16x8 pa0, pa1, pa2, pa3;
    SLOAD(0, 0); SWRITE(0, 0); __syncthreads();
    qkt(pA0, pA1, K_lds, qr, r32, hi); MASK(pA0, pA1, 0); partialSM(pA0, pA1, m_reg, mnA, alA);
    SLOAD(1, 1); SLOAD(0, 2); SWRITE(1, 1);
    __syncthreads();
    for (int j = 1; j + 1 < NT; j += 2) {
        SBAR(); qkt(pB0, pB1, K_lds + SHM_K, qr, r32, hi); MASK(pB0, pB1, j);
        finishSM(pA0, pA1, alA, l_reg, pa0, pa1, pa2, pa3); SBAR();
        SLOAD(1, j + 2); SBAR();
        pv_all(o, vb0, pa0, pa1, pa2, pa3); partialSM(pB0, pB1, m_reg, mnB, alB);
        __syncthreads(); SWRITE(0, 0);
        RESC(alB); __syncthreads();
        SBAR(); qkt(pA0, pA1, K_lds, qr, r32, hi); MASK(pA0, pA1, j + 1);
        finishSM(pB0, pB1, alB, l_reg, pa0, pa1, pa2, pa3); SBAR();
        SLOAD(0, j + 3); SBAR();
        pv_all(o, vb0 + SHM_V, pa0, pa1, pa2, pa3); partialSM(pA0, pA1, m_reg, mnA, alA);
        __syncthreads(); SWRITE(1, 1);
        RESC(alA); __syncthreads();
    }
    finishSM(pA0, pA1, alA, l_reg, pa0, pa1, pa2, pa3); SBAR();
    pv_all(o, vb0, pa0, pa1, pa2, pa3);
    if (hi == 0) li_l[r32] = l_reg; asm volatile("s_waitcnt lgkmcnt(0)" ::: "memory");
    __syncthreads();
    { float* stg = (float*)(lds + 65536) + wid * 2048;
#pragma unroll
      for (int r = 0; r < 16; ++r) { const int orow = crow(r, hi); const float rl = __builtin_amdgcn_rcpf(li_l[orow]);
#pragma unroll
          for (int d0 = 0; d0 < 2; ++d0) stg[orow * 64 + d0 * 32 + r32] = o[d0][r] * rl; }
      asm volatile("s_waitcnt lgkmcnt(0)" ::: "memory");
      u32x4 zz[4];
#pragma unroll
      for (int i = 0; i < 4; ++i) { const int row = i * 8 + (lane >> 3), ch = lane & 7; zz[i] = *(const u32x4*)(SZ + (size_t)(qrow0 + wid * QBLK + row) * 1024 + h * 64 + ch * 8); }
#pragma unroll
      for (int i = 0; i < 4; ++i) { const int row = i * 8 + (lane >> 3), ch = lane & 7; const f32x4 a = *(const f32x4*)(stg + row * 64 + ch * 8), c = *(const f32x4*)(stg + row * 64 + ch * 8 + 4);
          u32x4 w; w.x = cvtpk(a[0] * bflo(zz[i].x), a[1] * bfhi(zz[i].x)); w.y = cvtpk(a[2] * bflo(zz[i].y), a[3] * bfhi(zz[i].y)); w.z = cvtpk(c[0] * bflo(zz[i].z), c[1] * bfhi(zz[i].z)); w.w = cvtpk(c[2] * bflo(zz[i].w), c[3] * bfhi(zz[i].w));
          *(u32x4*)(OG + (size_t)(qrow0 + wid * QBLK + row) * 1024 + h * 64 + ch * 8) = w; } }
    __syncthreads();
#undef TROW
#undef SLOAD
#undef SWRITE
#undef RESC
#undef MASK
}
}

namespace as {
constexpr int IMG_HALF = 16384, IMG_ROPE = 32768, IMG_BYTES = 36864;
constexpr int OFF_Q = 0, OFF_K0 = IMG_BYTES, OFF_WS = OFF_K0 + 3 * IMG_BYTES, LDS_BYTES_AS = OFF_WS + 8 * 64 * 4;
constexpr float THR = 8.0f;
constexpr int NTILE = 2 * AS_PAGES;
__device__ __forceinline__ unsigned off_a(unsigned row, unsigned ch) { return 2048u * (row >> 3) + 512u * (ch >> 2) + 64u * (row & 7) + 16u * ((ch & 3) ^ ((row >> 2) & 3)); }
__device__ __forceinline__ unsigned off_rope(unsigned row, unsigned ch) { return IMG_ROPE + 64u * row + 16u * (ch ^ ((row >> 2) & 3)); }
__device__ __forceinline__ unsigned img_off(unsigned row, unsigned c8) { return c8 < 32 ? (c8 >> 4) * IMG_HALF + off_a(row, c8 & 15) : off_rope(row, c8 - 32); }
__device__ __forceinline__ s16x4 tr_read_dyn(unsigned addr) { s16x4 r; asm volatile("ds_read_b64_tr_b16 %0, %1" : "=&v"(r) : "v"(addr) : "memory"); return r; }

__device__ __forceinline__ void attn_s_unit(const Args& A, int b, int s, char* lds, const int wave) {
    unsigned char* ws = A.ws;
    const int lane = lane_fresh(), wid = wave, tid = wave * 64 + lane, r32 = lane & 31, hi = lane >> 5;
    const int qg = wid & 1, kh = (wid >> 1) & 1, chh = wid >> 2;
    const int* pt = A.page_table + (size_t)b * NPAGES + s * AS_PAGES;
    float* wsf = (float*)(lds + OFF_WS) + wid * 64;
    struct Stage { f32x4 c[8]; f32x4 r; } sA, sB;
    const unsigned lo16 = (unsigned)lane * 16u, to16 = (unsigned)tid * 16u;
#define GLD16_NT(dst, voff, sbase) asm volatile("global_load_dwordx4 %0, %1, %2 nt" : "=&v"(dst) : "v"(voff), "s"(sbase) : "memory")
#define TLOAD(S, t) do { const int pg_ = pt[(t) >> 1]; const size_t k0_ = (size_t)pg_ * PAGE + ((t) & 1) * 64; const float* cb_ = A.cache_ckv + (k0_ + wid) * KVL; const float* rb_ = A.cache_krope + k0_ * QKR; \
    GLD16_NT(S.c[0], lo16, cb_); GLD16_NT(S.c[1], lo16, cb_ + 8 * KVL); GLD16_NT(S.c[2], lo16, cb_ + 16 * KVL); GLD16_NT(S.c[3], lo16, cb_ + 24 * KVL); \
    GLD16_NT(S.c[4], lo16, cb_ + 32 * KVL); GLD16_NT(S.c[5], lo16, cb_ + 40 * KVL); GLD16_NT(S.c[6], lo16, cb_ + 48 * KVL); GLD16_NT(S.c[7], lo16, cb_ + 56 * KVL); GLD16_NT(S.r, to16, rb_); } while (0)
#define TWAIT(N, S) asm volatile("s_waitcnt vmcnt(" #N ")" : "+v"(S.c[0]), "+v"(S.c[1]), "+v"(S.c[2]), "+v"(S.c[3]), "+v"(S.c[4]), "+v"(S.c[5]), "+v"(S.c[6]), "+v"(S.c[7]), "+v"(S.r) :: "memory")
#define TWRITE(bufoff, S) do { _Pragma("unroll") for (int i_ = 0; i_ < 8; ++i_) { u32x2 w_; w_.x = cvtpk(S.c[i_][0], S.c[i_][1]); w_.y = cvtpk(S.c[i_][2], S.c[i_][3]); \
        *(u32x2*)(lds + (bufoff) + img_off(8 * i_ + wid, lane >> 1) + (lane & 1) * 8) = w_; } \
    { const int rrow_ = tid >> 3, rc4 = tid & 7; u32x2 w_; w_.x = cvtpk(S.r[0], S.r[1]); w_.y = cvtpk(S.r[2], S.r[3]); *(u32x2*)(lds + (bufoff) + off_rope(rrow_, rc4 >> 1) + (rc4 & 1) * 8) = w_; } } while (0)
    TLOAD(sA, 0); TLOAD(sB, 1);
    {
        const bf16* QN = (const bf16*)(ws + WS_QN); const bf16* QR = (const bf16*)(ws + WS_QR); const bf16* WUKB = (const bf16*)(ws + WS_WUKB);
        bf16* QABS = (bf16*)(ws + WS_QABS) + (size_t)b * 64 * 288;
        const size_t qrow0 = (size_t)(SAMP0 + b * 4);
        const int l15 = lane & 15, l4 = lane >> 4, tok = l15 & 3;
#pragma unroll 1
        for (int hh = 0; hh < 2; ++hh) { const int h = 2 * wid + hh;
            const bf16x8 bq0 = *(const bf16x8*)(QN + (qrow0 + tok) * 1024 + h * 64 + 8 * l4), bq1 = *(const bf16x8*)(QN + (qrow0 + tok) * 1024 + h * 64 + 32 + 8 * l4);
#pragma unroll 4
            for (int nt = 0; nt < 16; ++nt) { const bf16* wp = WUKB + (size_t)(nt * 16 + l15) * 1024 + h * 64 + 8 * l4;
                const bf16x8 a0 = *(const bf16x8*)wp, a1 = *(const bf16x8*)(wp + 32);
                f32x4 acc = (f32x4){0.f, 0.f, 0.f, 0.f};
                acc = __builtin_amdgcn_mfma_f32_16x16x32_bf16(a0, bq0, acc, 0, 0, 0);
                acc = __builtin_amdgcn_mfma_f32_16x16x32_bf16(a1, bq1, acc, 0, 0, 0);
                if (l15 < 4) { const int q = l15 * 16 + h, c0 = nt * 16 + l4 * 4; u32x2 w; w.x = cvtpk(acc[0], acc[1]); w.y = cvtpk(acc[2], acc[3]);
                    *(u32x2*)(lds + OFF_Q + img_off(q, c0 >> 3) + (c0 & 7) * 2) = w; if (s == 0) *(u32x2*)(QABS + (size_t)q * 288 + c0) = w; } }
        }
        if (tid < 256) { const int q = tid >> 2, c = tid & 3; const u32x4 w = *(const u32x4*)(QR + (qrow0 + (q >> 4)) * 512 + (q & 15) * 32 + c * 8);
            *(u32x4*)(lds + OFF_Q + off_rope(q, c)) = w; if (s == 0) *(u32x4*)(QABS + (size_t)q * 288 + 256 + c * 8) = w; }
    }
    unsigned kaddr[2], qaddr[2], kraddr, qraddr;
    { const unsigned krow = kh * 32 + r32, qrow = qg * 32 + r32;
#pragma unroll
      for (int od = 0; od < 2; ++od) { kaddr[od] = off_a(krow, 2 * od + hi); qaddr[od] = OFF_Q + off_a(qrow, 2 * od + hi); }
      kraddr = off_rope(krow, hi); qraddr = OFF_Q + off_rope(qrow, hi); }
    const unsigned kr2 = IMG_ROPE + 64u * (kh * 32 + r32) + 16u * ((2 + hi) ^ (((kh * 32 + r32) >> 2) & 3)), qr2 = OFF_Q + IMG_ROPE + 64u * (qg * 32 + r32) + 16u * ((2 + hi) ^ (((qg * 32 + r32) >> 2) & 3));
    unsigned vaddr[2];
    { const unsigned blk = (lane >> 4) & 1, q = (lane & 15) >> 2, p = lane & 3;
#pragma unroll
      for (int t = 0; t < 2; ++t) vaddr[t] = chh * IMG_HALF + off_a(32 * kh + 8 * hi + 4 * t + q, 2 * blk + (p >> 1)) + 8 * (p & 1); }
    float m_reg = -1e30f, l_reg = 0.f; f32x16 o[4] = {};
    const unsigned ldsb = (unsigned)(uintptr_t)lds;
#define COMPUTE(bufoff) do { f32x16 p = f32x16{}; const unsigned bo_ = (bufoff); \
    _Pragma("unroll 4") for (int pp = 0; pp < 8; ++pp) { const unsigned so_ = 512u * (pp & 3) + (unsigned)IMG_HALF * (pp >> 2); \
        const bf16x8 kf0 = *(const bf16x8*)(lds + bo_ + kaddr[0] + so_), qf0 = *(const bf16x8*)(lds + qaddr[0] + so_), kf1 = *(const bf16x8*)(lds + bo_ + kaddr[1] + so_), qf1 = *(const bf16x8*)(lds + qaddr[1] + so_); \
        p = __builtin_amdgcn_mfma_f32_32x32x16_bf16(kf0, qf0, p, 0, 0, 0); p = __builtin_amdgcn_mfma_f32_32x32x16_bf16(kf1, qf1, p, 0, 0, 0); } \
    { const bf16x8 kf0 = *(const bf16x8*)(lds + bo_ + kraddr), qf0 = *(const bf16x8*)(lds + qraddr), kf1 = *(const bf16x8*)(lds + bo_ + kr2), qf1 = *(const bf16x8*)(lds + qr2); \
      p = __builtin_amdgcn_mfma_f32_32x32x16_bf16(kf0, qf0, p, 0, 0, 0); p = __builtin_amdgcn_mfma_f32_32x32x16_bf16(kf1, qf1, p, 0, 0, 0); } \
    float pmax = p[0]; _Pragma("unroll") for (int r = 1; r < 16; ++r) pmax = fmaxf(pmax, p[r]); \
    { auto rr = __builtin_amdgcn_permlane32_swap(__float_as_uint(pmax), __float_as_uint(pmax), false, false); pmax = fmaxf(__uint_as_float(rr[0]), __uint_as_float(rr[1])); } \
    float alpha = 1.f; \
    if (!__all(pmax - m_reg <= THR)) { const float mn = fmaxf(m_reg, pmax); alpha = __builtin_amdgcn_exp2f(m_reg - mn); m_reg = mn; \
        if (hi == 0) wsf[r32] = alpha; asm volatile("s_waitcnt lgkmcnt(0)" ::: "memory"); \
        _Pragma("unroll") for (int n = 0; n < 4; ++n) _Pragma("unroll") for (int r = 0; r < 16; ++r) o[n][r] *= wsf[ap::crow(r, hi)]; } \
    float ps = 0.f; _Pragma("unroll") for (int r = 0; r < 16; ++r) { p[r] = __builtin_amdgcn_exp2f(p[r] - m_reg); ps += p[r]; } \
    { auto rr = __builtin_amdgcn_permlane32_swap(__float_as_uint(ps), __float_as_uint(ps), false, false); ps = __uint_as_float(rr[0]) + __uint_as_float(rr[1]); } \
    l_reg = l_reg * alpha + ps; \
    bf16x8 pa0, pa1; PK4(p, 0, pa0); PK4(p, 8, pa1); \
    _Pragma("unroll") for (int nt = 0; nt < 4; ++nt) { \
        const s16x4 a0 = tr_read_dyn(ldsb + bo_ + vaddr[0] + 512 * nt), a1 = tr_read_dyn(ldsb + bo_ + vaddr[1] + 512 * nt); \
        const s16x4 b0 = tr_read_dyn(ldsb + bo_ + vaddr[0] + 512 * nt + 4096), b1 = tr_read_dyn(ldsb + bo_ + vaddr[1] + 512 * nt + 4096); \
        asm volatile("s_waitcnt lgkmcnt(0)" ::: "memory"); SBAR(); \
        o[nt] = __builtin_amdgcn_mfma_f32_32x32x16_bf16(pa0, ((bf16x8){a0[0], a0[1], a0[2], a0[3], a1[0], a1[1], a1[2], a1[3]}), o[nt], 0, 0, 0); \
        o[nt] = __builtin_amdgcn_mfma_f32_32x32x16_bf16(pa1, ((bf16x8){b0[0], b0[1], b0[2], b0[3], b1[0], b1[1], b1[2], b1[3]}), o[nt], 0, 0, 0); SBAR(); } } while (0)
    TWAIT(9, sA); TWRITE(OFF_K0, sA); TLOAD(sA, 2); TWAIT(9, sB); TWRITE(OFF_K0 + IMG_BYTES, sB); TLOAD(sB, 3); __syncthreads();
    { unsigned bc = OFF_K0, bn = OFF_K0 + IMG_BYTES, bw = OFF_K0 + 2 * IMG_BYTES;
#pragma unroll 1
      for (int t = 0; t < NTILE; t += 2) {
        SBAR(); COMPUTE(bc); SBAR();
        if (t + 2 < NTILE) { if (t + 3 < NTILE) TWAIT(9, sA); else TWAIT(0, sA); TWRITE(bw, sA); if (t + 4 < NTILE) TLOAD(sA, t + 4); }
        __syncthreads();
        { const unsigned x_ = bc; bc = bn; bn = bw; bw = x_; }
        SBAR(); COMPUTE(bc); SBAR();
        if (t + 3 < NTILE) { if (t + 4 < NTILE) TWAIT(9, sB); else TWAIT(0, sB); TWRITE(bw, sB); if (t + 5 < NTILE) TLOAD(sB, t + 5); }
        __syncthreads();
        { const unsigned x_ = bc; bc = bn; bn = bw; bw = x_; }
      } }
    { float* xo = (float*)lds + (size_t)(chh * 2 + qg) * 4096;
      float* xml = (float*)(lds + 65536) + (chh * 2 + qg) * 128;
      if (kh == 1) {
#pragma unroll
          for (int nt = 0; nt < 4; ++nt)
#pragma unroll
              for (int r = 0; r < 16; ++r) xo[(nt * 16 + r) * 64 + lane] = o[nt][r];
          xml[lane] = m_reg; xml[64 + lane] = l_reg; }
      __syncthreads();
      if (kh == 0) {
          const float m2 = xml[lane], l2 = xml[64 + lane]; const float mn = fmaxf(m_reg, m2); const float a1 = __builtin_amdgcn_exp2f(m_reg - mn), a2 = __builtin_amdgcn_exp2f(m2 - mn);
          l_reg = l_reg * a1 + l2 * a2; m_reg = mn;
          if (hi == 0) { wsf[r32] = a1; wsf[32 + r32] = a2; } asm volatile("s_waitcnt lgkmcnt(0)" ::: "memory");
          float* PO = (float*)(ws + WS_PART) + ((size_t)(b * 4 + s) * 64) * 256; float* PML = (float*)(ws + WS_PML) + (size_t)(b * 4 + s) * 128;
#pragma unroll
          for (int nt = 0; nt < 4; ++nt)
#pragma unroll
              for (int r = 0; r < 16; ++r) { const int qr_ = ap::crow(r, hi); PO[(size_t)(qg * 32 + qr_) * 256 + chh * 128 + nt * 32 + r32] = o[nt][r] * wsf[qr_] + xo[(nt * 16 + r) * 64 + lane] * wsf[32 + qr_]; }
          if (chh == 0 && hi == 0) { PML[qg * 32 + r32] = m_reg; PML[64 + qg * 32 + r32] = l_reg; } }
    }
    __syncthreads();
#undef TLOAD
#undef TWRITE
#undef TWAIT
#undef GLD16_NT
#undef COMPUTE
}
#undef PK4
#undef PKV
#undef KSWZ
}

__device__ __forceinline__ void comb_unit(const Args& A, int b, int hq, char* lds, const int wave) {
    unsigned char* ws = A.ws; const int tid = wave * 64 + lane_fresh(), lq = tid >> 5, l = lq >> 2, h = hq * 4 + (lq & 3), j = tid & 31, q = l * 16 + h;
    const bf16* QABS = (const bf16*)(ws + WS_QABS) + ((size_t)b * 64 + q) * 288; const bf16* CB = (const bf16*)(ws + WS_CB); const bf16* KRB = (const bf16*)(ws + WS_KRB);
    const float* PO = (const float*)(ws + WS_PART) + ((size_t)b * 4 * 64 + q) * 256; const float* PML = (const float*)(ws + WS_PML) + (size_t)b * 4 * 128;
    float* olds = (float*)lds;
    float qv[8], qrv[8];
    { const u32x4 w = *(const u32x4*)(QABS + j * 8);
#pragma unroll
      for (int k = 0; k < 4; ++k) { qv[2 * k] = bflo(w[k]); qv[2 * k + 1] = bfhi(w[k]); }
      u32x4 wr = (u32x4){0u, 0u, 0u, 0u}; if (j < 4) wr = *(const u32x4*)(QABS + 256 + j * 8);
#pragma unroll
      for (int k = 0; k < 4; ++k) { qrv[2 * k] = bflo(wr[k]); qrv[2 * k + 1] = bfhi(wr[k]); } }
    float sc[4], cn[4][8];
#pragma unroll
    for (int jn = 0; jn < 4; ++jn) { const size_t row = (size_t)(SAMP0 + b * 4 + jn); const u32x4 w = *(const u32x4*)(CB + row * 256 + j * 8); float d = 0.f;
#pragma unroll
        for (int k = 0; k < 4; ++k) { cn[jn][2 * k] = bflo(w[k]); cn[jn][2 * k + 1] = bfhi(w[k]); d += qv[2 * k] * cn[jn][2 * k] + qv[2 * k + 1] * cn[jn][2 * k + 1]; }
        if (j < 4) { const u32x4 wr = *(const u32x4*)(KRB + row * 32 + j * 8);
#pragma unroll
            for (int k = 0; k < 4; ++k) d += qrv[2 * k] * bflo(wr[k]) + qrv[2 * k + 1] * bfhi(wr[k]); }
#pragma unroll
        for (int o = 1; o < 32; o <<= 1) d = d + shfl_xor_f(d, o, tid & 63);
        sc[jn] = jn <= l ? d : -INFINITY; }
    float mp[4], lp[4], M = -INFINITY;
#pragma unroll
    for (int p = 0; p < AS_SPLITS; ++p) { mp[p] = PML[p * 128 + q]; lp[p] = PML[p * 128 + 64 + q]; M = fmaxf(M, mp[p]); }
#pragma unroll
    for (int jn = 0; jn < 4; ++jn) M = fmaxf(M, sc[jn]);
    float L = 0.f, acc[8];
#pragma unroll
    for (int k = 0; k < 8; ++k) acc[k] = 0.f;
#pragma unroll
    for (int p = 0; p < AS_SPLITS; ++p) { const float w = __builtin_amdgcn_exp2f(mp[p] - M); L += w * lp[p]; const f32x4 a = *(const f32x4*)(PO + (size_t)p * 64 * 256 + j * 8), c = *(const f32x4*)(PO + (size_t)p * 64 * 256 + j * 8 + 4);
#pragma unroll
        for (int k = 0; k < 4; ++k) { acc[k] += w * a[k]; acc[4 + k] += w * c[k]; } }
#pragma unroll
    for (int jn = 0; jn < 4; ++jn) { const float w = __builtin_amdgcn_exp2f(sc[jn] - M); L += w;
#pragma unroll
        for (int k = 0; k < 8; ++k) acc[k] += w * cn[jn][k]; }
    const float rl = 1.0f / L;
    *(f32x4*)(olds + lq * 256 + j * 8) = (f32x4){acc[0] * rl, acc[1] * rl, acc[2] * rl, acc[3] * rl}; *(f32x4*)(olds + lq * 256 + j * 8 + 4) = (f32x4){acc[4] * rl, acc[5] * rl, acc[6] * rl, acc[7] * rl};
    __syncthreads();
    const bf16* WUV = (const bf16*)(ws + WS_WUKV) + (size_t)(1024 + h * 64 + 2 * j) * 256;
    float o0 = 0.f, o1 = 0.f;
    for (int c = 0; c < 256; c += 8) { const u32x4 w0 = *(const u32x4*)(WUV + c), w1 = *(const u32x4*)(WUV + 256 + c); const f32x4 x0 = *(const f32x4*)(olds + lq * 256 + c), x1 = *(const f32x4*)(olds + lq * 256 + c + 4);
        o0 += x0[0] * bflo(w0[0]) + x0[1] * bfhi(w0[0]) + x0[2] * bflo(w0[1]) + x0[3] * bfhi(w0[1]) + x1[0] * bflo(w0[2]) + x1[1] * bfhi(w0[2]) + x1[2] * bflo(w0[3]) + x1[3] * bfhi(w0[3]);
        o1 += x0[0] * bflo(w1[0]) + x0[1] * bfhi(w1[0]) + x0[2] * bflo(w1[1]) + x0[3] * bfhi(w1[1]) + x1[0] * bflo(w1[2]) + x1[1] * bfhi(w1[2]) + x1[2] * bflo(w1[3]) + x1[3] * bfhi(w1[3]); }
    const size_t orow = (size_t)(SAMP0 + b * 4 + l) * 1024 + h * 64 + 2 * j;
    const unsigned z = *(const unsigned*)((const bf16*)(ws + WS_SZ) + orow);
    *(unsigned*)((bf16*)(ws + WS_OG) + orow) = cvtpk(o0 * bflo(z), o1 * bfhi(z));
    __syncthreads();
}
constexpr int N_AS_ITEMS = DECB * AS_SPLITS;
#ifndef PREF_DIV
#define PREF_DIV 4
#endif
#ifndef PREF_NUM
#define PREF_NUM 0
#endif
#ifndef ARGS_RELOAD
#define ARGS_RELOAD 1
#endif
#ifndef REP_BAR
#define REP_BAR 1
#endif
#ifndef REP_ELT
#define REP_ELT 1
#endif
#ifndef TAIL_CONV
#define TAIL_CONV 1
#endif
#ifndef STATIC_SCHED
#define STATIC_SCHED 0
#endif
#ifndef REP_AS
#define REP_AS 1
#endif
#ifndef REP_AP
#define REP_AP 1
#endif
#ifndef REP_GEMM
#define REP_GEMM 1
#endif
#ifndef EN_P0
#define EN_P0 1
#endif
#ifndef EN_G1
#define EN_G1 1
#endif
#ifndef EN_CONV
#define EN_CONV 1
#endif
#ifndef EN_G4
#define EN_G4 1
#endif
#ifndef EN_LAT
#define EN_LAT 1
#endif
#ifndef EN_G5
#define EN_G5 1
#endif
#ifndef EN_G6
#define EN_G6 1
#endif
#ifndef EN_AP
#define EN_AP 1
#endif
#ifndef EN_AS
#define EN_AS 1
#endif
#ifndef EN_COMB
#define EN_COMB 1
#endif
#ifndef EN_GOUT
#define EN_GOUT 1
#endif
#ifndef EN_NORM
#define EN_NORM 1
#endif

__device__ __forceinline__ Args fresh_args() {
    const __attribute__((address_space(4))) unsigned long long* p = (const __attribute__((address_space(4))) unsigned long long*)__builtin_amdgcn_kernarg_segment_ptr();
    asm volatile("" : "+s"(p));
#define GP(T, i) ((T*)(__attribute__((address_space(1))) T*)p[i])
    Args a;
    a.x_prompt = GP(const float, 0); a.x_sample = GP(const float, 1); a.cache_ckv = GP(const float, 2); a.cache_krope = GP(const float, 3); a.state_conv = GP(const float, 4); a.page_table = GP(const int, 5);
    a.meta = GP(const float, 6); a.pre_g = GP(const float, 7); a.post_g = GP(const float, 8); a.w_in_conv = GP(const float, 9); a.conv_w = GP(const float, 10); a.w_out_conv = GP(const float, 11);
    a.kv_norm_g = GP(const float, 12); a.w_dkv = GP(const float, 13); a.kv_lat_g = GP(const float, 14); a.w_uk = GP(const float, 15); a.w_uv = GP(const float, 16); a.w_in_mla = GP(const float, 17);
    a.q_norm_g = GP(const float, 18); a.w_uq = GP(const float, 19); a.w_out_mla = GP(const float, 20); a.out = GP(float, 21); a.ws = GP(unsigned char, 22);
#undef GP
    return a;
}
static_assert(sizeof(Args) == 23 * 8, "Args = 23 pointers, no padding: fresh_args() reads them by index");
__global__ void __launch_bounds__(NWAVES * 64, 2) yoco_fwd(Args args_unused_directly) {
    extern __shared__ __attribute__((aligned(16))) unsigned char lds[];
    LAS unsigned char* ldsl = (LAS unsigned char*)lds;
    const int wave = __builtin_amdgcn_readfirstlane(threadIdx.x >> 6) & 7;
#define LANE_OPAQUE() const int lane = lane_fresh()
#define IS_T0() (wave == 0 && lane_fresh() == 0)
#if ARGS_RELOAD
#define PHASE_ARGS() const Args args = fresh_args(); unsigned char* const ws = args.ws; (void)ws
#else
#define PHASE_ARGS() Args args = args_unused_directly; asm volatile("" : "+s"(args.ws), "+s"(args.out)); unsigned char* const ws = args.ws; (void)ws
#endif
    const int G = gridDim.x; const int bx = blockIdx.x; const int vcu = (G % 8 == 0) ? (bx % 8) * (G / 8) + bx / 8 : bx;
    const int gw = vcu * NWAVES + wave, NGW = G * NWAVES;
    { const int t_ = wave * 64 + lane_fresh(); if (t_ < 8) ((LAS unsigned*)(ldsl + LDSCTL_OFF))[t_] = 0u; }
    __syncthreads();
    { PHASE_ARGS(); (void)xcd_barrier_post((unsigned*)(ws + WS_CTL) + CW_BAR, (volatile LAS unsigned*)(ldsl + LDSCTL_OFF), IS_T0()); }
#define GRID_BAR() do { PHASE_ARGS(); XcdBarrier b_; b_.bar = (unsigned*)(ws + WS_CTL) + CW_BAR; b_.x = xb_xcc_id(); b_.st = (volatile LAS unsigned*)(ldsl + LDSCTL_OFF); for (int rb_ = 0; rb_ < REP_BAR; ++rb_) xcd_barrier(b_, IS_T0()); } while (0)
#if EN_P0
    { PHASE_ARGS(); LANE_OPAQUE(); for (int re_ = 0; re_ < REP_ELT; ++re_) p0_prologue(args, ldsl, gw, NGW, wave, lane); }
#endif
    GRID_BAR();

#pragma unroll 1
    for (int l = 0; l < 4; ++l) {
        if (l < 2) {
            { PHASE_ARGS(); pg8::Gemm g{(const bf16*)(ws + WS_X), (const bf16*)(ws + WS_WIN) + (size_t)l * 4096 * 1024, NROWS, 4096, 1024}; pg8::RepOrder<REP_GEMM> S; S.init(NROWS, 4096, G, bx);
              pg8::EpiConvSplit E{(bf16*)(ws + WS_V1), (bf16*)(ws + WS_GZ), (const float*)(ws + WS_RS)};
#if EN_G1
              pg8::gemm_phase<pg8::EpiConvSplit, pg8::RepOrder<REP_GEMM>, true, true>(ldsl, g, S, E, wave);
#endif
              { constexpr int r_ = (67 * 16) % 256; if (TAIL_CONV && G == 256 && bx >= r_) { LANE_OPAQUE(); convert_set(args, l == 0 ? 1 : 3, ldsl, (bx - r_) * NWAVES + wave, (256 - r_) * NWAVES, wave, lane); }
                else if (TAIL_CONV && G != 256 && l == 0) { LANE_OPAQUE(); convert_set(args, 1, ldsl, gw, NGW, wave, lane); convert_set(args, 3, ldsl, gw, NGW, wave, lane); } }
 }
            GRID_BAR();
#if EN_CONV
            { PHASE_ARGS(); LANE_OPAQUE(); for (int re_ = 0; re_ < REP_ELT; ++re_) conv_phase(args, l, gw, NGW, lane); }
#endif
            GRID_BAR();
        } else {
            const int j = l - 2;
            { PHASE_ARGS(); pg8::Gemm g{(const bf16*)(ws + WS_X), (const bf16*)(ws + (j ? WS_WA1 : WS_WA0)), NROWS, j ? 1536 : 2048, 1024}; pg8::RepOrder<REP_GEMM> S; S.init(NROWS, j ? 1536 : 2048, G, bx);
              pg8::EpiMlaIn E{(float*)(ws + WS_CKR), (bf16*)(ws + WS_QL), (float*)(ws + WS_SSQ), (bf16*)(ws + WS_SZ), j ? 0 : 2, (const float*)(ws + WS_RS)};
#if EN_G4
              pg8::gemm_phase<pg8::EpiMlaIn, pg8::RepOrder<REP_GEMM>, true, true>(ldsl, g, S, E, wave);
#endif
 }
            GRID_BAR();
            if (j == 0) {
#if EN_LAT
                { PHASE_ARGS(); LANE_OPAQUE(); for (int re_ = 0; re_ < REP_ELT; ++re_) latent_phase(args, gw, NGW, lane); }
#endif
                GRID_BAR();
                { PHASE_ARGS(); pg8::Gemm g{(const bf16*)(ws + WS_CB), (const bf16*)(ws + WS_WUKV), NROWS, 2048, 256}; pg8::RepOrder<REP_GEMM> S; S.init(NROWS, 2048, G, bx);
                  pg8::EpiBf16 E{(bf16*)(ws + WS_KN), 1024, 1024, (size_t)(WS_VV - WS_KN) / 2};
#if EN_G5
                  pg8::gemm_phase<pg8::EpiBf16, pg8::RepOrder<REP_GEMM>, true, true>(ldsl, g, S, E, wave);
#endif
 }
            }
            { PHASE_ARGS(); pg8::Gemm g{(const bf16*)(ws + WS_QL), (const bf16*)(ws + WS_WUQ) + (size_t)j * 1536 * 512, NROWS, 1536, 512}; pg8::RepOrder<REP_GEMM> S; S.init(NROWS, 1536, G, bx);
              pg8::EpiQUp E{(bf16*)(ws + WS_QN), (bf16*)(ws + WS_QR), (const float*)(ws + WS_SSQ), (const float*)(ws + WS_COS), (const float*)(ws + WS_SIN)};
#if EN_G6
              pg8::gemm_phase<pg8::EpiQUp, pg8::RepOrder<REP_GEMM>, true, true>(ldsl, g, S, E, wave);
#endif
 }
            GRID_BAR();
            {
                PHASE_ARGS();
                const bf16* QN = (const bf16*)(ws + WS_QN); const bf16* QR = (const bf16*)(ws + WS_QR); const bf16* KN = (const bf16*)(ws + WS_KN); const bf16* KRB = (const bf16*)(ws + WS_KRB);
                const bf16* VV = (const bf16*)(ws + WS_VV); const bf16* SZ = (const bf16*)(ws + WS_SZ); bf16* OG = (bf16*)(ws + WS_OG);
                unsigned* qh = (unsigned*)(ws + WS_CTL) + CW_Q + j * 16 * 64;
                volatile LAS int* slot = (volatile LAS int*)(ldsl + LDSCTL_OFF + 16);
                const int myq = bx & 7; const bool prefS = ((bx >> 3) % PREF_DIV) < PREF_NUM;
                bool s_open = true, own_open = true; unsigned steal = 0xffffffffu;
#define DEQUEUE(dst, word) do { if (IS_T0()) *slot = (int)__hip_atomic_fetch_add(qh + (word) * 64, 1u, __ATOMIC_RELAXED, __HIP_MEMORY_SCOPE_AGENT); __syncthreads(); dst = *slot; __syncthreads(); } while (0)
#pragma unroll 1
                for (;;) {
                    int type = -1, id = 0, q = 0;
                    if (prefS && s_open) { DEQUEUE(id, 8); if (id < N_AS_ITEMS * REP_AS) type = 0; else s_open = false; }
                    if (type < 0 && own_open) { q = myq; DEQUEUE(id, q); if (id < 130 * REP_AP) { id = id % 130; type = id < 128 ? 1 : 2; } else own_open = false; }
                    if (type < 0 && s_open) { DEQUEUE(id, 8); if (id < N_AS_ITEMS * REP_AS) type = 0; else s_open = false; }
                    if (type < 0) {
                        if (steal == 0xffffffffu) { if (IS_T0()) { unsigned m_ = 0u;
#pragma unroll
                                for (int k_ = 0; k_ < 8; ++k_) if (__hip_atomic_load(qh + k_ * 64, __ATOMIC_RELAXED, __HIP_MEMORY_SCOPE_AGENT) < 130u * REP_AP) m_ |= 1u << k_;
                                *slot = (int)m_; } __syncthreads(); steal = (unsigned)*slot & ~(1u << myq); __syncthreads(); }
                        while (steal) { q = __builtin_ctz(steal); DEQUEUE(id, q); if (id < 130 * REP_AP) { id = id % 130; type = id < 128 ? 1 : 2; break; } steal &= ~(1u << q); }
                    }
                    if (type < 0) break;
#if EN_AS
                    if (type == 0) { id = id % N_AS_ITEMS; as::attn_s_unit(args, id / AS_SPLITS, id % AS_SPLITS, (char*)lds, wave); }
#endif
#if EN_AP
                    if (type == 1) { const int bh = q * 8 + (id & 7); ap::attn_unit(QN, QR, KN, KRB, VV, SZ, OG, bh >> 4, bh & 15, 15 - (id >> 3), false, (char*)lds, wave); }
                    if (type == 2) ap::attn_unit(QN, QR, KN, KRB, VV, SZ, OG, 0, q * 2 + (id - 128), 0, true, (char*)lds, wave);
#endif
                }
#undef DEQUEUE
            }
            GRID_BAR();
#if EN_COMB
            { PHASE_ARGS(); for (int u = vcu; u < NSAMP * REP_ELT; u += G) comb_unit(args, (u % NSAMP) >> 2, u & 3, (char*)lds, wave); }
#endif
            GRID_BAR();
        }
        { PHASE_ARGS(); const bf16* Ag = (const bf16*)(ws + (l < 2 ? WS_G : WS_OG)); const bf16* Wl = (const bf16*)(ws + (l < 2 ? WS_WOC : WS_WOM)) + (size_t)(l & 1) * 1024 * 1024;
#if EN_GOUT
          { pg8::Gemm g{Ag, Wl, NMAIN, 1024, 1024}; pg8::StaticOrder S; S.init(NMAIN, 1024, G, bx); pg8::EpiBf16 E{(bf16*)(ws + WS_MB), 1024, 0, 0};
            pg8::gemm_phase<pg8::EpiBf16, pg8::StaticOrder, true, true>(ldsl, g, S, E, wave); }
          { pg8::Gemm g{Ag, Wl, NROWS, 1024, 1024 / GOUT_SPLITK, 1024}; pg8::SplitKSmallOrder<GOUT_SPLITK> S; S.init(1024, 1024, G, bx); pg8::EpiPartF32 E{(float*)(ws + WS_PARTG), 1024 / GOUT_SPLITK};
            pg8::gemm_phase<pg8::EpiPartF32, pg8::SplitKSmallOrder<GOUT_SPLITK>, true, true>(ldsl, g, S, E, wave); }
#endif
          if (l < 2) { constexpr int r_ = 96; if (TAIL_CONV && G == 256 && bx >= r_) { LANE_OPAQUE(); convert_set(args, l == 0 ? 2 : 4, ldsl, (bx - r_) * NWAVES + wave, (256 - r_) * NWAVES, wave, lane); }
                       else if (TAIL_CONV && G != 256 && l == 0) { LANE_OPAQUE(); convert_set(args, 2, ldsl, gw, NGW, wave, lane); convert_set(args, 4, ldsl, gw, NGW, wave, lane); } }
 }
        GRID_BAR();
#if EN_NORM
        { PHASE_ARGS(); LANE_OPAQUE(); norm_phase(args, l, gw, NGW, lane); }
#endif
        if (l < 3) GRID_BAR();
    }
}

extern "C" void kernel_launch(void* const* d_in, const int* in_sizes, int n_in, void* d_out, int out_size, void* d_ws, size_t ws_size, hipStream_t stream) {
    static int grid = 0;
    if (grid == 0) {
        if (n_in != 21 || out_size != (int)O_END || ws_size < WS_END) { fprintf(stderr, "kernel_launch: unexpected shapes: n_in %d out %d (want %zu) ws %zu (want >= %zu)\n", n_in, out_size, (size_t)O_END, ws_size, (size_t)WS_END); grid = -1; return; }
        int dev = 0, cus = 0, per_cu = 0;
        if (hipGetDevice(&dev) != hipSuccess || hipDeviceGetAttribute(&cus, hipDeviceAttributeMultiprocessorCount, dev) != hipSuccess) { grid = -1; return; }
        if (hipFuncSetAttribute((const void*)yoco_fwd, hipFuncAttributeMaxDynamicSharedMemorySize, LDS_BYTES) != hipSuccess) { fprintf(stderr, "kernel_launch: hipFuncSetAttribute failed\n"); grid = -1; return; }
        if (hipOccupancyMaxActiveBlocksPerMultiprocessor(&per_cu, (const void*)yoco_fwd, NWAVES * 64, LDS_BYTES) != hipSuccess || per_cu < 1) { fprintf(stderr, "kernel_launch: occupancy query says %d blocks per CU\n", per_cu); }
        (void)hipGetLastError();
        grid = cus;
    }
    if (grid < 0) return;
    if (hipMemsetAsync((char*)d_ws + WS_CTL, 0, CTL_ZERO_BYTES, stream) != hipSuccess) return;
    Args a{};
    a.x_prompt = (const float*)d_in[0]; a.x_sample = (const float*)d_in[1]; a.cache_ckv = (const float*)d_in[2]; a.cache_krope = (const float*)d_in[3]; a.state_conv = (const float*)d_in[4];
    a.page_table = (const int*)d_in[5]; a.meta = (const float*)d_in[6]; a.pre_g = (const float*)d_in[7]; a.post_g = (const float*)d_in[8]; a.w_in_conv = (const float*)d_in[9];
    a.conv_w = (const float*)d_in[10]; a.w_out_conv = (const float*)d_in[11]; a.kv_norm_g = (const float*)d_in[12]; a.w_dkv = (const float*)d_in[13]; a.kv_lat_g = (const float*)d_in[14];
    a.w_uk = (const float*)d_in[15]; a.w_uv = (const float*)d_in[16]; a.w_in_mla = (const float*)d_in[17]; a.q_norm_g = (const float*)d_in[18]; a.w_uq = (const float*)d_in[19]; a.w_out_mla = (const float*)d_in[20];
    a.out = (float*)d_out; a.ws = (unsigned char*)d_ws;
    hipLaunchKernelGGL(yoco_fwd, dim3(grid), dim3(NWAVES * 64), LDS_BYTES, stream, a);
    const hipError_t le = hipPeekAtLastError();
    if (le != hipSuccess) fprintf(stderr, "kernel_launch: launch failed: %s\n", hipGetErrorName(le));
}
```

```cpp
#include <hip/hip_runtime.h>
#include <hip/hip_bf16.h>
#include <cstdio>
#include <cstdint>
#include <cmath>

constexpr int DM = 1024, NB = 4, SEQ = 4096, NMETA = 16, TTOT = SEQ + NMETA;
constexpr int DECB = 128, DECS = 4, PAST = 8192, PAGE = 128, NPAGES = PAST / PAGE;
constexpr int NH = 16, QKN = 64, QKR = 32, VH = 64, QLORA = 512, KVL = 256;
constexpr int NMAIN = NB * SEQ;
constexpr int SAMP0 = NMAIN, NSAMP = DECB * DECS;
constexpr int META0 = SAMP0 + NSAMP;
constexpr int NROWS = META0 + 256;
constexpr int NPOS = TTOT + DECS;
constexpr float RMS_EPS = 1e-6f;
constexpr int AS_SPLITS = 2, AS_PAGES = NPAGES / AS_SPLITS;
constexpr float QSCALE = 0.10206207261596575f * 1.4426950408889634f;

__device__ __forceinline__ float shfl_xor_f(float v, int mask, int lane) { return __int_as_float(__builtin_amdgcn_ds_bpermute((lane ^ mask) << 2, __float_as_int(v))); }

__device__ __forceinline__ int lane_fresh() { int l; asm volatile("v_mbcnt_lo_u32_b32 %0, -1, 0\n\tv_mbcnt_hi_u32_b32 %0, -1, %0" : "=v"(l)); return l & 63; }

namespace pg8 {
#define PG8_LAS __attribute__((address_space(3)))
typedef unsigned short bf16_t;
typedef short bf16x8 __attribute__((ext_vector_type(8)));
typedef float f32x4 __attribute__((ext_vector_type(4)));
typedef unsigned u32x4 __attribute__((ext_vector_type(4)));
constexpr int BM = 256, BK = 64, HALF = 128, HTB = HALF * BK * 2  , STAGE_BYTES = 8 * HTB, NXCD = 8, WGM = 8;

__host__ __device__ __forceinline__ int lds_byte(int r, int c) { const int st = (r >> 4) * 2 + (c >> 5), rr = r & 15, cc = c & 31, ob = rr * 64 + cc * 2; return st * 1024 + (ob ^ (((ob >> 9) & 1) << 5)); }
__host__ __device__ __forceinline__ void stage_rc(int b, int& R, int& C) { const int st = b / 1024, sb = b % 1024, swz = sb ^ (((sb >> 9) & 1) << 5); R = (st >> 1) * 16 + swz / 64; C = (st & 1) * 32 + (swz % 64) / 2; }
__host__ __device__ __forceinline__ int perm32(int rho) { const int n = rho >> 4, i = rho & 15; return 8 * (i >> 2) + 4 * n + (i & 3); }

struct Unit { int pm, pn; int koff = 0; };
struct Gemm { const bf16_t* A; const bf16_t* Bt; int M, N, K; int ld = 0; };

struct StaticOrder {
    int nM, nN, nwg, G, c;
    __host__ __device__ void init(int M, int N, int G_, int c_) { nM = M / BM; nN = N / BM; nwg = nM * nN; G = G_; c = c_; }
    __host__ __device__ bool next(int i, Unit& u) const {
        const long L = (long)i * G + c; if (L >= nwg) return false;
        int wgid = (int)L; { const int q = nwg / NXCD, r = nwg % NXCD, xcd = wgid % NXCD, off = wgid / NXCD; wgid = (xcd < r ? xcd * (q + 1) : r * (q + 1) + (xcd - r) * q) + off; }
        const int nig = WGM * nN, gid = wgid / nig, fm = gid * WGM, gsz = (nM - fm) < WGM ? (nM - fm) : WGM;
        u.pm = fm + ((wgid % nig) % gsz); u.pn = (wgid % nig) / gsz; return true;
    }
    __device__ __forceinline__ void a_ready(const Unit&) const {}
    __device__ __forceinline__ void done(const Unit&) const {}
};


template <int R> struct RepOrder {
    StaticOrder base; int cnt;
    __host__ __device__ void init(int M, int N, int G_, int c_) { base.init(M, N, G_, c_); cnt = (base.nwg - c_ + G_ - 1) / G_; if (cnt < 0) cnt = 0; }
    __host__ __device__ bool next(int i, Unit& u) const { if (i >= R * cnt) return false; return base.next(i % cnt, u); }
    __device__ __forceinline__ void a_ready(const Unit&) const {}
    __device__ __forceinline__ void done(const Unit&) const {}
};

template <int S> struct SplitKSmallOrder {
    int nN, G, c, ksub;
    __host__ __device__ void init(int N, int K, int G_, int c_) { nN = N / BM; G = G_; c = c_; ksub = K / S; }
    __host__ __device__ bool next(int i, Unit& u) const { const long L = (long)i * G + c; if (L >= 3L * nN * S) return false; const int r = (int)(L / S); u.koff = (int)(L % S) * ksub; u.pm = 64 + r % 3; u.pn = r / 3; return true; }
    __device__ __forceinline__ void a_ready(const Unit&) const {}
    __device__ __forceinline__ void done(const Unit&) const {}
};

typedef float f32x2_t __attribute__((ext_vector_type(2))); typedef __bf16 bf16x2_t __attribute__((ext_vector_type(2)));
__device__ __forceinline__ unsigned cvt_pk_bf16(float lo, float hi) { f32x2_t v = {lo, hi}; bf16x2_t b = __builtin_convertvector(v, bf16x2_t); return __builtin_bit_cast(unsigned, b); }
typedef unsigned u32x2 __attribute__((ext_vector_type(2)));
__device__ __forceinline__ float sigmoidf_fast(float z) { return __builtin_amdgcn_rcpf(1.0f + __builtin_amdgcn_exp2f(-1.4426950408889634f * z)); }

struct EpiBf16 {
    static constexpr bool PERM = true, AFTER_DRAIN = false;
    bf16_t* O; int ldc; int split_cols; size_t split_stride;
    __device__ __forceinline__ void operator()(const f32x4 (&acc)[2][2][4][2], const Unit& u, int wr, int wc, int fr, int fq) const {
        const int row0 = u.pm * BM + wr * 64 + fr; int colt = u.pn * BM; bf16_t* base = O;
        if (split_cols && colt >= split_cols) { base += split_stride; colt -= split_cols; }
        const int col0 = colt + wc * 32 + 8 * fq;
#pragma unroll
        for (int ai = 0; ai < 2; ++ai)
#pragma unroll
            for (int m = 0; m < 4; ++m) { bf16_t* rowp = base + (size_t)(row0 + ai * HALF + m * 16) * ldc + col0;
#pragma unroll
                for (int bj = 0; bj < 2; ++bj) { const f32x4 v0 = acc[ai][bj][m][0], v1 = acc[ai][bj][m][1];
                    u32x4 w; w.x = cvt_pk_bf16(v0[0], v0[1]); w.y = cvt_pk_bf16(v0[2], v0[3]); w.z = cvt_pk_bf16(v1[0], v1[1]); w.w = cvt_pk_bf16(v1[2], v1[3]);
                    *(u32x4*)(rowp + bj * HALF) = w; } }
    }
};

struct EpiConvSplit {
    static constexpr bool PERM = true, AFTER_DRAIN = false;
    bf16_t* V; bf16_t* GZ; const float* RS;
    __device__ __forceinline__ void operator()(const f32x4 (&acc)[2][2][4][2], const Unit& u, int wr, int wc, int fr, int fq) const {
        const int row0 = u.pm * BM + wr * 64 + fr, ch0 = u.pn * 64 + wc * 16 + fq * 4;
#pragma unroll
        for (int ai = 0; ai < 2; ++ai)
#pragma unroll
            for (int m = 0; m < 4; ++m) { const size_t off = (size_t)(row0 + ai * HALF + m * 16) * 1024 + ch0;
                const float rs = RS[row0 + ai * HALF + m * 16];
                const f32x4 bg = acc[ai][0][m][0] * rs, cg = acc[ai][0][m][1] * rs, uu = acc[ai][1][m][0] * rs, zz = acc[ai][1][m][1] * rs;
                const f32x4 v = cg * uu; f32x4 g;
#pragma unroll
                for (int e = 0; e < 4; ++e) g[e] = bg[e] * zz[e] * sigmoidf_fast(zz[e]);
                u32x2 wv, wg; wv.x = cvt_pk_bf16(v[0], v[1]); wv.y = cvt_pk_bf16(v[2], v[3]); wg.x = cvt_pk_bf16(g[0], g[1]); wg.y = cvt_pk_bf16(g[2], g[3]);
                *(u32x2*)(V + off) = wv; *(u32x2*)(GZ + off) = wg; }
    }
};

struct EpiMlaIn {
    static constexpr bool PERM = true, AFTER_DRAIN = false;
    float* CKR; bf16_t* QL; float* SSQ; bf16_t* SZ; int nck; const float* RS;
    __device__ __forceinline__ void operator()(const f32x4 (&acc)[2][2][4][2], const Unit& u, int wr, int wc, int fr, int fq) const {
        const int row0 = u.pm * BM + wr * 64 + fr; const int t = u.pn - nck;
        if (t < 0) {
            const int col0 = u.pn * BM + wc * 32 + 8 * fq;
#pragma unroll
            for (int ai = 0; ai < 2; ++ai)
#pragma unroll
                for (int m = 0; m < 4; ++m) { float* rowp = CKR + (size_t)(row0 + ai * HALF + m * 16) * 512 + col0; const float rs = RS[row0 + ai * HALF + m * 16];
#pragma unroll
                    for (int bj = 0; bj < 2; ++bj) { *(f32x4*)(rowp + bj * HALF) = acc[ai][bj][m][0] * rs; *(f32x4*)(rowp + bj * HALF + 4) = acc[ai][bj][m][1] * rs; } }
        } else if (t < 2) {
            const int col0 = t * BM + wc * 32 + 8 * fq;
#pragma unroll
            for (int ai = 0; ai < 2; ++ai)
#pragma unroll
                for (int m = 0; m < 4; ++m) { const int row = row0 + ai * HALF + m * 16; bf16_t* rowp = QL + (size_t)row * 512 + col0; float s = 0.f; const float rs = RS[row];
#pragma unroll
                    for (int bj = 0; bj < 2; ++bj) { const f32x4 v0 = acc[ai][bj][m][0] * rs, v1 = acc[ai][bj][m][1] * rs;
                        s += (v0[0] * v0[0] + v0[1] * v0[1]) + (v0[2] * v0[2] + v0[3] * v0[3]) + (v1[0] * v1[0] + v1[1] * v1[1]) + (v1[2] * v1[2] + v1[3] * v1[3]);
                        u32x4 w; w.x = cvt_pk_bf16(v0[0], v0[1]); w.y = cvt_pk_bf16(v0[2], v0[3]); w.z = cvt_pk_bf16(v1[0], v1[1]); w.w = cvt_pk_bf16(v1[2], v1[3]);
                        *(u32x4*)(rowp + bj * HALF) = w; }
                    { const int ln = fq * 16 + fr; s += shfl_xor_f(s, 16, ln); s += shfl_xor_f(s, 32, ln); }
                    if (fq == 0) SSQ[(size_t)row * 8 + t * 4 + wc] = s; }
        } else {
            const int col0 = (t - 2) * BM + wc * 32 + 8 * fq;
#pragma unroll
            for (int ai = 0; ai < 2; ++ai)
#pragma unroll
                for (int m = 0; m < 4; ++m) { bf16_t* rowp = SZ + (size_t)(row0 + ai * HALF + m * 16) * 1024 + col0; const float rs = RS[row0 + ai * HALF + m * 16];
#pragma unroll
                    for (int bj = 0; bj < 2; ++bj) { f32x4 v0 = acc[ai][bj][m][0] * rs, v1 = acc[ai][bj][m][1] * rs;
#pragma unroll
                        for (int e = 0; e < 4; ++e) { v0[e] = v0[e] * sigmoidf_fast(v0[e]); v1[e] = v1[e] * sigmoidf_fast(v1[e]); }
                        u32x4 w; w.x = cvt_pk_bf16(v0[0], v0[1]); w.y = cvt_pk_bf16(v0[2], v0[3]); w.z = cvt_pk_bf16(v1[0], v1[1]); w.w = cvt_pk_bf16(v1[2], v1[3]);
                        *(u32x4*)(rowp + bj * HALF) = w; } }
        }
    }
};

__device__ __forceinline__ int posidx_of_row(int row) {
    return row < NMAIN ? (row & (SEQ - 1)) + NMETA : (row < META0 ? TTOT + ((row - SAMP0) & 3) : (row < META0 + NMETA ? row - META0 : 0));
}
struct EpiQUp {
    static constexpr bool PERM = true, AFTER_DRAIN = false;
    bf16_t* QN; bf16_t* QR; const float* SSQ; const float* COS; const float* SIN;
    __device__ __forceinline__ void operator()(const f32x4 (&acc)[2][2][4][2], const Unit& u, int wr, int wc, int fr, int fq) const {
        const int row0 = u.pm * BM + wr * 64 + fr;
#pragma unroll
        for (int ai = 0; ai < 2; ++ai)
#pragma unroll
            for (int m = 0; m < 4; ++m) { const int row = row0 + ai * HALF + m * 16;
                const f32x4 s0 = *(const f32x4*)(SSQ + (size_t)row * 8), s1 = *(const f32x4*)(SSQ + (size_t)row * 8 + 4);
                const float ss = ((s0[0] + s0[1]) + (s0[2] + s0[3])) + ((s1[0] + s1[1]) + (s1[2] + s1[3]));
                const float sc = QSCALE / sqrtf(ss * (1.0f / 512.0f) + RMS_EPS);
                if (u.pn < 4) { bf16_t* rowp = QN + (size_t)row * 1024 + u.pn * BM + wc * 32 + 8 * fq;
#pragma unroll
                    for (int bj = 0; bj < 2; ++bj) { const f32x4 v0 = acc[ai][bj][m][0] * sc, v1 = acc[ai][bj][m][1] * sc;
                        u32x4 w; w.x = cvt_pk_bf16(v0[0], v0[1]); w.y = cvt_pk_bf16(v0[2], v0[3]); w.z = cvt_pk_bf16(v1[0], v1[1]); w.w = cvt_pk_bf16(v1[2], v1[3]);
                        *(u32x4*)(rowp + bj * HALF) = w; }
                } else { const int pi = posidx_of_row(row);
                    const f32x4 cs = *(const f32x4*)(COS + pi * 16 + 4 * fq), sn = *(const f32x4*)(SIN + pi * 16 + 4 * fq);
#pragma unroll
                    for (int bj = 0; bj < 2; ++bj) { const f32x4 x1 = acc[ai][bj][m][0] * sc, x2 = acc[ai][bj][m][1] * sc;
                        const f32x4 o1 = x1 * cs - x2 * sn, o2 = x1 * sn + x2 * cs;
                        bf16_t* hp = QR + (size_t)row * 512 + ((u.pn - 4) * 8 + 4 * bj + wc) * 32 + 4 * fq;
                        u32x2 w1, w2; w1.x = cvt_pk_bf16(o1[0], o1[1]); w1.y = cvt_pk_bf16(o1[2], o1[3]); w2.x = cvt_pk_bf16(o2[0], o2[1]); w2.y = cvt_pk_bf16(o2[2], o2[3]);
                        *(u32x2*)hp = w1; *(u32x2*)(hp + 16) = w2; } }
            }
    }
};


struct EpiPartF32 {
    static constexpr bool PERM = true, AFTER_DRAIN = false;
    float* P; int ksub;
    __device__ __forceinline__ void operator()(const f32x4 (&acc)[2][2][4][2], const Unit& u, int wr, int wc, int fr, int fq) const {
        float* base = P + ((size_t)(u.koff / ksub) * 768 + (size_t)(u.pm - 64) * BM + wr * 64 + fr) * 1024 + u.pn * BM + wc * 32 + 8 * fq;
#pragma unroll
        for (int ai = 0; ai < 2; ++ai)
#pragma unroll
            for (int m = 0; m < 4; ++m) { float* rowp = base + (size_t)(ai * HALF + m * 16) * 1024;
#pragma unroll
                for (int bj = 0; bj < 2; ++bj) { *(f32x4*)(rowp + bj * HALF) = acc[ai][bj][m][0]; *(f32x4*)(rowp + bj * HALF + 4) = acc[ai][bj][m][1]; } }
    }
};
template <class Epi, class Sched, bool ALIGN_EPI = false, bool SP2 = false>
__device__ __forceinline__ void gemm_phase(PG8_LAS unsigned char* lds, const Gemm g, const Sched& S, const Epi& E, const int wave) {
    int wave_ = wave; asm volatile("" : "+s"(wave_)); wave_ &= 7;
    const int lane = lane_fresh(), tid = wave_ * 64 + lane, wid = wave_, wr = wid >> 2, wc = wid & 3, fr = lane & 15, fq = lane >> 4;
    const int K = g.K, nt = K / BK, ld = g.ld ? g.ld : g.K;
    unsigned voffA[2], voffB[2];
#pragma unroll
    for (int i = 0; i < 2; ++i) { int R, C; stage_rc(tid * 16 + i * 8192, R, C); const int Rb = Epi::PERM ? ((R & ~31) + perm32(R & 31)) : R;
        voffA[i] = (unsigned)(R * ld + C) * 2u; voffB[i] = (unsigned)(Rb * ld + C) * 2u; }
    const size_t kstep = (size_t)(BK * 2);
    const size_t hstep = (size_t)HALF * ld * 2;
    const size_t tstep = 2 * hstep;
    const unsigned ldsw = (unsigned)wid * 1024u;
    const int aoff = lds_byte(wr * 64 + fr, fq * 8), boff = lds_byte(wc * 32 + fr, fq * 8);
#define PG8_SA(b, h) (((b) * 2 + (h)) * HTB)
#define PG8_SB(b, h) ((4 + (b) * 2 + (h)) * HTB)
#define PG8_STAGE(bufoff, gbase, voff) do { _Pragma("unroll") for (int _i = 0; _i < 2; ++_i) \
        __builtin_amdgcn_global_load_lds((const unsigned*)((const char*)(gbase) + (voff)[_i]), (PG8_LAS unsigned*)(lds + (bufoff) + ldsw + _i * 8192), 16, 0, 0); } while (0)
#define PG8_LDA(dst, b, h) do { _Pragma("unroll") for (int m = 0; m < 4; ++m) _Pragma("unroll") for (int k = 0; k < 2; ++k) dst[m][k] = *(const PG8_LAS bf16x8*)(lds + PG8_SA(b, h) + aoff + m * 2048 + k * 1024); } while (0)
#define PG8_LDB(dst, b, h) do { _Pragma("unroll") for (int n = 0; n < 2; ++n) _Pragma("unroll") for (int k = 0; k < 2; ++k) dst[n][k] = *(const PG8_LAS bf16x8*)(lds + PG8_SB(b, h) + boff + n * 2048 + k * 1024); } while (0)
#define PG8_MMA(ai, bj, At, Bt) do { __builtin_amdgcn_s_setprio(1); _Pragma("unroll") for (int m = 0; m < 4; ++m) _Pragma("unroll") for (int n = 0; n < 2; ++n) _Pragma("unroll") for (int k = 0; k < 2; ++k) \
        acc[ai][bj][m][n] = __builtin_amdgcn_mfma_f32_16x16x32_bf16(Bt[n][k], At[m][k], acc[ai][bj][m][n], 0, 0, 0); __builtin_amdgcn_s_setprio(0); } while (0)
#define PG8_WAIT_V(n) asm volatile("s_waitcnt vmcnt(" #n ")" ::: "memory")
#define PG8_WAIT_L(n) asm volatile("s_waitcnt lgkmcnt(" #n ")" ::: "memory")
#define PG8_BAR __builtin_amdgcn_s_barrier()
#define PG8_SCHED __builtin_amdgcn_sched_barrier(0)
    Unit cur, nxt; int ui = 0;
    if (!S.next(0, cur)) return;
    f32x4 acc[2][2][4][2];
    float zf_ = 0.f; asm volatile("" : "+v"(zf_));
#pragma unroll
    for (int a = 0; a < 2; ++a)
#pragma unroll
        for (int b = 0; b < 2; ++b)
#pragma unroll
            for (int m = 0; m < 4; ++m)
#pragma unroll
                for (int n = 0; n < 2; ++n) acc[a][b][m][n] = (f32x4){zf_, zf_, zf_, zf_};
    bf16x8 At[4][2], B0[2][2], B1[2][2];
    const char* cA = (const char*)g.A + (size_t)cur.pm * tstep + (size_t)cur.koff * 2; const char* cB = (const char*)g.Bt + (size_t)cur.pn * tstep + (size_t)cur.koff * 2;
    S.a_ready(cur);
    if constexpr (SP2) {
        PG8_STAGE(PG8_SB(0, 0), cB, voffB); PG8_STAGE(PG8_SB(0, 1), cB + hstep, voffB); PG8_STAGE(PG8_SA(0, 0), cA, voffA); PG8_STAGE(PG8_SA(0, 1), cA + hstep, voffA);
        if (wr == 1) PG8_BAR;
        PG8_WAIT_V(2); PG8_BAR;
        PG8_STAGE(PG8_SB(1, 0), cB + kstep, voffB); PG8_STAGE(PG8_SA(1, 0), cA + kstep, voffA); PG8_STAGE(PG8_SB(1, 1), cB + hstep + kstep, voffB);
        PG8_WAIT_V(6); PG8_BAR;
    } else {
        PG8_STAGE(PG8_SB(0, 0), cB, voffB); PG8_STAGE(PG8_SA(0, 0), cA, voffA); PG8_STAGE(PG8_SB(0, 1), cB + hstep, voffB); PG8_STAGE(PG8_SA(0, 1), cA + hstep, voffA);
        if (wr == 1) PG8_BAR;
        PG8_WAIT_V(4); PG8_BAR;
        PG8_STAGE(PG8_SB(1, 0), cB + kstep, voffB); PG8_STAGE(PG8_SA(1, 0), cA + kstep, voffA); PG8_STAGE(PG8_SB(1, 1), cB + hstep + kstep, voffB);
        PG8_WAIT_V(6); PG8_BAR;
    }
    for (;;) {
        const bool has_next = S.next(ui + 1, nxt);
        const char* nA = has_next ? (const char*)g.A + (size_t)nxt.pm * tstep + (size_t)nxt.koff * 2 : cA; const char* nB = has_next ? (const char*)g.Bt + (size_t)nxt.pn * tstep + (size_t)nxt.koff * 2 : cB;
        for (int t = 0; t < nt; t += 2) {
            const bool last = (t == nt - 2);
            const char* a1 = cA + (size_t)(t + 1) * kstep;
            const char* a2 = last ? nA : cA + (size_t)(t + 2) * kstep; const char* b2 = last ? nB : cB + (size_t)(t + 2) * kstep;
            const char* a3 = a2 + kstep; const char* b3 = b2 + kstep;
            if (last && has_next) S.a_ready(nxt);
            if constexpr (SP2) {
            PG8_LDB(B0, 0, 0); PG8_LDB(B1, 0, 1); PG8_SCHED; PG8_LDA(At, 0, 0); PG8_STAGE(PG8_SA(1, 1), a1 + hstep, voffA);
            PG8_WAIT_V(8); PG8_WAIT_L(0); PG8_BAR; PG8_MMA(0, 0, At, B0); PG8_MMA(0, 1, At, B1); PG8_BAR; PG8_SCHED;
            PG8_LDA(At, 0, 1); PG8_STAGE(PG8_SB(0, 0), b2, voffB); PG8_STAGE(PG8_SB(0, 1), b2 + hstep, voffB); PG8_STAGE(PG8_SA(0, 0), a2, voffA);
            PG8_WAIT_V(8); PG8_WAIT_L(0); PG8_BAR; PG8_MMA(1, 0, At, B0); PG8_MMA(1, 1, At, B1); PG8_BAR; PG8_SCHED;
            PG8_LDB(B0, 1, 0); PG8_LDB(B1, 1, 1); PG8_SCHED; PG8_LDA(At, 1, 0); PG8_STAGE(PG8_SA(0, 1), a2 + hstep, voffA);
            PG8_WAIT_V(8); PG8_WAIT_L(0); PG8_BAR; PG8_MMA(0, 0, At, B0); PG8_MMA(0, 1, At, B1); PG8_BAR; PG8_SCHED;
            PG8_LDA(At, 1, 1); PG8_STAGE(PG8_SB(1, 0), b3, voffB); PG8_STAGE(PG8_SB(1, 1), b3 + hstep, voffB); PG8_STAGE(PG8_SA(1, 0), a3, voffA);
            PG8_WAIT_V(8); PG8_WAIT_L(0); PG8_BAR; PG8_MMA(1, 0, At, B0); PG8_MMA(1, 1, At, B1); PG8_BAR; PG8_SCHED;
            } else {
            PG8_LDB(B0, 0, 0); PG8_SCHED; PG8_LDA(At, 0, 0); PG8_STAGE(PG8_SA(1, 1), a1 + hstep, voffA);
            PG8_WAIT_L(8); PG8_BAR; PG8_WAIT_L(0); PG8_MMA(0, 0, At, B0); PG8_BAR; PG8_SCHED;
            PG8_LDB(B1, 0, 1); PG8_STAGE(PG8_SB(0, 0), b2, voffB);
            PG8_BAR; PG8_WAIT_L(0); PG8_MMA(0, 1, At, B1); PG8_BAR;
            PG8_LDA(At, 0, 1); PG8_STAGE(PG8_SA(0, 0), a2, voffA);
            PG8_BAR; PG8_WAIT_L(0); PG8_MMA(1, 0, At, B0); PG8_BAR; PG8_SCHED;
            PG8_STAGE(PG8_SB(0, 1), b2 + hstep, voffB);
            PG8_WAIT_V(6); PG8_BAR; PG8_MMA(1, 1, At, B1); PG8_BAR;
            PG8_LDB(B0, 1, 0); PG8_SCHED; PG8_LDA(At, 1, 0); PG8_STAGE(PG8_SA(0, 1), a2 + hstep, voffA);
            PG8_WAIT_L(8); PG8_BAR; PG8_WAIT_L(0); PG8_MMA(0, 0, At, B0); PG8_BAR; PG8_SCHED;
            PG8_LDB(B1, 1, 1); PG8_STAGE(PG8_SB(1, 0), b3, voffB);
            PG8_BAR; PG8_WAIT_L(0); PG8_MMA(0, 1, At, B1); PG8_BAR;
            PG8_LDA(At, 1, 1); PG8_STAGE(PG8_SA(1, 0), a3, voffA);
            PG8_BAR; PG8_WAIT_L(0); PG8_MMA(1, 0, At, B0); PG8_BAR; PG8_SCHED;
            PG8_STAGE(PG8_SB(1, 1), b3 + hstep, voffB);
            PG8_WAIT_V(6); PG8_BAR; PG8_MMA(1, 1, At, B1); PG8_BAR;
            }
        }
        if constexpr (ALIGN_EPI) { if (wr == 0) PG8_BAR; }
        if constexpr (!Epi::AFTER_DRAIN) { const int ln_ = lane_fresh(); const int fr_ = ln_ & 15, fq_ = ln_ >> 4;
            E(acc, cur, wr, wc, fr_, fq_); S.done(cur); }
        if (!has_next) break;
        float zg_ = 0.f; asm volatile("" : "+v"(zg_));
#pragma unroll
        for (int a = 0; a < 2; ++a)
#pragma unroll
            for (int b = 0; b < 2; ++b)
#pragma unroll
                for (int m = 0; m < 4; ++m)
#pragma unroll
                    for (int n = 0; n < 2; ++n) acc[a][b][m][n] = (f32x4){zg_, zg_, zg_, zg_};
        cur = nxt; cA = nA; cB = nB; ++ui;
        if constexpr (ALIGN_EPI) { if (wr == 1) PG8_BAR; }
    }
    PG8_WAIT_V(0);
    if constexpr (!ALIGN_EPI) { if (wr == 0) PG8_BAR; }
    PG8_BAR;
    if constexpr (Epi::AFTER_DRAIN) { E.fused(acc, cur, wr, wc, fr, fq, lds, wid, lane); S.done(cur); }
#undef PG8_SA
#undef PG8_SB
#undef PG8_STAGE
#undef PG8_LDA
#undef PG8_LDB
#undef PG8_MMA
#undef PG8_WAIT_V
#undef PG8_WAIT_L
#undef PG8_BAR
#undef PG8_SCHED
}
}
#define GAS __attribute__((address_space(1)))
#define LAS __attribute__((address_space(3)))
typedef unsigned short bf16;
typedef unsigned v4u __attribute__((ext_vector_type(4)));
typedef float f32x4 __attribute__((ext_vector_type(4)));
typedef short bf16x8 __attribute__((ext_vector_type(8)));
typedef GAS unsigned gu32;
typedef GAS unsigned long long gu64;
#define RLX_AGENT __ATOMIC_RELAXED, __HIP_MEMORY_SCOPE_AGENT
#define LDS_WAIT() asm volatile("s_waitcnt lgkmcnt(0)" ::: "memory")
#define VM_WAIT() asm volatile("s_waitcnt vmcnt(0)" ::: "memory")
__device__ __forceinline__ unsigned long long rt() { return __builtin_amdgcn_s_memrealtime(); }
__device__ __forceinline__ unsigned f2bf(float f) { unsigned u = __builtin_bit_cast(unsigned, f); return (u + 0x7fffu + ((u >> 16) & 1u)) >> 16; }
__device__ __forceinline__ unsigned pk2(float lo, float hi) { return f2bf(lo) | (f2bf(hi) << 16); }

#define XB_TMO      128
#define XB_XCNT(j)  (256  + 64 * (j))
#define XB_XSUB(j)  (1280 + 64 * (j))
#define XB_XGEN(j)  (2304 + 64 * (j))
#define XB_TOP      3328
#define XB_TOPGEN   3392
#define XCD_BAR_WORDS 3456
#define XB_SPIN_CAP (1u << 18)

__device__ __forceinline__ unsigned xb_ld(unsigned* p)              { return __hip_atomic_load(p, __ATOMIC_RELAXED, __HIP_MEMORY_SCOPE_AGENT); }
__device__ __forceinline__ unsigned xb_add(unsigned* p, unsigned v) { return __hip_atomic_fetch_add(p, v, __ATOMIC_RELAXED, __HIP_MEMORY_SCOPE_AGENT); }
__device__ __forceinline__ unsigned xb_xcc_id() { return (unsigned)__builtin_amdgcn_s_getreg((3 << 11) | 20) & 0xFu; }
#define XB_SPIN(cond, bar) do { unsigned _sp = 0; while (cond) { __builtin_amdgcn_s_sleep(1); \
    if ((++_sp & 255u) == 0u) { if (xb_ld(&(bar)[XB_TMO])) break; if (_sp > XB_SPIN_CAP) { atomicAdd(&(bar)[XB_TMO], 1u); break; } } } } while (0)

struct XcdBarrier {
    unsigned* bar; unsigned x;
    volatile LAS unsigned* st;
};

__device__ __forceinline__ XcdBarrier xcd_barrier_post(unsigned* bar, volatile LAS unsigned* st, const bool is_t0) {
    XcdBarrier b; b.bar = bar; b.x = xb_xcc_id(); b.st = st;
    if (is_t0) (void)xb_add(&bar[XB_XCNT(b.x)], 1u);
    return b;
}
__device__ __forceinline__ void xcd_barrier_complete(unsigned* bar, unsigned x, unsigned& nloc, unsigned& nx) {
    const unsigned G = gridDim.x * gridDim.y * gridDim.z;
    unsigned sum, cnt, mine, sp = 0u;
    for (;;) {
        sum = 0u; cnt = 0u; mine = 0u;
#pragma unroll
        for (unsigned j = 0; j < 16; ++j) { const unsigned c = xb_ld(&bar[XB_XCNT(j)]); sum += c; cnt += (c > 0u) ? 1u : 0u; mine = (j == x) ? c : mine; }
        if (sum == G) break;
        __builtin_amdgcn_s_sleep(1);
        if ((++sp & 255u) == 0u) { if (xb_ld(&bar[XB_TMO])) break; if (sp > XB_SPIN_CAP) { atomicAdd(&bar[XB_TMO], 1u); break; } }
    }
    nloc = mine > 0u ? mine : 1u; nx = cnt > 0u ? cnt : 1u;
}

__device__ __forceinline__ void xcd_barrier(const XcdBarrier& b, const bool is_t0) {
    asm volatile("s_waitcnt vmcnt(0)" ::: "memory");
    __syncthreads();
    if (is_t0) {
        unsigned* bar = b.bar;
        __builtin_amdgcn_s_waitcnt(0);
        unsigned nloc = b.st[0], nx = b.st[1];
        if (nloc == 0u) { xcd_barrier_complete(bar, b.x, nloc, nx); b.st[0] = nloc; b.st[1] = nx; }
        const unsigned old = xb_add(&bar[XB_XSUB(b.x)], 1u);
        const unsigned gen = old / nloc;
        if (old + 1u == (gen + 1u) * nloc) {
            __builtin_amdgcn_fence(__ATOMIC_RELEASE, "agent");
            asm volatile("s_waitcnt vmcnt(0)" ::: "memory");
            const unsigned og = xb_add(&bar[XB_TOP], 1u);
            const unsigned tg = og / nx;
            if (og + 1u == (tg + 1u) * nx) xb_add(&bar[XB_TOPGEN], 1u);
            else XB_SPIN(xb_ld(&bar[XB_TOPGEN]) == tg, bar);
            __builtin_amdgcn_fence(__ATOMIC_ACQUIRE, "agent");
            xb_add(&bar[XB_XGEN(b.x)], 1u);
            asm volatile("s_waitcnt vmcnt(0)" ::: "memory");
        } else {
            XB_SPIN(xb_ld(&bar[XB_XGEN(b.x)]) == gen, bar);
            __builtin_amdgcn_fence(__ATOMIC_ACQUIRE, "agent");
            asm volatile("s_waitcnt vmcnt(0)" ::: "memory");
        }
    }
    __syncthreads();
}

constexpr size_t MiB = 1u << 20;
constexpr size_t WS_CTL = 0, CTL_ZERO_BYTES = 64 * 1024;
constexpr int CW_BAR = 1024;
constexpr int CW_Q = 8192;
constexpr size_t WS_COS = 1 * MiB;
constexpr size_t WS_SIN = WS_COS + 512 * 1024;
constexpr size_t WS_WIN  = 2 * MiB;
constexpr size_t WS_WOC  = WS_WIN + 16 * MiB;
constexpr size_t WS_WA0  = WS_WOC + 4 * MiB;
constexpr size_t WS_WA1  = WS_WA0 + 4 * MiB;
constexpr size_t WS_WUKV = WS_WA1 + 3 * MiB;
constexpr size_t WS_WUQ  = WS_WUKV + 1 * MiB;
constexpr size_t WS_WOM  = WS_WUQ + 3 * MiB;
constexpr size_t WS_WUKB = WS_WOM + 4 * MiB;
constexpr size_t WS_ACT  = 40 * MiB;
constexpr size_t SZ_F32R = (size_t)NROWS * 1024 * 4, SZ_BFR = (size_t)NROWS * 1024 * 2;
constexpr size_t WS_X    = WS_ACT;
constexpr size_t WS_XH   = WS_X + SZ_F32R;
constexpr size_t WS_V1   = WS_XH + SZ_BFR;
constexpr size_t WS_GZ   = WS_V1 + SZ_BFR;
constexpr size_t WS_G    = WS_GZ + SZ_BFR;
constexpr size_t WS_MB   = WS_G + SZ_BFR;
constexpr size_t WS_CKR  = WS_MB + SZ_BFR;
constexpr size_t WS_CB   = WS_CKR + (size_t)NROWS * 512 * 4;
constexpr size_t WS_KRB  = WS_CB + (size_t)NROWS * 256 * 2;
constexpr size_t WS_KN   = WS_KRB + (size_t)NROWS * 32 * 2;
constexpr size_t WS_VV   = WS_KN + SZ_BFR;
constexpr size_t WS_QL   = WS_VV + SZ_BFR;
constexpr size_t WS_SSQ  = WS_QL + (size_t)NROWS * 512 * 2;
constexpr size_t WS_SZ   = WS_SSQ + (size_t)NROWS * 8 * 4;
constexpr size_t WS_QN   = WS_SZ + SZ_BFR;
constexpr size_t WS_QR   = WS_QN + SZ_BFR;
constexpr size_t WS_OG   = WS_QR + (size_t)NROWS * 512 * 2;
constexpr size_t WS_PART = WS_OG + SZ_BFR;
constexpr size_t WS_PML  = WS_PART + (size_t)DECB * 4 * 64 * 256 * 4;
constexpr size_t WS_QABS = WS_PML + (size_t)DECB * 4 * 2 * 64 * 4;
constexpr int GOUT_SPLITK = 8;
constexpr size_t WS_PARTG = WS_QABS + (size_t)DECB * 64 * 288 * 2;
constexpr size_t WS_END  = WS_PARTG + (size_t)GOUT_SPLITK * 768 * 1024 * 4;
static_assert(WS_WUKB + 1 * MiB <= WS_ACT && WS_END < 1024 * MiB, "d_ws map");

constexpr size_t O_YP = 0, O_YS = O_YP + (size_t)NB * SEQ * DM, O_CKP = O_YS + (size_t)NSAMP * DM, O_KRP = O_CKP + (size_t)NB * TTOT * KVL,
                 O_CVP = O_KRP + (size_t)NB * TTOT * QKR, O_CKS = O_CVP + (size_t)2 * NB * 2 * DM, O_KRS = O_CKS + (size_t)NSAMP * KVL,
                 O_CVS = O_KRS + (size_t)NSAMP * QKR, O_END = O_CVS + (size_t)2 * DECB * 2 * DM;

#ifndef TAIL_CONV
#define TAIL_CONV 1
#endif
constexpr size_t WS_RS = WS_XH;
constexpr int RING_BYTES = 131072;
constexpr int LDS_BYTES = 163840;
constexpr int LDSCTL_OFF = LDS_BYTES - 64;
constexpr int NWAVES = 8;

struct Args {
    const float* x_prompt; const float* x_sample; const float* cache_ckv; const float* cache_krope; const float* state_conv; const int* page_table;
    const float* meta; const float* pre_g; const float* post_g; const float* w_in_conv; const float* conv_w; const float* w_out_conv;
    const float* kv_norm_g; const float* w_dkv; const float* kv_lat_g; const float* w_uk; const float* w_uv; const float* w_in_mla;
    const float* q_norm_g; const float* w_uq; const float* w_out_mla;
    float* out; unsigned char* ws;
};

typedef unsigned short bf16;
typedef short bf16x8 __attribute__((ext_vector_type(8)));
typedef float f32x4 __attribute__((ext_vector_type(4)));
typedef float f32x8 __attribute__((ext_vector_type(8)));
typedef float f32x16 __attribute__((ext_vector_type(16)));
typedef unsigned u32x4 __attribute__((ext_vector_type(4)));
typedef unsigned u32x2 __attribute__((ext_vector_type(2)));
typedef short s16x4 __attribute__((ext_vector_type(4)));
#define LDS_WAIT() asm volatile("s_waitcnt lgkmcnt(0)" ::: "memory")
#define VM_WAIT() asm volatile("s_waitcnt vmcnt(0)" ::: "memory")
#define SBAR() __builtin_amdgcn_sched_barrier(0)
typedef float f32x2_t __attribute__((ext_vector_type(2))); typedef __bf16 bf16x2_t __attribute__((ext_vector_type(2)));
__device__ __forceinline__ unsigned cvtpk(float lo, float hi) { f32x2_t v = {lo, hi}; bf16x2_t b = __builtin_convertvector(v, bf16x2_t); return __builtin_bit_cast(unsigned, b); }
__device__ __forceinline__ float bf2f(unsigned short b) { return __uint_as_float((unsigned)b << 16); }
__device__ __forceinline__ float bflo(unsigned w) { return __uint_as_float(w << 16); }
__device__ __forceinline__ float bfhi(unsigned w) { return __uint_as_float(w & 0xffff0000u); }
__device__ __forceinline__ float wave_sum(float v, int lane) {
#pragma unroll
    for (int o = 1; o < 64; o <<= 1) v += shfl_xor_f(v, o, lane);
    return v;
}

template <class DestRow>
__device__ __forceinline__ void transpose_item(const float* __restrict__ W, int K, int N, const float* __restrict__ gain, bf16* WT, const DestRow& dest, LAS float* scr, int item, int lane) {
    const int nblk = N / 32, kb = item / nblk, nb = item % nblk, k0 = 64 * kb, n0 = 32 * nb;
#pragma unroll 8
    for (int i = 0; i < 32; ++i) { const int kk = 2 * i + (lane >> 5); float w = W[(size_t)(k0 + kk) * N + n0 + (lane & 31)]; if (gain) w *= gain[k0 + kk]; scr[kk * 33 + (lane & 31)] = w; }
    LDS_WAIT(); asm volatile("" ::: "memory");
    const int c = lane & 7;
#pragma unroll
    for (int j = 0; j < 4; ++j) { const int n = (lane >> 3) + 8 * j; const LAS float* s = scr + (8 * c) * 33 + n;
        u32x4 o; o.x = cvtpk(s[0 * 33], s[1 * 33]); o.y = cvtpk(s[2 * 33], s[3 * 33]); o.z = cvtpk(s[4 * 33], s[5 * 33]); o.w = cvtpk(s[6 * 33], s[7 * 33]);
        *(u32x4*)(WT + (size_t)dest(n0 + n) * K + k0 + 8 * c) = o; }
    LDS_WAIT(); asm volatile("" ::: "memory");
}
struct DestIdent { int off; __device__ __forceinline__ int operator()(int n) const { return off + n; } };
struct DestConvIn {
    __device__ __forceinline__ int operator()(int n) const { const int p = n >> 10, ch = n & 1023, cl = ch & 63; return (ch >> 6) * 256 + (p >> 1) * 128 + (cl >> 4) * 32 + ((cl >> 2) & 3) * 8 + (p & 1) * 4 + (cl & 3); } };
struct DestUq {
    __device__ __forceinline__ int operator()(int n) const { const int h = n / 96, t = n - h * 96; if (t < 64) return h * 64 + t; const int el = t - 64, i = el & 15;
        return 1024 + (h >> 3) * 256 + ((h & 7) >> 2) * 128 + (h & 3) * 32 + (i >> 2) * 8 + (el >> 4) * 4 + (i & 3); } };

__device__ __forceinline__ void x_row_store(const f32x4 (&v)[4], bf16* xrow, float* rs, int lane) {
    float s = 0.f;
#pragma unroll
    for (int j = 0; j < 4; ++j) s += (v[j].x * v[j].x + v[j].y * v[j].y) + (v[j].z * v[j].z + v[j].w * v[j].w);
    const float r = 1.0f / sqrtf(wave_sum(s, lane) * (1.0f / 1024.0f) + RMS_EPS);
    u32x2* o8 = (u32x2*)xrow + lane;
#pragma unroll
    for (int j = 0; j < 4; ++j) { u32x2 w; w.x = cvtpk(v[j].x, v[j].y); w.y = cvtpk(v[j].z, v[j].w); o8[64 * j] = w; }
    if (lane == 0) *rs = r;
}

template <class DestRow>
__device__ __forceinline__ void transpose_item64(const float* __restrict__ W, int K, int N, const float* __restrict__ gain, bf16* WT, const DestRow& dest, LAS float* scr, int item, int lane) {
    const int nblk = N / 64, kb = item / nblk, nb = item % nblk, k0 = 64 * kb, n0 = 64 * nb;
    float wv[64];
#pragma unroll
    for (int i = 0; i < 64; ++i) wv[i] = W[(size_t)(k0 + i) * N + n0 + lane];
#pragma unroll
    for (int i = 0; i < 64; ++i) { float w = wv[i]; if (gain) w *= gain[k0 + i]; scr[i * 65 + lane] = w; }
    LDS_WAIT(); asm volatile("" ::: "memory");
#pragma unroll
    for (int jj = 0; jj < 8; ++jj) { const int p = lane + 64 * jj, n = p >> 3, c = p & 7; const LAS float* s = scr + (8 * c) * 65 + n;
        u32x4 o; o.x = cvtpk(s[0 * 65], s[1 * 65]); o.y = cvtpk(s[2 * 65], s[3 * 65]); o.z = cvtpk(s[4 * 65], s[5 * 65]); o.w = cvtpk(s[6 * 65], s[7 * 65]);
        *(u32x4*)(WT + (size_t)dest(n0 + n) * K + k0 + 8 * c) = o; }
    LDS_WAIT(); asm volatile("" ::: "memory");
}
__device__ __forceinline__ void convert_set(const Args& A, const int set, LAS unsigned char* lds, int iw, int nw, int wave, int lane) {
    unsigned char* ws = A.ws;
    LAS float* scr = (LAS float*)(lds + wave * 16640);
    constexpr int I_WIN = 16 * 64, I_SQ = 16 * 16, I_DKV = (1024 / 64) * (288 / 32), I_INM = 16 * 24, I_UKV = 4 * 16, I_UQ = 8 * 24;
    if (set == 0 || set == 1) { const int l = set;
        for (int it = iw; it < I_WIN + I_SQ; it += nw) {
            if (it < I_WIN) transpose_item64(A.w_in_conv + (size_t)l * 1024 * 4096, 1024, 4096, A.pre_g + l * 1024, (bf16*)(ws + WS_WIN) + (size_t)l * 4096 * 1024, DestConvIn{}, scr, it, lane);
            else transpose_item64(A.w_out_conv + (size_t)l * 1024 * 1024, 1024, 1024, nullptr, (bf16*)(ws + WS_WOC) + (size_t)l * 1024 * 1024, DestIdent{0}, scr, it - I_WIN, lane); }
    } else if (set == 2) {
        for (int it = iw; it < I_DKV + 2 * I_INM; it += nw) {
            if (it < I_DKV) transpose_item(A.w_dkv, 1024, 288, A.kv_norm_g, (bf16*)(ws + WS_WA0), DestIdent{0}, scr, it, lane);
            else { const int r = it - I_DKV, j = r / I_INM; transpose_item64(A.w_in_mla + (size_t)j * 1024 * 1536, 1024, 1536, A.pre_g + (2 + j) * 1024, (bf16*)(ws + (j ? WS_WA1 : WS_WA0)), DestIdent{j ? 0 : 512}, scr, r % I_INM, lane); } }
        { unsigned z_ = 0u; asm volatile("" : "+v"(z_));
          for (int i = iw * 64 + lane; i < 224 * 128; i += nw * 64) ((u32x4*)((bf16*)(ws + WS_WA0) + 288 * 1024))[i] = (u32x4){z_, z_, z_, z_}; }
    } else if (set == 3) {
        for (int it = iw; it < 2 * I_UKV + 2 * I_UQ; it += nw) {
            if (it < 2 * I_UKV) { const int j = it / I_UKV; transpose_item64(j ? A.w_uv : A.w_uk, 256, 1024, nullptr, (bf16*)(ws + WS_WUKV), DestIdent{j * 1024}, scr, it % I_UKV, lane); }
            else { const int r = it - 2 * I_UKV, j = r / I_UQ; transpose_item64(A.w_uq + (size_t)j * 512 * 1536, 512, 1536, A.q_norm_g + j * 512, (bf16*)(ws + WS_WUQ) + (size_t)j * 1536 * 512, DestUq{}, scr, r % I_UQ, lane); } }
        for (int i = iw * 64 + lane; i < 256 * 1024 / 8; i += nw * 64) { const f32x4 a = ((const f32x4*)A.w_uk)[2 * i], b = ((const f32x4*)A.w_uk)[2 * i + 1];
            u32x4 w; w.x = cvtpk(a.x, a.y); w.y = cvtpk(a.z, a.w); w.z = cvtpk(b.x, b.y); w.w = cvtpk(b.z, b.w); ((u32x4*)(ws + WS_WUKB))[i] = w; }
    } else {
        for (int it = iw; it < 2 * I_SQ; it += nw) { const int j = it / I_SQ; transpose_item64(A.w_out_mla + (size_t)j * 1024 * 1024, 1024, 1024, nullptr, (bf16*)(ws + WS_WOM) + (size_t)j * 1024 * 1024, DestIdent{0}, scr, it % I_SQ, lane); }
    }
}

__device__ __forceinline__ void p0_prologue(const Args& A, LAS unsigned char* lds, int gw, int NGW, int wave, int lane) {
    unsigned char* ws = A.ws;
    convert_set(A, 0, lds, gw, NGW, wave, lane);
#if !TAIL_CONV
    convert_set(A, 1, lds, gw, NGW, wave, lane); convert_set(A, 2, lds, gw, NGW, wave, lane); convert_set(A, 3, lds, gw, NGW, wave, lane); convert_set(A, 4, lds, gw, NGW, wave, lane);
#endif
    for (int i = gw * 64 + lane; i < NPOS * 16; i += NGW * 64) { const int p = i >> 4, e = i & 15; const float pos = (float)(p < TTOT ? p : PAST + (p - TTOT));
        const float inv = powf(10000.0f, -(float)e / 16.0f); const float ang = pos * inv; ((float*)(ws + WS_COS))[i] = cosf(ang); ((float*)(ws + WS_SIN))[i] = sinf(ang); }
    for (int row0 = gw; row0 < NROWS; row0 += 4 * NGW) {
        f32x4 v[4][4];
#pragma unroll
        for (int k = 0; k < 4; ++k) { const int row = row0 + k * NGW < NROWS ? row0 + k * NGW : row0;
            const float* src = row < NMAIN ? A.x_prompt + (size_t)row * 1024 : (row < META0 ? A.x_sample + (size_t)(row - SAMP0) * 1024 : (row < META0 + NMETA ? A.meta + (size_t)(row - META0) * 1024 : nullptr));
#pragma unroll
            for (int j = 0; j < 4; ++j) v[k][j] = src ? ((const f32x4*)src)[lane + 64 * j] : (f32x4){0.f, 0.f, 0.f, 0.f}; }
#pragma unroll
        for (int k = 0; k < 4; ++k) { const int row = row0 + k * NGW; if (row < NROWS) {
            x_row_store(v[k], (bf16*)(ws + WS_X) + (size_t)row * 1024, (float*)(ws + WS_RS) + row, lane); } }
    }
}

__device__ __forceinline__ void conv_phase(const Args& A, int layer, int gw, int NGW, int lane) {
    unsigned char* ws = A.ws; const bf16* V = (const bf16*)(ws + WS_V1); const bf16* GZ = (const bf16*)(ws + WS_GZ); bf16* G = (bf16*)(ws + WS_G);
    const float* cw = A.conv_w + (size_t)layer * 3 * 1024;
    const int c0 = (gw & 1) * 512 + lane * 8, gr = gw >> 1, NGR = NGW >> 1;
    float w0[8], w1[8], w2[8];
#pragma unroll
    for (int k = 0; k < 2; ++k) { const f32x4 t0 = *(const f32x4*)(cw + c0 + 4 * k), t1 = *(const f32x4*)(cw + 1024 + c0 + 4 * k), t2 = *(const f32x4*)(cw + 2048 + c0 + 4 * k);
#pragma unroll
        for (int e = 0; e < 4; ++e) { w0[4 * k + e] = t0[e]; w1[4 * k + e] = t1[e]; w2[4 * k + e] = t2[e]; } }
    for (int row0 = gr; row0 < NROWS; row0 += 4 * NGR) {
        u32x4 v0[4], gz[4]; float a1[4][8], a2[4][8];
#pragma unroll
        for (int q = 0; q < 4; ++q) { const int row = row0 + q * NGR < NROWS ? row0 + q * NGR : row0;
            int r1, r2; const float* s1 = nullptr; const float* s2 = nullptr;
            if (row < NMAIN) { const int i = row & (SEQ - 1); r1 = i >= 1 ? row - 1 : META0 + 15; r2 = i >= 2 ? row - 2 : META0 + 14 + i; }
            else if (row < META0) { const int s = row - SAMP0, b = s >> 2, l = s & 3; const float* st = A.state_conv + ((size_t)layer * DECB + b) * 2 * 1024;
                if (l >= 1) r1 = row - 1; else { r1 = -2; s1 = st + 1024; }
                if (l >= 2) r2 = row - 2; else { r2 = -2; s2 = st + l * 1024; } }
            else if (row < META0 + NMETA) { const int j = row - META0; r1 = j >= 1 ? row - 1 : -1; r2 = j >= 2 ? row - 2 : -1; }
            else { r1 = -1; r2 = -1; }
            v0[q] = *(const u32x4*)(V + (size_t)row * 1024 + c0); gz[q] = *(const u32x4*)(GZ + (size_t)row * 1024 + c0);
            if (r1 >= 0) { const u32x4 t = *(const u32x4*)(V + (size_t)r1 * 1024 + c0);
#pragma unroll
                for (int k = 0; k < 4; ++k) { a1[q][2 * k] = bflo(t[k]); a1[q][2 * k + 1] = bfhi(t[k]); } }
            else if (r1 == -2) { const f32x4 t0 = *(const f32x4*)(s1 + c0), t1 = *(const f32x4*)(s1 + c0 + 4);
#pragma unroll
                for (int k = 0; k < 4; ++k) { a1[q][k] = t0[k]; a1[q][4 + k] = t1[k]; } }
            else {
#pragma unroll
                for (int k = 0; k < 8; ++k) a1[q][k] = 0.f; }
            if (r2 >= 0) { const u32x4 t = *(const u32x4*)(V + (size_t)r2 * 1024 + c0);
#pragma unroll
                for (int k = 0; k < 4; ++k) { a2[q][2 * k] = bflo(t[k]); a2[q][2 * k + 1] = bfhi(t[k]); } }
            else if (r2 == -2) { const f32x4 t0 = *(const f32x4*)(s2 + c0), t1 = *(const f32x4*)(s2 + c0 + 4);
#pragma unroll
                for (int k = 0; k < 4; ++k) { a2[q][k] = t0[k]; a2[q][4 + k] = t1[k]; } }
            else {
#pragma unroll
                for (int k = 0; k < 8; ++k) a2[q][k] = 0.f; } }
#pragma unroll
        for (int q = 0; q < 4; ++q) { const int row = row0 + q * NGR; if (row < NROWS) {
            float vc[8], gg[8], o[8];
#pragma unroll
            for (int k = 0; k < 4; ++k) { vc[2 * k] = bflo(v0[q][k]); vc[2 * k + 1] = bfhi(v0[q][k]); gg[2 * k] = bflo(gz[q][k]); gg[2 * k + 1] = bfhi(gz[q][k]); }
#pragma unroll
            for (int k = 0; k < 8; ++k) o[k] = gg[k] * (w0[k] * a2[q][k] + w1[k] * a1[q][k] + w2[k] * vc[k]);
            u32x4 w; w.x = cvtpk(o[0], o[1]); w.y = cvtpk(o[2], o[3]); w.z = cvtpk(o[4], o[5]); w.w = cvtpk(o[6], o[7]);
            *(u32x4*)(G + (size_t)row * 1024 + c0) = w;
            float* dst = nullptr;
            if (row < NMAIN) { const int i = row & (SEQ - 1), b = row >> 12; if (i >= SEQ - 2) dst = A.out + O_CVP + (((size_t)layer * NB + b) * 2 + (i - (SEQ - 2))) * 1024; }
            else if (row < META0) { const int s = row - SAMP0, b = s >> 2, l = s & 3; if (l >= 2) dst = A.out + O_CVS + (((size_t)layer * DECB + b) * 2 + (l - 2)) * 1024; }
            if (dst) { *(f32x4*)(dst + c0) = (f32x4){vc[0], vc[1], vc[2], vc[3]}; *(f32x4*)(dst + c0 + 4) = (f32x4){vc[4], vc[5], vc[6], vc[7]}; }
        } }
    }
}

__device__ __forceinline__ void norm_row_finish(const Args& A, int layer, int row, const f32x4 (&m)[4], const u32x2 (&xw)[4], const f32x4 (&g)[4], int lane) {
    unsigned char* ws = A.ws; float s = 0.f;
#pragma unroll
    for (int j = 0; j < 4; ++j) s += (m[j].x * m[j].x + m[j].y * m[j].y) + (m[j].z * m[j].z + m[j].w * m[j].w);
    const float r = 1.0f / sqrtf(wave_sum(s, lane) * (1.0f / 1024.0f) + RMS_EPS);
    f32x4 xn[4];
#pragma unroll
    for (int j = 0; j < 4; ++j) xn[j] = (f32x4){bflo(xw[j].x), bfhi(xw[j].x), bflo(xw[j].y), bfhi(xw[j].y)} + m[j] * r * g[j];
    if (layer == 3) { if (row < META0) {
#pragma unroll
            for (int j = 0; j < 4; ++j) ((f32x4*)(A.out + (size_t)row * 1024))[lane + 64 * j] = xn[j]; } }
    else x_row_store(xn, (bf16*)(ws + WS_X) + (size_t)row * 1024, (float*)(ws + WS_RS) + row, lane);
}
__device__ __forceinline__ void norm_phase(const Args& A, int layer, int gw, int NGW, int lane) {
    unsigned char* ws = A.ws; const bf16* MB = (const bf16*)(ws + WS_MB); const bf16* X = (const bf16*)(ws + WS_X); const float* pg = A.post_g + (size_t)layer * 1024;
    f32x4 g[4];
#pragma unroll
    for (int j = 0; j < 4; ++j) g[j] = ((const f32x4*)pg)[lane + 64 * j];
    for (int row0 = gw; row0 < NMAIN; row0 += 4 * NGW) {
        u32x2 mw[4][4], xw[4][4];
#pragma unroll
        for (int k = 0; k < 4; ++k) { const int row = row0 + k * NGW < NMAIN ? row0 + k * NGW : row0;
#pragma unroll
            for (int j = 0; j < 4; ++j) { mw[k][j] = ((const u32x2*)(MB + (size_t)row * 1024))[lane + 64 * j]; xw[k][j] = ((const u32x2*)(X + (size_t)row * 1024))[lane + 64 * j]; } }
#pragma unroll
        for (int k = 0; k < 4; ++k) { const int row = row0 + k * NGW; if (row < NMAIN) {
            f32x4 m[4];
#pragma unroll
            for (int j = 0; j < 4; ++j) m[j] = (f32x4){bflo(mw[k][j].x), bfhi(mw[k][j].x), bflo(mw[k][j].y), bfhi(mw[k][j].y)};
            norm_row_finish(A, layer, row, m, xw[k], g, lane); } }
    }
    const float* PG = (const float*)(ws + WS_PARTG);
    for (int row = NMAIN + gw; row < NROWS; row += NGW) {
        u32x2 xw[4]; f32x4 m[4];
#pragma unroll
        for (int j = 0; j < 4; ++j) xw[j] = ((const u32x2*)(X + (size_t)row * 1024))[lane + 64 * j];
#pragma unroll
        for (int s2 = 0; s2 < GOUT_SPLITK; s2 += 2) { f32x4 t0[4], t1[4];
#pragma unroll
            for (int j = 0; j < 4; ++j) { t0[j] = ((const f32x4*)(PG + ((size_t)s2 * 768 + (row - NMAIN)) * 1024))[lane + 64 * j]; t1[j] = ((const f32x4*)(PG + ((size_t)(s2 + 1) * 768 + (row - NMAIN)) * 1024))[lane + 64 * j]; }
#pragma unroll
            for (int j = 0; j < 4; ++j) m[j] = s2 == 0 ? t0[j] + t1[j] : m[j] + (t0[j] + t1[j]); }
        norm_row_finish(A, layer, row, m, xw, g, lane);
    }
}

__device__ __forceinline__ void latent_phase(const Args& A, int gw, int NGW, int lane) {
    unsigned char* ws = A.ws; const float* CKR = (const float*)(ws + WS_CKR); bf16* CB = (bf16*)(ws + WS_CB); bf16* KRB = (bf16*)(ws + WS_KRB);
    const float* COS = (const float*)(ws + WS_COS); const float* SIN = (const float*)(ws + WS_SIN);
    const f32x4 g = ((const f32x4*)A.kv_lat_g)[lane];
    for (int row0 = gw; row0 < NROWS; row0 += 4 * NGW) {
        f32x4 cc[4]; float x1[4], x2[4], cs[4], sn[4];
#pragma unroll
        for (int k = 0; k < 4; ++k) { const int row = row0 + k * NGW < NROWS ? row0 + k * NGW : row0; const int pi = pg8::posidx_of_row(row); const int l16 = lane & 15;
            cc[k] = ((const f32x4*)(CKR + (size_t)row * 512))[lane]; x1[k] = CKR[(size_t)row * 512 + 256 + l16]; x2[k] = CKR[(size_t)row * 512 + 272 + l16]; cs[k] = COS[pi * 16 + l16]; sn[k] = SIN[pi * 16 + l16]; }
#pragma unroll
        for (int k = 0; k < 4; ++k) { const int row = row0 + k * NGW; if (row < NROWS) {
            const f32x4 c = cc[k];
            const float r = 1.0f / sqrtf(wave_sum((c.x * c.x + c.y * c.y) + (c.z * c.z + c.w * c.w), lane) * (1.0f / 256.0f) + RMS_EPS);
            const f32x4 cn = c * r * g;
            u32x2 w; w.x = cvtpk(cn.x, cn.y); w.y = cvtpk(cn.z, cn.w); ((u32x2*)(CB + (size_t)row * 256))[lane] = w;
            const float o1 = x1[k] * cs[k] - x2[k] * sn[k], o2 = x1[k] * sn[k] + x2[k] * cs[k];
            if (lane < 16) { KRB[(size_t)row * 32 + lane] = (bf16)(cvtpk(o1, o1) & 0xffffu); KRB[(size_t)row * 32 + 16 + lane] = (bf16)(cvtpk(o2, o2) & 0xffffu); }
            if (row < NMAIN) { const int b = row >> 12, i = row & (SEQ - 1); const size_t t = (size_t)b * TTOT + NMETA + i;
                ((f32x4*)(A.out + O_CKP + t * KVL))[lane] = cn; if (lane < 16) { A.out[O_KRP + t * QKR + lane] = o1; A.out[O_KRP + t * QKR + 16 + lane] = o2; } }
            else if (row < META0) { const size_t t = row - SAMP0; ((f32x4*)(A.out + O_CKS + t * KVL))[lane] = cn; if (lane < 16) { A.out[O_KRS + t * QKR + lane] = o1; A.out[O_KRS + t * QKR + 16 + lane] = o2; } }
            else if (row < META0 + NMETA) { const int j = row - META0;
#pragma unroll
                for (int b = 0; b < NB; ++b) { const size_t t = (size_t)b * TTOT + j; ((f32x4*)(A.out + O_CKP + t * KVL))[lane] = cn; if (lane < 16) { A.out[O_KRP + t * QKR + lane] = o1; A.out[O_KRP + t * QKR + 16 + lane] = o2; } } }
        } }
    }
}

namespace ap {
constexpr int NW = 8, QBLK = 32, KVBLK = 64;
constexpr int SHM_K = 64 * 256, SHM_V = 64 * 64 * 2;
constexpr int OFF_V = 0, OFF_K = 2 * SHM_V, OFF_WS = OFF_K + 2 * SHM_K, LDS_BYTES_AP = OFF_WS + NW * 64 * 4;
constexpr float THR = 8.0f;
#define KSWZ(row, colB) ((row) * 256 + ((colB) ^ (((row) & 7) << 4)))
__device__ __forceinline__ int crow(int r, int hi) { return (r & 3) + 8 * (r >> 2) + 4 * hi; }
__device__ __forceinline__ void partialSM(f32x16& p0, f32x16& p1, float& m_reg, float& mn, float& alpha) {
    float pmax = p0[0];
#pragma unroll
    for (int r = 1; r < 16; ++r) pmax = fmaxf(pmax, p0[r]);
#pragma unroll
    for (int r = 0; r < 16; ++r) pmax = fmaxf(pmax, p1[r]);
    { auto rr = __builtin_amdgcn_permlane32_swap(__float_as_uint(pmax), __float_as_uint(pmax), false, false); pmax = fmaxf(__uint_as_float(rr[0]), __uint_as_float(rr[1])); }
    if (__builtin_expect(__all(pmax - m_reg <= THR), 1)) { mn = m_reg; alpha = 1.f; }
    else { mn = fmaxf(m_reg, pmax); alpha = __builtin_amdgcn_exp2f(m_reg - mn); m_reg = mn; }
#pragma unroll
    for (int r = 0; r < 16; ++r) p0[r] = p0[r] - mn;
#pragma unroll
    for (int r = 0; r < 16; ++r) p1[r] = p1[r] - mn;
#pragma unroll
    for (int r = 0; r < 16; ++r) p0[r] = __builtin_amdgcn_exp2f(p0[r]);
}
__device__ __forceinline__ void finishSM(f32x16& p0, f32x16& p1, float alpha, float& l_reg, bf16x8& pa0, bf16x8& pa1, bf16x8& pa2, bf16x8& pa3) {
#pragma unroll
    for (int r = 0; r < 16; ++r) p1[r] = __builtin_amdgcn_exp2f(p1[r]);
    float ps = 0;
#pragma unroll
    for (int r = 0; r < 16; ++r) ps += p0[r];
#pragma unroll
    for (int r = 0; r < 16; ++r) ps += p1[r];
    { auto rr = __builtin_amdgcn_permlane32_swap(__float_as_uint(ps), __float_as_uint(ps), false, false); ps = __uint_as_float(rr[0]) + __uint_as_float(rr[1]); }
    l_reg = l_reg * alpha + ps;
#define PK4(P, BASE, OUT) do { unsigned a0 = cvtpk(P[BASE + 0], P[BASE + 1]), a1 = cvtpk(P[BASE + 2], P[BASE + 3]);   \
    unsigned b0 = cvtpk(P[BASE + 4], P[BASE + 5]), b1 = cvtpk(P[BASE + 6], P[BASE + 7]);                              \
    auto r0 = __builtin_amdgcn_permlane32_swap(a0, b0, false, false); auto r1 = __builtin_amdgcn_permlane32_swap(a1, b1, false, false); \
    u32x4 w = {r0[0], r1[0], r0[1], r1[1]}; OUT = *reinterpret_cast<bf16x8*>(&w); } while (0)
    PK4(p0, 0, pa0); PK4(p0, 8, pa1); PK4(p1, 0, pa2); PK4(p1, 8, pa3);
}
__device__ __forceinline__ void qkt(f32x16& p0, f32x16& p1, const char* Ks, const bf16x8* qr, int r32, int hi) {
    p0 = f32x16{}; p1 = f32x16{};
#pragma unroll
    for (int d0 = 0; d0 < 6; ++d0) { const int cb = (d0 * 16 + hi * 8) * 2;
        const bf16x8 b0 = *reinterpret_cast<const bf16x8*>(Ks + KSWZ(r32, cb));
        const bf16x8 b1 = *reinterpret_cast<const bf16x8*>(Ks + KSWZ(32 + r32, cb));
        p0 = __builtin_amdgcn_mfma_f32_32x32x16_bf16(b0, qr[d0], p0, 0, 0, 0);
        p1 = __builtin_amdgcn_mfma_f32_32x32x16_bf16(b1, qr[d0], p1, 0, 0, 0); }
}
__device__ __forceinline__ void mask_tile(f32x16& p0, f32x16& p1, int lim, int hi) {
#pragma unroll
    for (int r = 0; r < 16; ++r) { const int kv = crow(r, hi); if (kv > lim) p0[r] = -INFINITY; if (kv + 32 > lim) p1[r] = -INFINITY; }
}
__device__ __forceinline__ int v_st(int k, int c) { const int kk = (k & ~0xC) | ((k & 4) << 1) | ((k & 8) >> 1); return ((kk >> 3) * 2 + (c >> 5)) * 512 + ((kk & 7) * 32 + (c & 31)) * 2; }
__device__ __forceinline__ int v_rd_base(int lane) { return ((lane & 3) << 3) | (((lane >> 2) & 3) << 6) | (((lane >> 4) & 1) << 5) | (((lane >> 5) & 1) << 8); }
constexpr int v_rd_off(int d0, int ks, int half) { return d0 * 512 + ks * 2048 + half * 1024; }
template <int OFF> __device__ __forceinline__ s16x4 tr_read(int vb) { s16x4 r; asm volatile("ds_read_b64_tr_b16 %0, %1 offset:%2" : "=&v"(r) : "v"(vb), "i"(OFF) : "memory"); return r; }
template <int D0> __device__ __forceinline__ void pv_one(f32x16& od, int vb, bf16x8 pa0, bf16x8 pa1, bf16x8 pa2, bf16x8 pa3) {
    const s16x4 l0 = tr_read<v_rd_off(D0, 0, 0)>(vb), h0 = tr_read<v_rd_off(D0, 0, 1)>(vb), l1 = tr_read<v_rd_off(D0, 1, 0)>(vb), h1 = tr_read<v_rd_off(D0, 1, 1)>(vb);
    const s16x4 l2 = tr_read<v_rd_off(D0, 2, 0)>(vb), h2 = tr_read<v_rd_off(D0, 2, 1)>(vb), l3 = tr_read<v_rd_off(D0, 3, 0)>(vb), h3 = tr_read<v_rd_off(D0, 3, 1)>(vb);
    asm volatile("s_waitcnt lgkmcnt(0)" ::: "memory"); SBAR();
#define PKV(L, H) (bf16x8){L[0], L[1], L[2], L[3], H[0], H[1], H[2], H[3]}
    od = __builtin_amdgcn_mfma_f32_32x32x16_bf16(pa0, PKV(l0, h0), od, 0, 0, 0);
    od = __builtin_amdgcn_mfma_f32_32x32x16_bf16(pa1, PKV(l1, h1), od, 0, 0, 0);
    od = __builtin_amdgcn_mfma_f32_32x32x16_bf16(pa2, PKV(l2, h2), od, 0, 0, 0);
    od = __builtin_amdgcn_mfma_f32_32x32x16_bf16(pa3, PKV(l3, h3), od, 0, 0, 0);
}
__device__ __forceinline__ void pv_all(f32x16* o, int vb, bf16x8 pa0, bf16x8 pa1, bf16x8 pa2, bf16x8 pa3) { pv_one<0>(o[0], vb, pa0, pa1, pa2, pa3); pv_one<1>(o[1], vb, pa0, pa1, pa2, pa3); }

__device__ __forceinline__ void attn_unit(const bf16* __restrict__ QN, const bf16* __restrict__ QR, const bf16* __restrict__ KN, const bf16* __restrict__ KRB, const bf16* __restrict__ VV,
                                          const bf16* __restrict__ SZ, bf16* __restrict__ OG, int b, int h, int qb, bool meta, char* lds, const int wave) {
    const int lane = lane_fresh(), wid = wave, tid = wave * 64 + lane, r32 = lane & 31, hi = lane >> 5;
    char* V_lds = lds + OFF_V; char* K_lds = lds + OFF_K;
    float* wsf = (float*)(lds + OFF_WS) + wid * 64; float* li_l = wsf; float* al_l = wsf + 32;
    float m_reg = -1e30f, l_reg = 0; f32x16 o[2] = {}; bf16x8 qr[6];
    const int qrow0 = meta ? META0 : b * SEQ + qb * 256;
    const int qrow = qrow0 + wid * QBLK + r32;
    const int qloc = qb * 256 + wid * QBLK + r32;
#pragma unroll
    for (int d0 = 0; d0 < 4; ++d0) qr[d0] = *reinterpret_cast<const bf16x8*>(QN + (size_t)qrow * 1024 + h * 64 + d0 * 16 + hi * 8);
#pragma unroll
    for (int d0 = 0; d0 < 2; ++d0) qr[4 + d0] = *reinterpret_cast<const bf16x8*>(QR + (size_t)qrow * 512 + h * 32 + d0 * 16 + hi * 8);
    const int NT = meta ? 1 : 4 * qb + 5;
    const int sr = tid >> 3, sc = (tid & 7) * 8, rr = (tid & 255) >> 2, rc = (tid & 3) * 8;
    const int vst = v_st(sr, sc), kst = KSWZ(sr, sc * 2), rst = KSWZ(rr, 128 + rc * 2);
    const int vb0 = (int)(uintptr_t)V_lds + v_rd_base(lane);
    struct { bf16x8 kn, kr, vs; } st_[2];
#define TROW(t) ((t) == 0 ? META0 : b * SEQ + ((t) - 1) * KVBLK)
#define SLOAD(i, t) do { const int t_ = (t) < NT ? (t) : NT - 1; const int row0_ = TROW(t_); st_[i].kn = *reinterpret_cast<const bf16x8*>(KN + (size_t)(row0_ + sr) * 1024 + h * 64 + sc); \
    st_[i].vs = *reinterpret_cast<const bf16x8*>(VV + (size_t)(row0_ + sr) * 1024 + h * 64 + sc); st_[i].kr = *reinterpret_cast<const bf16x8*>(KRB + (size_t)(row0_ + rr) * 32 + rc); } while (0)
#define SWRITE(bf, i) do { *(bf16x8*)(V_lds + (bf) * SHM_V + vst) = st_[i].vs; *(bf16x8*)(K_lds + (bf) * SHM_K + kst) = st_[i].kn; *(bf16x8*)(K_lds + (bf) * SHM_K + rst) = st_[i].kr; } while (0)
#define RESC(a) do { if (__any((a) < 1.f)) { if (hi == 0) al_l[r32] = (a); asm volatile("s_waitcnt lgkmcnt(0)" ::: "memory"); \
    _Pragma("unroll") for (int d = 0; d < 2; ++d) _Pragma("unroll") for (int r = 0; r < 16; ++r) o[d][r] *= al_l[crow(r, hi)]; } } while (0)
#define MASK(P0, P1, t) do { if ((t) == 0) { const int lim_ = meta ? (wid * QBLK + r32 < 15 ? wid * QBLK + r32 : 15) : 15; mask_tile(P0, P1, lim_, hi); } \
    else if ((t) > NT - 5) { mask_tile(P0, P1, qloc - ((t) - 1) * KVBLK, hi); } } while (0)
    f32x16 pA0, pA1, pB0, pB1; float mnA, mnB, alA, alB; bf16x8 pa0, pa1, pa2, pa3;
    SLOAD(0, 0); SWRITE(0, 0); __syncthreads();
    qkt(pA0, pA1, K_lds, qr, r32, hi); MASK(pA0, pA1, 0); partialSM(pA0, pA1, m_reg, mnA, alA);
    SLOAD(1, 1); SLOAD(0, 2); SWRITE(1, 1);
    __syncthreads();
    for (int j = 1; j + 1 < NT; j += 2) {
        SBAR(); qkt(pB0, pB1, K_lds + SHM_K, qr, r32, hi); MASK(pB0, pB1, j);
        finishSM(pA0, pA1, alA, l_reg, pa0, pa1, pa2, pa3); SBAR();
        SLOAD(1, j + 2); SBAR();
        pv_all(o, vb0, pa0, pa1, pa2, pa3); partialSM(pB0, pB1, m_reg, mnB, alB);
        __syncthreads(); SWRITE(0, 0);
        RESC(alB); __syncthreads();
        SBAR(); qkt(pA0, pA1, K_lds, qr, r32, hi); MASK(pA0, pA1, j + 1);
        finishSM(pB0, pB1, alB, l_reg, pa0, pa1, pa2, pa3); SBAR();
        SLOAD(0, j + 3); SBAR();
        pv_all(o, vb0 + SHM_V, pa0, pa1, pa2, pa3); partialSM(pA0, pA1, m_reg, mnA, alA);
        __syncthreads(); SWRITE(1, 1);
        RESC(alA); __syncthreads();
    }
    finishSM(pA0, pA1, alA, l_reg, pa0, pa1, pa2, pa3); SBAR();
    pv_all(o, vb0, pa0, pa1, pa2, pa3);
    if (hi == 0) li_l[r32] = l_reg; asm volatile("s_waitcnt lgkmcnt(0)" ::: "memory");
    __syncthreads();
    { float* stg = (float*)(lds + 65536) + wid * 2048;
#pragma unroll
      for (int r = 0; r < 16; ++r) { const int orow = crow(r, hi); const float rl = __builtin_amdgcn_rcpf(li_l[orow]);
#pragma unroll
          for (int d0 = 0; d0 < 2; ++d0) stg[orow * 64 + d0 * 32 + r32] = o[d0][r] * rl; }
      asm volatile("s_waitcnt lgkmcnt(0)" ::: "memory");
      u32x4 zz[4];
#pragma unroll
      for (int i = 0; i < 4; ++i) { const int row = i * 8 + (lane >> 3), ch = lane & 7; zz[i] = *(const u32x4*)(SZ + (size_t)(qrow0 + wid * QBLK + row) * 1024 + h * 64 + ch * 8); }
#pragma unroll
      for (int i = 0; i < 4; ++i) { const int row = i * 8 + (lane >> 3), ch = lane & 7; const f32x4 a = *(const f32x4*)(stg + row * 64 + ch * 8), c = *(const f32x4*)(stg + row * 64 + ch * 8 + 4);
          u32x4 w; w.x = cvtpk(a[0] * bflo(zz[i].x), a[1] * bfhi(zz[i].x)); w.y = cvtpk(a[2] * bflo(zz[i].y), a[3] * bfhi(zz[i].y)); w.z = cvtpk(c[0] * bflo(zz[i].z), c[1] * bfhi(zz[i].z)); w.w = cvtpk(c[2] * bflo(zz[i].w), c[3] * bfhi(zz[i].w));
          *(u32x4*)(OG + (size_t)(qrow0 + wid * QBLK + row) * 1024 + h * 64 + ch * 8) = w; } }
    __syncthreads();
#undef TROW
#undef SLOAD
#undef SWRITE
#undef RESC
#undef MASK
}
}

namespace as {
constexpr int IMG_HALF = 16384, IMG_ROPE = 32768, IMG_BYTES = 36864;
constexpr int OFF_Q = 0, OFF_K0 = IMG_BYTES, OFF_WS = OFF_K0 + 3 * IMG_BYTES, LDS_BYTES_AS = OFF_WS + 8 * 64 * 4 + 8 * 64 * 4;
constexpr float THR = 8.0f;
constexpr int NTILE = 2 * AS_PAGES;
__device__ __forceinline__ unsigned off_a(unsigned row, unsigned ch) { return 2048u * (row >> 3) + 512u * (ch >> 2) + 64u * (row & 7) + 16u * ((ch & 3) ^ ((row >> 2) & 3)); }
__device__ __forceinline__ unsigned off_rope(unsigned row, unsigned ch) { return IMG_ROPE + 64u * row + 16u * (ch ^ ((row >> 2) & 3)); }
__device__ __forceinline__ unsigned img_off(unsigned row, unsigned c8) { return c8 < 32 ? (c8 >> 4) * IMG_HALF + off_a(row, c8 & 15) : off_rope(row, c8 - 32); }
__device__ __forceinline__ s16x4 tr_read_dyn(unsigned addr) { s16x4 r; asm volatile("ds_read_b64_tr_b16 %0, %1" : "=&v"(r) : "v"(addr) : "memory"); return r; }

__device__ __forceinline__ void attn_s_unit(const Args& A, int b, int s, char* lds, const int wave) {
    unsigned char* ws = A.ws;
    const int lane = lane_fresh(), wid = wave, tid = wave * 64 + lane, r32 = lane & 31, hi = lane >> 5;
    const int qg = wid & 1, kh = (wid >> 1) & 1, chh = wid >> 2;
    const int* pt = A.page_table + (size_t)b * NPAGES + s * AS_PAGES;
    float* wsf = (float*)(lds + OFF_WS) + wid * 64;
    struct Stage { f32x4 c[8]; f32x4 r; } sA, sB;
#define TLOAD(S, t) do { const int t_ = (t) < NTILE ? (t) : NTILE - 1; const int pg_ = __builtin_amdgcn_readfirstlane(pgl[t_ >> 1]); const size_t k0_ = (size_t)pg_ * PAGE + (t_ & 1) * 64; \
    const int live_ = (t) < NTILE ? 1 : 0;        \
    const float* cb_ = A.cache_ckv + (k0_ + wid) * KVL + live_ * lane * 4; const float* rb_ = A.cache_krope + k0_ * QKR + live_ * tid * 4; \
    _Pragma("unroll") for (int i_ = 0; i_ < 8; ++i_) S.c[i_] = __builtin_nontemporal_load((const f32x4*)(cb_ + (size_t)(live_ * 8 * i_) * KVL)); S.r = __builtin_nontemporal_load((const f32x4*)rb_); } while (0)
#define TWRITE(bufoff, S) do { _Pragma("unroll") for (int i_ = 0; i_ < 8; ++i_) { u32x2 w_; w_.x = cvtpk(S.c[i_][0], S.c[i_][1]); w_.y = cvtpk(S.c[i_][2], S.c[i_][3]); \
        *(u32x2*)(lds + (bufoff) + img_off(8 * i_ + wid, lane >> 1) + (lane & 1) * 8) = w_; } \
    { const int rrow_ = tid >> 3, rc4 = tid & 7; u32x2 w_; w_.x = cvtpk(S.r[0], S.r[1]); w_.y = cvtpk(S.r[2], S.r[3]); *(u32x2*)(lds + (bufoff) + off_rope(rrow_, rc4 >> 1) + (rc4 & 1) * 8) = w_; } } while (0)
    __attribute__((address_space(3))) int* pgl = (__attribute__((address_space(3))) int*)(lds + OFF_WS + 2048) + wid * 64;
    if (lane < AS_PAGES) pgl[lane] = pt[lane];
    asm volatile("s_waitcnt vmcnt(0) lgkmcnt(0)" ::: "memory");
    TLOAD(sA, 0); TLOAD(sB, 1);
    {
        const bf16* QN = (const bf16*)(ws + WS_QN); const bf16* QR = (const bf16*)(ws + WS_QR); const bf16* WUKB = (const bf16*)(ws + WS_WUKB);
        bf16* QABS = (bf16*)(ws + WS_QABS) + (size_t)b * 64 * 288;
        const size_t qrow0 = (size_t)(SAMP0 + b * 4);
        const int l15 = lane & 15, l4 = lane >> 4, tok = l15 & 3;
#pragma unroll 1
        for (int hh = 0; hh < 2; ++hh) { const int h = 2 * wid + hh;
            const bf16x8 bq0 = *(const bf16x8*)(QN + (qrow0 + tok) * 1024 + h * 64 + 8 * l4), bq1 = *(const bf16x8*)(QN + (qrow0 + tok) * 1024 + h * 64 + 32 + 8 * l4);
#pragma unroll 4
            for (int nt = 0; nt < 16; ++nt) { const bf16* wp = WUKB + (size_t)(nt * 16 + l15) * 1024 + h * 64 + 8 * l4;
                const bf16x8 a0 = *(const bf16x8*)wp, a1 = *(const bf16x8*)(wp + 32);
                f32x4 acc = (f32x4){0.f, 0.f, 0.f, 0.f};
                acc = __builtin_amdgcn_mfma_f32_16x16x32_bf16(a0, bq0, acc, 0, 0, 0);
                acc = __builtin_amdgcn_mfma_f32_16x16x32_bf16(a1, bq1, acc, 0, 0, 0);
                if (l15 < 4) { const int q = l15 * 16 + h, c0 = nt * 16 + l4 * 4; u32x2 w; w.x = cvtpk(acc[0], acc[1]); w.y = cvtpk(acc[2], acc[3]);
                    *(u32x2*)(lds + OFF_Q + img_off(q, c0 >> 3) + (c0 & 7) * 2) = w; if (s == 0) *(u32x2*)(QABS + (size_t)q * 288 + c0) = w; } }
        }
        if (tid < 256) { const int q = tid >> 2, c = tid & 3; const u32x4 w = *(const u32x4*)(QR + (qrow0 + (q >> 4)) * 512 + (q & 15) * 32 + c * 8);
            *(u32x4*)(lds + OFF_Q + off_rope(q, c)) = w; if (s == 0) *(u32x4*)(QABS + (size_t)q * 288 + 256 + c * 8) = w; }
    }
    unsigned kaddr[2], qaddr[2], kraddr, qraddr;
    { const unsigned krow = kh * 32 + r32, qrow = qg * 32 + r32;
#pragma unroll
      for (int od = 0; od < 2; ++od) { kaddr[od] = off_a(krow, 2 * od + hi); qaddr[od] = OFF_Q + off_a(qrow, 2 * od + hi); }
      kraddr = off_rope(krow, hi); qraddr = OFF_Q + off_rope(qrow, hi); }
    const unsigned kr2 = IMG_ROPE + 64u * (kh * 32 + r32) + 16u * ((2 + hi) ^ (((kh * 32 + r32) >> 2) & 3)), qr2 = OFF_Q + IMG_ROPE + 64u * (qg * 32 + r32) + 16u * ((2 + hi) ^ (((qg * 32 + r32) >> 2) & 3));
    unsigned vaddr[2];
    { const unsigned blk = (lane >> 4) & 1, q = (lane & 15) >> 2, p = lane & 3;
#pragma unroll
      for (int t = 0; t < 2; ++t) vaddr[t] = chh * IMG_HALF + off_a(32 * kh + 8 * hi + 4 * t + q, 2 * blk + (p >> 1)) + 8 * (p & 1); }
    float m_reg = -1e30f, l_reg = 0.f; f32x16 o[4] = {};
    const unsigned ldsb = (unsigned)(uintptr_t)lds;
#define KQ_LD(X, pp) do { constexpr unsigned so_ = 512u * ((pp) & 3) + (unsigned)IMG_HALF * ((pp) >> 2); \
        k##X##0 = *(const bf16x8*)(lds + bo_ + kaddr[0] + so_); q##X##0 = *(const bf16x8*)(lds + qaddr[0] + so_); k##X##1 = *(const bf16x8*)(lds + bo_ + kaddr[1] + so_); q##X##1 = *(const bf16x8*)(lds + qaddr[1] + so_); } while (0)
#define KQ_LDR(X) do { k##X##0 = *(const bf16x8*)(lds + bo_ + kraddr); q##X##0 = *(const bf16x8*)(lds + qraddr); k##X##1 = *(const bf16x8*)(lds + bo_ + kr2); q##X##1 = *(const bf16x8*)(lds + qr2); } while (0)
#define KQ_MM(X) do { p = __builtin_amdgcn_mfma_f32_32x32x16_bf16(k##X##0, q##X##0, p, 0, 0, 0); p = __builtin_amdgcn_mfma_f32_32x32x16_bf16(k##X##1, q##X##1, p, 0, 0, 0); } while (0)
#define PV_RD(X, nt) do { v##X##0 = tr_read_dyn(ldsb + bo_ + vaddr[0] + 512 * (nt)); v##X##1 = tr_read_dyn(ldsb + bo_ + vaddr[1] + 512 * (nt)); \
        v##X##2 = tr_read_dyn(ldsb + bo_ + vaddr[0] + 512 * (nt) + 4096); v##X##3 = tr_read_dyn(ldsb + bo_ + vaddr[1] + 512 * (nt) + 4096); } while (0)
#define PV_MM(X, nt) do { o[nt] = __builtin_amdgcn_mfma_f32_32x32x16_bf16(pa0, ((bf16x8){v##X##0[0], v##X##0[1], v##X##0[2], v##X##0[3], v##X##1[0], v##X##1[1], v##X##1[2], v##X##1[3]}), o[nt], 0, 0, 0); \
        o[nt] = __builtin_amdgcn_mfma_f32_32x32x16_bf16(pa1, ((bf16x8){v##X##2[0], v##X##2[1], v##X##2[2], v##X##2[3], v##X##3[0], v##X##3[1], v##X##3[2], v##X##3[3]}), o[nt], 0, 0, 0); } while (0)
#define LGKM_WAIT(N) do { asm volatile("s_waitcnt lgkmcnt(" #N ")" ::: "memory"); SBAR(); } while (0)
#define COMPUTE(bufoff) do { f32x16 p = f32x16{}; const unsigned bo_ = (bufoff); bf16x8 kA0, qA0, kA1, qA1, kB0, qB0, kB1, qB1; \
    KQ_LD(A, 0); KQ_LD(B, 1); SBAR(); KQ_MM(A); KQ_LD(A, 2); SBAR(); KQ_MM(B); KQ_LD(B, 3); SBAR(); KQ_MM(A); KQ_LD(A, 4); SBAR(); KQ_MM(B); KQ_LD(B, 5); SBAR(); \
    KQ_MM(A); KQ_LD(A, 6); SBAR(); KQ_MM(B); KQ_LD(B, 7); SBAR(); KQ_MM(A); KQ_LDR(A); SBAR(); KQ_MM(B); SBAR(); KQ_MM(A); SBAR(); \
    float pmax = p[0]; _Pragma("unroll") for (int r = 1; r < 16; ++r) pmax = fmaxf(pmax, p[r]); \
    { auto rr = __builtin_amdgcn_permlane32_swap(__float_as_uint(pmax), __float_as_uint(pmax), false, false); pmax = fmaxf(__uint_as_float(rr[0]), __uint_as_float(rr[1])); } \
    float alpha = 1.f; \
    if (!__all(pmax - m_reg <= THR)) { const float mn = fmaxf(m_reg, pmax); alpha = __builtin_amdgcn_exp2f(m_reg - mn); m_reg = mn; \
        if (hi == 0) wsf[r32] = alpha; asm volatile("s_waitcnt lgkmcnt(0)" ::: "memory"); \
        _Pragma("unroll") for (int n = 0; n < 4; ++n) _Pragma("unroll") for (int r = 0; r < 16; ++r) o[n][r] *= wsf[ap::crow(r, hi)]; } \
    s16x4 vA0, vA1, vA2, vA3, vB0, vB1, vB2, vB3; asm volatile("s_waitcnt lgkmcnt(0)" ::: "memory"); SBAR(); PV_RD(A, 0); SBAR();        \
    float ps = 0.f; _Pragma("unroll") for (int r = 0; r < 16; ++r) { p[r] = __builtin_amdgcn_exp2f(p[r] - m_reg); ps += p[r]; } \
    { auto rr = __builtin_amdgcn_permlane32_swap(__float_as_uint(ps), __float_as_uint(ps), false, false); ps = __uint_as_float(rr[0]) + __uint_as_float(rr[1]); } \
    l_reg = l_reg * alpha + ps; \
    bf16x8 pa0, pa1; PK4(p, 0, pa0); PK4(p, 8, pa1); SBAR(); \
    PV_RD(B, 1); LGKM_WAIT(4); PV_MM(A, 0); SBAR(); PV_RD(A, 2); LGKM_WAIT(4); PV_MM(B, 1); SBAR(); PV_RD(B, 3); LGKM_WAIT(4); PV_MM(A, 2); SBAR(); LGKM_WAIT(0); PV_MM(B, 3); SBAR(); } while (0)
    TWRITE(OFF_K0, sA); TLOAD(sA, 2); TWRITE(OFF_K0 + IMG_BYTES, sB); TLOAD(sB, 3); __syncthreads();
    { unsigned bc = OFF_K0, bn = OFF_K0 + IMG_BYTES, bw = OFF_K0 + 2 * IMG_BYTES;
#pragma unroll 1
      for (int t = 0; t < NTILE; t += 2) {
        SBAR(); COMPUTE(bc); SBAR();
        TWRITE(bw, sA); TLOAD(sA, t + 4);
        __syncthreads();
        { const unsigned x_ = bc; bc = bn; bn = bw; bw = x_; }
        SBAR(); COMPUTE(bc); SBAR();
        TWRITE(bw, sB); TLOAD(sB, t + 5);
        __syncthreads();
        { const unsigned x_ = bc; bc = bn; bn = bw; bw = x_; }
      } }
    { float* xo = (float*)lds + (size_t)(chh * 2 + qg) * 4096;
      float* xml = (float*)(lds + 65536) + (chh * 2 + qg) * 128;
      if (kh == 1) {
#pragma unroll
          for (int nt = 0; nt < 4; ++nt)
#pragma unroll
              for (int r = 0; r < 16; ++r) xo[(nt * 16 + r) * 64 + lane] = o[nt][r];
          xml[lane] = m_reg; xml[64 + lane] = l_reg; }
      __syncthreads();
      if (kh == 0) {
          const float m2 = xml[lane], l2 = xml[64 + lane]; const float mn = fmaxf(m_reg, m2); const float a1 = __builtin_amdgcn_exp2f(m_reg - mn), a2 = __builtin_amdgcn_exp2f(m2 - mn);
          l_reg = l_reg * a1 + l2 * a2; m_reg = mn;
          if (hi == 0) { wsf[r32] = a1; wsf[32 + r32] = a2; } asm volatile("s_waitcnt lgkmcnt(0)" ::: "memory");
          float* PO = (float*)(ws + WS_PART) + ((size_t)(b * 4 + s) * 64) * 256; float* PML = (float*)(ws + WS_PML) + (size_t)(b * 4 + s) * 128;
#pragma unroll
          for (int nt = 0; nt < 4; ++nt)
#pragma unroll
              for (int r = 0; r < 16; ++r) { const int qr_ = ap::crow(r, hi); PO[(size_t)(qg * 32 + qr_) * 256 + chh * 128 + nt * 32 + r32] = o[nt][r] * wsf[qr_] + xo[(nt * 16 + r) * 64 + lane] * wsf[32 + qr_]; }
          if (chh == 0 && hi == 0) { PML[qg * 32 + r32] = m_reg; PML[64 + qg * 32 + r32] = l_reg; } }
    }
    __syncthreads();
#undef TLOAD
#undef TWRITE
#undef COMPUTE
#undef KQ_LD
#undef KQ_LDR
#undef KQ_MM
#undef PV_RD
#undef PV_MM
#undef LGKM_WAIT
}
#undef PK4
#undef PKV
#undef KSWZ
}

__device__ __forceinline__ void comb_unit(const Args& A, int b, int hq, char* lds, const int wave) {
    unsigned char* ws = A.ws; const int tid = wave * 64 + lane_fresh(), lq = tid >> 5, l = lq >> 2, h = hq * 4 + (lq & 3), j = tid & 31, q = l * 16 + h;
    const bf16* QABS = (const bf16*)(ws + WS_QABS) + ((size_t)b * 64 + q) * 288; const bf16* CB = (const bf16*)(ws + WS_CB); const bf16* KRB = (const bf16*)(ws + WS_KRB);
    const float* PO = (const float*)(ws + WS_PART) + ((size_t)b * 4 * 64 + q) * 256; const float* PML = (const float*)(ws + WS_PML) + (size_t)b * 4 * 128;
    float* olds = (float*)lds;
    float qv[8], qrv[8];
    { const u32x4 w = *(const u32x4*)(QABS + j * 8);
#pragma unroll
      for (int k = 0; k < 4; ++k) { qv[2 * k] = bflo(w[k]); qv[2 * k + 1] = bfhi(w[k]); }
      u32x4 wr = (u32x4){0u, 0u, 0u, 0u}; if (j < 4) wr = *(const u32x4*)(QABS + 256 + j * 8);
#pragma unroll
      for (int k = 0; k < 4; ++k) { qrv[2 * k] = bflo(wr[k]); qrv[2 * k + 1] = bfhi(wr[k]); } }
    float sc[4], cn[4][8];
#pragma unroll
    for (int jn = 0; jn < 4; ++jn) { const size_t row = (size_t)(SAMP0 + b * 4 + jn); const u32x4 w = *(const u32x4*)(CB + row * 256 + j * 8); float d = 0.f;
#pragma unroll
        for (int k = 0; k < 4; ++k) { cn[jn][2 * k] = bflo(w[k]); cn[jn][2 * k + 1] = bfhi(w[k]); d += qv[2 * k] * cn[jn][2 * k] + qv[2 * k + 1] * cn[jn][2 * k + 1]; }
        if (j < 4) { const u32x4 wr = *(const u32x4*)(KRB + row * 32 + j * 8);
#pragma unroll
            for (int k = 0; k < 4; ++k) d += qrv[2 * k] * bflo(wr[k]) + qrv[2 * k + 1] * bfhi(wr[k]); }
#pragma unroll
        for (int o = 1; o < 32; o <<= 1) d = d + shfl_xor_f(d, o, tid & 63);
        sc[jn] = jn <= l ? d : -INFINITY; }
    float mp[4], lp[4], M = -INFINITY;
#pragma unroll
    for (int p = 0; p < AS_SPLITS; ++p) { mp[p] = PML[p * 128 + q]; lp[p] = PML[p * 128 + 64 + q]; M = fmaxf(M, mp[p]); }
#pragma unroll
    for (int jn = 0; jn < 4; ++jn) M = fmaxf(M, sc[jn]);
    float L = 0.f, acc[8];
#pragma unroll
    for (int k = 0; k < 8; ++k) acc[k] = 0.f;
#pragma unroll
    for (int p = 0; p < AS_SPLITS; ++p) { const float w = __builtin_amdgcn_exp2f(mp[p] - M); L += w * lp[p]; const f32x4 a = *(const f32x4*)(PO + (size_t)p * 64 * 256 + j * 8), c = *(const f32x4*)(PO + (size_t)p * 64 * 256 + j * 8 + 4);
#pragma unroll
        for (int k = 0; k < 4; ++k) { acc[k] += w * a[k]; acc[4 + k] += w * c[k]; } }
#pragma unroll
    for (int jn = 0; jn < 4; ++jn) { const float w = __builtin_amdgcn_exp2f(sc[jn] - M); L += w;
#pragma unroll
        for (int k = 0; k < 8; ++k) acc[k] += w * cn[jn][k]; }
    const float rl = 1.0f / L;
    *(f32x4*)(olds + lq * 256 + j * 8) = (f32x4){acc[0] * rl, acc[1] * rl, acc[2] * rl, acc[3] * rl}; *(f32x4*)(olds + lq * 256 + j * 8 + 4) = (f32x4){acc[4] * rl, acc[5] * rl, acc[6] * rl, acc[7] * rl};
    __syncthreads();
    const bf16* WUV = (const bf16*)(ws + WS_WUKV) + (size_t)(1024 + h * 64 + 2 * j) * 256;
    float o0 = 0.f, o1 = 0.f;
    for (int c = 0; c < 256; c += 8) { const u32x4 w0 = *(const u32x4*)(WUV + c), w1 = *(const u32x4*)(WUV + 256 + c); const f32x4 x0 = *(const f32x4*)(olds + lq * 256 + c), x1 = *(const f32x4*)(olds + lq * 256 + c + 4);
        o0 += x0[0] * bflo(w0[0]) + x0[1] * bfhi(w0[0]) + x0[2] * bflo(w0[1]) + x0[3] * bfhi(w0[1]) + x1[0] * bflo(w0[2]) + x1[1] * bfhi(w0[2]) + x1[2] * bflo(w0[3]) + x1[3] * bfhi(w0[3]);
        o1 += x0[0] * bflo(w1[0]) + x0[1] * bfhi(w1[0]) + x0[2] * bflo(w1[1]) + x0[3] * bfhi(w1[1]) + x1[0] * bflo(w1[2]) + x1[1] * bfhi(w1[2]) + x1[2] * bflo(w1[3]) + x1[3] * bfhi(w1[3]); }
    const size_t orow = (size_t)(SAMP0 + b * 4 + l) * 1024 + h * 64 + 2 * j;
    const unsigned z = *(const unsigned*)((const bf16*)(ws + WS_SZ) + orow);
    *(unsigned*)((bf16*)(ws + WS_OG) + orow) = cvtpk(o0 * bflo(z), o1 * bfhi(z));
    __syncthreads();
}
constexpr int N_AS_ITEMS = DECB * AS_SPLITS;
#ifndef PREF_DIV
#define PREF_DIV 4
#endif
#ifndef PREF_NUM
#define PREF_NUM 0
#endif
#ifndef ARGS_RELOAD
#define ARGS_RELOAD 1
#endif
#ifndef REP_BAR
#define REP_BAR 1
#endif
#ifndef REP_ELT
#define REP_ELT 1
#endif
#ifndef TAIL_CONV
#define TAIL_CONV 1
#endif
#ifndef STATIC_SCHED
#define STATIC_SCHED 0
#endif
#ifndef REP_AS
#define REP_AS 1
#endif
#ifndef REP_AP
#define REP_AP 1
#endif
#ifndef REP_GEMM
#define REP_GEMM 1
#endif
#ifndef EN_P0
#define EN_P0 1
#endif
#ifndef EN_G1
#define EN_G1 1
#endif
#ifndef EN_CONV
#define EN_CONV 1
#endif
#ifndef EN_G4
#define EN_G4 1
#endif
#ifndef EN_LAT
#define EN_LAT 1
#endif
#ifndef EN_G5
#define EN_G5 1
#endif
#ifndef EN_G6
#define EN_G6 1
#endif
#ifndef EN_AP
#define EN_AP 1
#endif
#ifndef EN_AS
#define EN_AS 1
#endif
#ifndef EN_COMB
#define EN_COMB 1
#endif
#ifndef EN_GOUT
#define EN_GOUT 1
#endif
#ifndef EN_NORM
#define EN_NORM 1
#endif

__device__ __forceinline__ Args fresh_args() {
    const __attribute__((address_space(4))) unsigned long long* p = (const __attribute__((address_space(4))) unsigned long long*)__builtin_amdgcn_kernarg_segment_ptr();
    asm volatile("" : "+s"(p));
#define GP(T, i) ((T*)(__attribute__((address_space(1))) T*)p[i])
    Args a;
    a.x_prompt = GP(const float, 0); a.x_sample = GP(const float, 1); a.cache_ckv = GP(const float, 2); a.cache_krope = GP(const float, 3); a.state_conv = GP(const float, 4); a.page_table = GP(const int, 5);
    a.meta = GP(const float, 6); a.pre_g = GP(const float, 7); a.post_g = GP(const float, 8); a.w_in_conv = GP(const float, 9); a.conv_w = GP(const float, 10); a.w_out_conv = GP(const float, 11);
    a.kv_norm_g = GP(const float, 12); a.w_dkv = GP(const float, 13); a.kv_lat_g = GP(const float, 14); a.w_uk = GP(const float, 15); a.w_uv = GP(const float, 16); a.w_in_mla = GP(const float, 17);
    a.q_norm_g = GP(const float, 18); a.w_uq = GP(const float, 19); a.w_out_mla = GP(const float, 20); a.out = GP(float, 21); a.ws = GP(unsigned char, 22);
#undef GP
    return a;
}
static_assert(sizeof(Args) == 23 * 8, "Args = 23 pointers, no padding: fresh_args() reads them by index");
__global__ void __launch_bounds__(NWAVES * 64, 2) yoco_fwd(Args args_unused_directly) {
    extern __shared__ __attribute__((aligned(16))) unsigned char lds[];
    LAS unsigned char* ldsl = (LAS unsigned char*)lds;
    const int wave = __builtin_amdgcn_readfirstlane(threadIdx.x >> 6) & 7;
#define LANE_OPAQUE() const int lane = lane_fresh()
#define IS_T0() (wave == 0 && lane_fresh() == 0)
#if ARGS_RELOAD
#define PHASE_ARGS() const Args args = fresh_args(); unsigned char* const ws = args.ws; (void)ws
#else
#define PHASE_ARGS() Args args = args_unused_directly; asm volatile("" : "+s"(args.ws), "+s"(args.out)); unsigned char* const ws = args.ws; (void)ws
#endif
    const int G = gridDim.x; const int bx = blockIdx.x; const int vcu = (G % 8 == 0) ? (bx % 8) * (G / 8) + bx / 8 : bx;
    const int gw = vcu * NWAVES + wave, NGW = G * NWAVES;
    { const int t_ = wave * 64 + lane_fresh(); if (t_ < 8) ((LAS unsigned*)(ldsl + LDSCTL_OFF))[t_] = 0u; }
    __syncthreads();
    { PHASE_ARGS(); (void)xcd_barrier_post((unsigned*)(ws + WS_CTL) + CW_BAR, (volatile LAS unsigned*)(ldsl + LDSCTL_OFF), IS_T0()); }
#define GRID_BAR() do { PHASE_ARGS(); XcdBarrier b_; b_.bar = (unsigned*)(ws + WS_CTL) + CW_BAR; b_.x = xb_xcc_id(); b_.st = (volatile LAS unsigned*)(ldsl + LDSCTL_OFF); for (int rb_ = 0; rb_ < REP_BAR; ++rb_) xcd_barrier(b_, IS_T0()); } while (0)
#if EN_P0
    { PHASE_ARGS(); LANE_OPAQUE(); for (int re_ = 0; re_ < REP_ELT; ++re_) p0_prologue(args, ldsl, gw, NGW, wave, lane); }
#endif
    GRID_BAR();

#pragma unroll 1
    for (int l = 0; l < 4; ++l) {
        if (l < 2) {
            { PHASE_ARGS(); pg8::Gemm g{(const bf16*)(ws + WS_X), (const bf16*)(ws + WS_WIN) + (size_t)l * 4096 * 1024, NROWS, 4096, 1024}; pg8::RepOrder<REP_GEMM> S; S.init(NROWS, 4096, G, bx);
              pg8::EpiConvSplit E{(bf16*)(ws + WS_V1), (bf16*)(ws + WS_GZ), (const float*)(ws + WS_RS)};
#if EN_G1
              pg8::gemm_phase<pg8::EpiConvSplit, pg8::RepOrder<REP_GEMM>, true, true>(ldsl, g, S, E, wave);
#endif
              { constexpr int r_ = (67 * 16) % 256; if (TAIL_CONV && G == 256 && bx >= r_) { LANE_OPAQUE(); convert_set(args, l == 0 ? 1 : 3, ldsl, (bx - r_) * NWAVES + wave, (256 - r_) * NWAVES, wave, lane); }
                else if (TAIL_CONV && G != 256 && l == 0) { LANE_OPAQUE(); convert_set(args, 1, ldsl, gw, NGW, wave, lane); convert_set(args, 3, ldsl, gw, NGW, wave, lane); } }
 }
            GRID_BAR();
#if EN_CONV
            { PHASE_ARGS(); LANE_OPAQUE(); for (int re_ = 0; re_ < REP_ELT; ++re_) conv_phase(args, l, gw, NGW, lane); }
#endif
            GRID_BAR();
        } else {
            const int j = l - 2;
            { PHASE_ARGS(); pg8::Gemm g{(const bf16*)(ws + WS_X), (const bf16*)(ws + (j ? WS_WA1 : WS_WA0)), NROWS, j ? 1536 : 2048, 1024}; pg8::RepOrder<REP_GEMM> S; S.init(NROWS, j ? 1536 : 2048, G, bx);
              pg8::EpiMlaIn E{(float*)(ws + WS_CKR), (bf16*)(ws + WS_QL), (float*)(ws + WS_SSQ), (bf16*)(ws + WS_SZ), j ? 0 : 2, (const float*)(ws + WS_RS)};
#if EN_G4
              pg8::gemm_phase<pg8::EpiMlaIn, pg8::RepOrder<REP_GEMM>, true, true>(ldsl, g, S, E, wave);
#endif
 }
            GRID_BAR();
            if (j == 0) {
#if EN_LAT
                { PHASE_ARGS(); LANE_OPAQUE(); for (int re_ = 0; re_ < REP_ELT; ++re_) latent_phase(args, gw, NGW, lane); }
#endif
                GRID_BAR();
                { PHASE_ARGS(); pg8::Gemm g{(const bf16*)(ws + WS_CB), (const bf16*)(ws + WS_WUKV), NROWS, 2048, 256}; pg8::RepOrder<REP_GEMM> S; S.init(NROWS, 2048, G, bx);
                  pg8::EpiBf16 E{(bf16*)(ws + WS_KN), 1024, 1024, (size_t)(WS_VV - WS_KN) / 2};
#if EN_G5
                  pg8::gemm_phase<pg8::EpiBf16, pg8::RepOrder<REP_GEMM>, true, true>(ldsl, g, S, E, wave);
#endif
 }
            }
            { PHASE_ARGS(); pg8::Gemm g{(const bf16*)(ws + WS_QL), (const bf16*)(ws + WS_WUQ) + (size_t)j * 1536 * 512, NROWS, 1536, 512}; pg8::RepOrder<REP_GEMM> S; S.init(NROWS, 1536, G, bx);
              pg8::EpiQUp E{(bf16*)(ws + WS_QN), (bf16*)(ws + WS_QR), (const float*)(ws + WS_SSQ), (const float*)(ws + WS_COS), (const float*)(ws + WS_SIN)};
#if EN_G6
              pg8::gemm_phase<pg8::EpiQUp, pg8::RepOrder<REP_GEMM>, true, true>(ldsl, g, S, E, wave);
#endif
 }
            GRID_BAR();
            {
                PHASE_ARGS();
                const bf16* QN = (const bf16*)(ws + WS_QN); const bf16* QR = (const bf16*)(ws + WS_QR); const bf16* KN = (const bf16*)(ws + WS_KN); const bf16* KRB = (const bf16*)(ws + WS_KRB);
                const bf16* VV = (const bf16*)(ws + WS_VV); const bf16* SZ = (const bf16*)(ws + WS_SZ); bf16* OG = (bf16*)(ws + WS_OG);
                unsigned* qh = (unsigned*)(ws + WS_CTL) + CW_Q + j * 16 * 64;
                volatile LAS int* slot = (volatile LAS int*)(ldsl + LDSCTL_OFF + 16);
                const int myq = bx & 7; const bool prefS = ((bx >> 3) % PREF_DIV) < PREF_NUM;
                bool s_open = true, own_open = true; unsigned steal = 0xffffffffu;
#define DEQUEUE(dst, word) do { if (IS_T0()) *slot = (int)__hip_atomic_fetch_add(qh + (word) * 64, 1u, __ATOMIC_RELAXED, __HIP_MEMORY_SCOPE_AGENT); __syncthreads(); dst = *slot; __syncthreads(); } while (0)
#pragma unroll 1
                for (;;) {
                    int type = -1, id = 0, q = 0;
                    if (prefS && s_open) { DEQUEUE(id, 8); if (id < N_AS_ITEMS * REP_AS) type = 0; else s_open = false; }
                    if (type < 0 && own_open) { q = myq; DEQUEUE(id, q); if (id < 130 * REP_AP) { id = id % 130; type = id < 128 ? 1 : 2; } else own_open = false; }
                    if (type < 0 && s_open) { DEQUEUE(id, 8); if (id < N_AS_ITEMS * REP_AS) type = 0; else s_open = false; }
                    if (type < 0) {
                        if (steal == 0xffffffffu) { if (IS_T0()) { unsigned m_ = 0u;
#pragma unroll
                                for (int k_ = 0; k_ < 8; ++k_) if (__hip_atomic_load(qh + k_ * 64, __ATOMIC_RELAXED, __HIP_MEMORY_SCOPE_AGENT) < 130u * REP_AP) m_ |= 1u << k_;
                                *slot = (int)m_; } __syncthreads(); steal = (unsigned)*slot & ~(1u << myq); __syncthreads(); }
                        while (steal) { q = __builtin_ctz(steal); DEQUEUE(id, q); if (id < 130 * REP_AP) { id = id % 130; type = id < 128 ? 1 : 2; break; } steal &= ~(1u << q); }
                    }
                    if (type < 0) break;
#if EN_AS
                    if (type == 0) { id = id % N_AS_ITEMS; as::attn_s_unit(args, id / AS_SPLITS, id % AS_SPLITS, (char*)lds, wave); }
#endif
#if EN_AP
                    if (type == 1) { const int bh = q * 8 + (id & 7); ap::attn_unit(QN, QR, KN, KRB, VV, SZ, OG, bh >> 4, bh & 15, 15 - (id >> 3), false, (char*)lds, wave); }
                    if (type == 2) ap::attn_unit(QN, QR, KN, KRB, VV, SZ, OG, 0, q * 2 + (id - 128), 0, true, (char*)lds, wave);
#endif
                }
#undef DEQUEUE
            }
            GRID_BAR();
#if EN_COMB
            { PHASE_ARGS(); for (int u = vcu; u < NSAMP * REP_ELT; u += G) comb_unit(args, (u % NSAMP) >> 2, u & 3, (char*)lds, wave); }
#endif
            GRID_BAR();
        }
        { PHASE_ARGS(); const bf16* Ag = (const bf16*)(ws + (l < 2 ? WS_G : WS_OG)); const bf16* Wl = (const bf16*)(ws + (l < 2 ? WS_WOC : WS_WOM)) + (size_t)(l & 1) * 1024 * 1024;
#if EN_GOUT
          { pg8::Gemm g{Ag, Wl, NMAIN, 1024, 1024}; pg8::StaticOrder S; S.init(NMAIN, 1024, G, bx); pg8::EpiBf16 E{(bf16*)(ws + WS_MB), 1024, 0, 0};
            pg8::gemm_phase<pg8::EpiBf16, pg8::StaticOrder, true, true>(ldsl, g, S, E, wave); }
          { pg8::Gemm g{Ag, Wl, NROWS, 1024, 1024 / GOUT_SPLITK, 1024}; pg8::SplitKSmallOrder<GOUT_SPLITK> S; S.init(1024, 1024, G, bx); pg8::EpiPartF32 E{(float*)(ws + WS_PARTG), 1024 / GOUT_SPLITK};
            pg8::gemm_phase<pg8::EpiPartF32, pg8::SplitKSmallOrder<GOUT_SPLITK>, true, true>(ldsl, g, S, E, wave); }
#endif
          if (l < 2) { constexpr int r_ = 96; if (TAIL_CONV && G == 256 && bx >= r_) { LANE_OPAQUE(); convert_set(args, l == 0 ? 2 : 4, ldsl, (bx - r_) * NWAVES + wave, (256 - r_) * NWAVES, wave, lane); }
                       else if (TAIL_CONV && G != 256 && l == 0) { LANE_OPAQUE(); convert_set(args, 2, ldsl, gw, NGW, wave, lane); convert_set(args, 4, ldsl, gw, NGW, wave, lane); } }
 }
        GRID_BAR();
#if EN_NORM
        { PHASE_ARGS(); LANE_OPAQUE(); norm_phase(args, l, gw, NGW, lane); }
#endif
        if (l < 3) GRID_BAR();
    }
}

extern "C" void kernel_launch(void* const* d_in, const int* in_sizes, int n_in, void* d_out, int out_size, void* d_ws, size_t ws_size, hipStream_t stream) {
    static int grid = 0;
    if (grid == 0) {
        if (n_in != 21 || out_size != (int)O_END || ws_size < WS_END) { fprintf(stderr, "kernel_launch: unexpected shapes: n_in %d out %d (want %zu) ws %zu (want >= %zu)\n", n_in, out_size, (size_t)O_END, ws_size, (size_t)WS_END); grid = -1; return; }
        int dev = 0, cus = 0, per_cu = 0;
        if (hipGetDevice(&dev) != hipSuccess || hipDeviceGetAttribute(&cus, hipDeviceAttributeMultiprocessorCount, dev) != hipSuccess) { grid = -1; return; }
        if (hipFuncSetAttribute((const void*)yoco_fwd, hipFuncAttributeMaxDynamicSharedMemorySize, LDS_BYTES) != hipSuccess) { fprintf(stderr, "kernel_launch: hipFuncSetAttribute failed\n"); grid = -1; return; }
        if (hipOccupancyMaxActiveBlocksPerMultiprocessor(&per_cu, (const void*)yoco_fwd, NWAVES * 64, LDS_BYTES) != hipSuccess || per_cu < 1) { fprintf(stderr, "kernel_launch: occupancy query says %d blocks per CU\n", per_cu); }
        (void)hipGetLastError();
        grid = cus;
    }
    if (grid < 0) return;
    if (hipMemsetAsync((char*)d_ws + WS_CTL, 0, CTL_ZERO_BYTES, stream) != hipSuccess) return;
    Args a{};
    a.x_prompt = (const float*)d_in[0]; a.x_sample = (const float*)d_in[1]; a.cache_ckv = (const float*)d_in[2]; a.cache_krope = (const float*)d_in[3]; a.state_conv = (const float*)d_in[4];
    a.page_table = (const int*)d_in[5]; a.meta = (const float*)d_in[6]; a.pre_g = (const float*)d_in[7]; a.post_g = (const float*)d_in[8]; a.w_in_conv = (const float*)d_in[9];
    a.conv_w = (const float*)d_in[10]; a.w_out_conv = (const float*)d_in[11]; a.kv_norm_g = (const float*)d_in[12]; a.w_dkv = (const float*)d_in[13]; a.kv_lat_g = (const float*)d_in[14];
    a.w_uk = (const float*)d_in[15]; a.w_uv = (const float*)d_in[16]; a.w_in_mla = (const float*)d_in[17]; a.q_norm_g = (const float*)d_in[18]; a.w_uq = (const float*)d_in[19]; a.w_out_mla = (const float*)d_in[20];
    a.out = (float*)d_out; a.ws = (unsigned char*)d_ws;
    hipLaunchKernelGGL(yoco_fwd, dim3(grid), dim3(NWAVES * 64), LDS_BYTES, stream, a);
    const hipError_t le = hipPeekAtLastError();
    if (le != hipSuccess) fprintf(stderr, "kernel_launch: launch failed: %s\n", hipGetErrorName(le));
}
```

```cpp
#include <hip/hip_runtime.h>
#include <hip/hip_bf16.h>
#include <cstdio>
#include <cstdint>
#include <cmath>

constexpr int DM = 1024, NB = 4, SEQ = 4096, NMETA = 16, TTOT = SEQ + NMETA;
constexpr int DECB = 128, DECS = 4, PAST = 8192, PAGE = 128, NPAGES = PAST / PAGE;
constexpr int NH = 16, QKN = 64, QKR = 32, VH = 64, QLORA = 512, KVL = 256;
constexpr int NMAIN = NB * SEQ;
constexpr int SAMP0 = NMAIN, NSAMP = DECB * DECS;
constexpr int META0 = SAMP0 + NSAMP;
constexpr int NROWS = META0 + 256;
constexpr int NPOS = TTOT + DECS;
constexpr float RMS_EPS = 1e-6f;
constexpr int AS_SPLITS = 2, AS_PAGES = NPAGES / AS_SPLITS;
constexpr float QSCALE = 0.10206207261596575f * 1.4426950408889634f;

__device__ __forceinline__ float shfl_xor_f(float v, int mask, int lane) { return __int_as_float(__builtin_amdgcn_ds_bpermute((lane ^ mask) << 2, __float_as_int(v))); }

__device__ __forceinline__ int lane_fresh() { int l; asm volatile("v_mbcnt_lo_u32_b32 %0, -1, 0\n\tv_mbcnt_hi_u32_b32 %0, -1, %0" : "=v"(l)); return l & 63; }

template <class T> __device__ __forceinline__ T* opaque_global(T* p) { unsigned long long v = (unsigned long long)p; asm volatile("" : "+s"(v)); return (T*)(__attribute__((address_space(1))) T*)v; }

namespace pg8 {
#define PG8_LAS __attribute__((address_space(3)))
typedef unsigned short bf16_t;
typedef short bf16x8 __attribute__((ext_vector_type(8)));
typedef float f32x4 __attribute__((ext_vector_type(4)));
typedef unsigned u32x4 __attribute__((ext_vector_type(4)));
constexpr int BM = 256, BK = 64, HALF = 128, HTB = HALF * BK * 2  , STAGE_BYTES = 8 * HTB, NXCD = 8, WGM = 8;

__host__ __device__ __forceinline__ int lds_byte(int r, int c) { const int st = (r >> 4) * 2 + (c >> 5), rr = r & 15, cc = c & 31, ob = rr * 64 + cc * 2; return st * 1024 + (ob ^ (((ob >> 9) & 1) << 5)); }
__host__ __device__ __forceinline__ void stage_rc(int b, int& R, int& C) { const int st = b / 1024, sb = b % 1024, swz = sb ^ (((sb >> 9) & 1) << 5); R = (st >> 1) * 16 + swz / 64; C = (st & 1) * 32 + (swz % 64) / 2; }
__host__ __device__ __forceinline__ int perm32(int rho) { const int n = rho >> 4, i = rho & 15; return 8 * (i >> 2) + 4 * n + (i & 3); }

struct Unit { int pm, pn; int koff = 0; };
struct Gemm { const bf16_t* A; const bf16_t* Bt; int M, N, K; int ld = 0; };

struct StaticOrder {
    int nM, nN, nwg, G, c;
    __host__ __device__ void init(int M, int N, int G_, int c_) { nM = M / BM; nN = N / BM; nwg = nM * nN; G = G_; c = c_; }
    __host__ __device__ bool next(int i, Unit& u) const {
        const long L = (long)i * G + c; if (L >= nwg) return false;
        int wgid = (int)L; { const int q = nwg / NXCD, r = nwg % NXCD, xcd = wgid % NXCD, off = wgid / NXCD; wgid = (xcd < r ? xcd * (q + 1) : r * (q + 1) + (xcd - r) * q) + off; }
        const int nig = WGM * nN, gid = wgid / nig, fm = gid * WGM, gsz = (nM - fm) < WGM ? (nM - fm) : WGM;
        u.pm = fm + ((wgid % nig) % gsz); u.pn = (wgid % nig) / gsz; return true;
    }
    __device__ __forceinline__ void a_ready(const Unit&) const {}
    __device__ __forceinline__ void done(const Unit&) const {}
};


template <int R> struct RepOrder {
    StaticOrder base; int cnt;
    __host__ __device__ void init(int M, int N, int G_, int c_) { base.init(M, N, G_, c_); cnt = (base.nwg - c_ + G_ - 1) / G_; if (cnt < 0) cnt = 0; }
    __host__ __device__ bool next(int i, Unit& u) const { if (i >= R * cnt) return false; return base.next(i % cnt, u); }
    __device__ __forceinline__ void a_ready(const Unit&) const {}
    __device__ __forceinline__ void done(const Unit&) const {}
};

template <int S> struct SplitKSmallOrder {
    int nN, G, c, ksub;
    __host__ __device__ void init(int N, int K, int G_, int c_) { nN = N / BM; G = G_; c = c_; ksub = K / S; }
    __host__ __device__ bool next(int i, Unit& u) const { const long L = (long)i * G + c; if (L >= 3L * nN * S) return false; const int r = (int)(L / S); u.koff = (int)(L % S) * ksub; u.pm = 64 + r % 3; u.pn = r / 3; return true; }
    __device__ __forceinline__ void a_ready(const Unit&) const {}
    __device__ __forceinline__ void done(const Unit&) const {}
};

typedef float f32x2_t __attribute__((ext_vector_type(2))); typedef __bf16 bf16x2_t __attribute__((ext_vector_type(2)));
__device__ __forceinline__ unsigned cvt_pk_bf16(float lo, float hi) { f32x2_t v = {lo, hi}; bf16x2_t b = __builtin_convertvector(v, bf16x2_t); return __builtin_bit_cast(unsigned, b); }
typedef unsigned u32x2 __attribute__((ext_vector_type(2)));
__device__ __forceinline__ float sigmoidf_fast(float z) { return __builtin_amdgcn_rcpf(1.0f + __builtin_amdgcn_exp2f(-1.4426950408889634f * z)); }

struct EpiBf16 {
    static constexpr bool PERM = true, AFTER_DRAIN = false;
    bf16_t* O; int ldc; int split_cols; size_t split_stride;
    __device__ __forceinline__ void operator()(const f32x4 (&acc)[2][2][4][2], const Unit& u, int wr, int wc, int fr, int fq) const {
        const int row0 = u.pm * BM + wr * 64 + fr; int colt = u.pn * BM; bf16_t* base = O;
        if (split_cols && colt >= split_cols) { base += split_stride; colt -= split_cols; }
        const int col0 = colt + wc * 32 + 8 * fq;
#pragma unroll
        for (int ai = 0; ai < 2; ++ai)
#pragma unroll
            for (int m = 0; m < 4; ++m) { bf16_t* rowp = base + (size_t)(row0 + ai * HALF + m * 16) * ldc + col0;
#pragma unroll
                for (int bj = 0; bj < 2; ++bj) { const f32x4 v0 = acc[ai][bj][m][0], v1 = acc[ai][bj][m][1];
                    u32x4 w; w.x = cvt_pk_bf16(v0[0], v0[1]); w.y = cvt_pk_bf16(v0[2], v0[3]); w.z = cvt_pk_bf16(v1[0], v1[1]); w.w = cvt_pk_bf16(v1[2], v1[3]);
                    *(u32x4*)(rowp + bj * HALF) = w; } }
    }
};

struct EpiConvSplit {
    static constexpr bool PERM = true, AFTER_DRAIN = false;
    bf16_t* V; bf16_t* GZ; const float* RS;
    __device__ __forceinline__ void operator()(const f32x4 (&acc)[2][2][4][2], const Unit& u, int wr, int wc, int fr, int fq) const {
        const int row0 = u.pm * BM + wr * 64 + fr, ch0 = u.pn * 64 + wc * 16 + fq * 4;
#pragma unroll
        for (int ai = 0; ai < 2; ++ai)
#pragma unroll
            for (int m = 0; m < 4; ++m) { const size_t off = (size_t)(row0 + ai * HALF + m * 16) * 1024 + ch0;
                const float rs = RS[row0 + ai * HALF + m * 16];
                const f32x4 bg = acc[ai][0][m][0] * rs, cg = acc[ai][0][m][1] * rs, uu = acc[ai][1][m][0] * rs, zz = acc[ai][1][m][1] * rs;
                const f32x4 v = cg * uu; f32x4 g;
#pragma unroll
                for (int e = 0; e < 4; ++e) g[e] = bg[e] * zz[e] * sigmoidf_fast(zz[e]);
                u32x2 wv, wg; wv.x = cvt_pk_bf16(v[0], v[1]); wv.y = cvt_pk_bf16(v[2], v[3]); wg.x = cvt_pk_bf16(g[0], g[1]); wg.y = cvt_pk_bf16(g[2], g[3]);
                *(u32x2*)(V + off) = wv; *(u32x2*)(GZ + off) = wg; }
    }
};

struct EpiMlaIn {
    static constexpr bool PERM = true, AFTER_DRAIN = false;
    float* CKR; bf16_t* QL; float* SSQ; bf16_t* SZ; int nck; const float* RS;
    __device__ __forceinline__ void operator()(const f32x4 (&acc)[2][2][4][2], const Unit& u, int wr, int wc, int fr, int fq) const {
        const int row0 = u.pm * BM + wr * 64 + fr; const int t = u.pn - nck;
        if (t < 0) {
            const int col0 = u.pn * BM + wc * 32 + 8 * fq;
#pragma unroll
            for (int ai = 0; ai < 2; ++ai)
#pragma unroll
                for (int m = 0; m < 4; ++m) { float* rowp = CKR + (size_t)(row0 + ai * HALF + m * 16) * 512 + col0; const float rs = RS[row0 + ai * HALF + m * 16];
#pragma unroll
                    for (int bj = 0; bj < 2; ++bj) { *(f32x4*)(rowp + bj * HALF) = acc[ai][bj][m][0] * rs; *(f32x4*)(rowp + bj * HALF + 4) = acc[ai][bj][m][1] * rs; } }
        } else if (t < 2) {
            const int col0 = t * BM + wc * 32 + 8 * fq;
#pragma unroll
            for (int ai = 0; ai < 2; ++ai)
#pragma unroll
                for (int m = 0; m < 4; ++m) { const int row = row0 + ai * HALF + m * 16; bf16_t* rowp = QL + (size_t)row * 512 + col0; float s = 0.f; const float rs = RS[row];
#pragma unroll
                    for (int bj = 0; bj < 2; ++bj) { const f32x4 v0 = acc[ai][bj][m][0] * rs, v1 = acc[ai][bj][m][1] * rs;
                        s += (v0[0] * v0[0] + v0[1] * v0[1]) + (v0[2] * v0[2] + v0[3] * v0[3]) + (v1[0] * v1[0] + v1[1] * v1[1]) + (v1[2] * v1[2] + v1[3] * v1[3]);
                        u32x4 w; w.x = cvt_pk_bf16(v0[0], v0[1]); w.y = cvt_pk_bf16(v0[2], v0[3]); w.z = cvt_pk_bf16(v1[0], v1[1]); w.w = cvt_pk_bf16(v1[2], v1[3]);
                        *(u32x4*)(rowp + bj * HALF) = w; }
                    { const int ln = fq * 16 + fr; s += shfl_xor_f(s, 16, ln); s += shfl_xor_f(s, 32, ln); }
                    if (fq == 0) SSQ[(size_t)row * 8 + t * 4 + wc] = s; }
        } else {
            const int col0 = (t - 2) * BM + wc * 32 + 8 * fq;
#pragma unroll
            for (int ai = 0; ai < 2; ++ai)
#pragma unroll
                for (int m = 0; m < 4; ++m) { bf16_t* rowp = SZ + (size_t)(row0 + ai * HALF + m * 16) * 1024 + col0; const float rs = RS[row0 + ai * HALF + m * 16];
#pragma unroll
                    for (int bj = 0; bj < 2; ++bj) { f32x4 v0 = acc[ai][bj][m][0] * rs, v1 = acc[ai][bj][m][1] * rs;
#pragma unroll
                        for (int e = 0; e < 4; ++e) { v0[e] = v0[e] * sigmoidf_fast(v0[e]); v1[e] = v1[e] * sigmoidf_fast(v1[e]); }
                        u32x4 w; w.x = cvt_pk_bf16(v0[0], v0[1]); w.y = cvt_pk_bf16(v0[2], v0[3]); w.z = cvt_pk_bf16(v1[0], v1[1]); w.w = cvt_pk_bf16(v1[2], v1[3]);
                        *(u32x4*)(rowp + bj * HALF) = w; } }
        }
    }
};

__device__ __forceinline__ int posidx_of_row(int row) {
    return row < NMAIN ? (row & (SEQ - 1)) + NMETA : (row < META0 ? TTOT + ((row - SAMP0) & 3) : (row < META0 + NMETA ? row - META0 : 0));
}
struct EpiQUp {
    static constexpr bool PERM = true, AFTER_DRAIN = false;
    bf16_t* QN; bf16_t* QR; const float* SSQ; const float* COS; const float* SIN;
    __device__ __forceinline__ void operator()(const f32x4 (&acc)[2][2][4][2], const Unit& u, int wr, int wc, int fr, int fq) const {
        const int row0 = u.pm * BM + wr * 64 + fr;
#pragma unroll
        for (int ai = 0; ai < 2; ++ai)
#pragma unroll
            for (int m = 0; m < 4; ++m) { const int row = row0 + ai * HALF + m * 16;
                const f32x4 s0 = *(const f32x4*)(SSQ + (size_t)row * 8), s1 = *(const f32x4*)(SSQ + (size_t)row * 8 + 4);
                const float ss = ((s0[0] + s0[1]) + (s0[2] + s0[3])) + ((s1[0] + s1[1]) + (s1[2] + s1[3]));
                const float sc = QSCALE / sqrtf(ss * (1.0f / 512.0f) + RMS_EPS);
                if (u.pn < 4) { bf16_t* rowp = QN + (size_t)row * 1024 + u.pn * BM + wc * 32 + 8 * fq;
#pragma unroll
                    for (int bj = 0; bj < 2; ++bj) { const f32x4 v0 = acc[ai][bj][m][0] * sc, v1 = acc[ai][bj][m][1] * sc;
                        u32x4 w; w.x = cvt_pk_bf16(v0[0], v0[1]); w.y = cvt_pk_bf16(v0[2], v0[3]); w.z = cvt_pk_bf16(v1[0], v1[1]); w.w = cvt_pk_bf16(v1[2], v1[3]);
                        *(u32x4*)(rowp + bj * HALF) = w; }
                } else { const int pi = posidx_of_row(row);
                    const f32x4 cs = *(const f32x4*)(COS + pi * 16 + 4 * fq), sn = *(const f32x4*)(SIN + pi * 16 + 4 * fq);
#pragma unroll
                    for (int bj = 0; bj < 2; ++bj) { const f32x4 x1 = acc[ai][bj][m][0] * sc, x2 = acc[ai][bj][m][1] * sc;
                        const f32x4 o1 = x1 * cs - x2 * sn, o2 = x1 * sn + x2 * cs;
                        bf16_t* hp = QR + (size_t)row * 512 + ((u.pn - 4) * 8 + 4 * bj + wc) * 32 + 4 * fq;
                        u32x2 w1, w2; w1.x = cvt_pk_bf16(o1[0], o1[1]); w1.y = cvt_pk_bf16(o1[2], o1[3]); w2.x = cvt_pk_bf16(o2[0], o2[1]); w2.y = cvt_pk_bf16(o2[2], o2[3]);
                        *(u32x2*)hp = w1; *(u32x2*)(hp + 16) = w2; } }
            }
    }
};


struct EpiPartF32 {
    static constexpr bool PERM = true, AFTER_DRAIN = false;
    float* P; int ksub;
    __device__ __forceinline__ void operator()(const f32x4 (&acc)[2][2][4][2], const Unit& u, int wr, int wc, int fr, int fq) const {
        float* base = P + ((size_t)(u.koff / ksub) * 768 + (size_t)(u.pm - 64) * BM + wr * 64 + fr) * 1024 + u.pn * BM + wc * 32 + 8 * fq;
#pragma unroll
        for (int ai = 0; ai < 2; ++ai)
#pragma unroll
            for (int m = 0; m < 4; ++m) { float* rowp = base + (size_t)(ai * HALF + m * 16) * 1024;
#pragma unroll
                for (int bj = 0; bj < 2; ++bj) { *(f32x4*)(rowp + bj * HALF) = acc[ai][bj][m][0]; *(f32x4*)(rowp + bj * HALF + 4) = acc[ai][bj][m][1]; } }
    }
};
template <class Epi, class Sched, bool ALIGN_EPI = false, bool SP2 = false>
__device__ __forceinline__ void gemm_phase(PG8_LAS unsigned char* lds, const Gemm g, const Sched& S, const Epi& E, const int wave) {
    int wave_ = wave; asm volatile("" : "+s"(wave_)); wave_ &= 7;
    const int lane = lane_fresh(), tid = wave_ * 64 + lane, wid = wave_, wr = wid >> 2, wc = wid & 3, fr = lane & 15, fq = lane >> 4;
    const int K = g.K, nt = K / BK, ld = g.ld ? g.ld : g.K;
    unsigned voffA[2], voffB[2];
#pragma unroll
    for (int i = 0; i < 2; ++i) { int R, C; stage_rc(tid * 16 + i * 8192, R, C); const int Rb = Epi::PERM ? ((R & ~31) + perm32(R & 31)) : R;
        voffA[i] = (unsigned)(R * ld + C) * 2u; voffB[i] = (unsigned)(Rb * ld + C) * 2u; }
    const size_t kstep = (size_t)(BK * 2);
    const size_t hstep = (size_t)HALF * ld * 2;
    const size_t tstep = 2 * hstep;
    const unsigned ldsw = (unsigned)wid * 1024u;
    const int aoff = lds_byte(wr * 64 + fr, fq * 8), boff = lds_byte(wc * 32 + fr, fq * 8);
#define PG8_SA(b, h) (((b) * 2 + (h)) * HTB)
#define PG8_SB(b, h) ((4 + (b) * 2 + (h)) * HTB)
#define PG8_STAGE(bufoff, gbase, voff) do { _Pragma("unroll") for (int _i = 0; _i < 2; ++_i) \
        __builtin_amdgcn_global_load_lds((const unsigned*)((const char*)(gbase) + (voff)[_i]), (PG8_LAS unsigned*)(lds + (bufoff) + ldsw + _i * 8192), 16, 0, 0); } while (0)
#define PG8_LDA(dst, b, h) do { _Pragma("unroll") for (int m = 0; m < 4; ++m) _Pragma("unroll") for (int k = 0; k < 2; ++k) dst[m][k] = *(const PG8_LAS bf16x8*)(lds + PG8_SA(b, h) + aoff + m * 2048 + k * 1024); } while (0)
#define PG8_LDB(dst, b, h) do { _Pragma("unroll") for (int n = 0; n < 2; ++n) _Pragma("unroll") for (int k = 0; k < 2; ++k) dst[n][k] = *(const PG8_LAS bf16x8*)(lds + PG8_SB(b, h) + boff + n * 2048 + k * 1024); } while (0)
#define PG8_MMA(ai, bj, At, Bt) do { __builtin_amdgcn_s_setprio(1); _Pragma("unroll") for (int m = 0; m < 4; ++m) _Pragma("unroll") for (int n = 0; n < 2; ++n) _Pragma("unroll") for (int k = 0; k < 2; ++k) \
        acc[ai][bj][m][n] = __builtin_amdgcn_mfma_f32_16x16x32_bf16(Bt[n][k], At[m][k], acc[ai][bj][m][n], 0, 0, 0); __builtin_amdgcn_s_setprio(0); } while (0)
#define PG8_WAIT_V(n) asm volatile("s_waitcnt vmcnt(" #n ")" ::: "memory")
#define PG8_WAIT_L(n) asm volatile("s_waitcnt lgkmcnt(" #n ")" ::: "memory")
#define PG8_BAR __builtin_amdgcn_s_barrier()
#define PG8_SCHED __builtin_amdgcn_sched_barrier(0)
    Unit cur, nxt; int ui = 0;
    if (!S.next(0, cur)) return;
    f32x4 acc[2][2][4][2];
    float zf_ = 0.f; asm volatile("" : "+v"(zf_));
#pragma unroll
    for (int a = 0; a < 2; ++a)
#pragma unroll
        for (int b = 0; b < 2; ++b)
#pragma unroll
            for (int m = 0; m < 4; ++m)
#pragma unroll
                for (int n = 0; n < 2; ++n) acc[a][b][m][n] = (f32x4){zf_, zf_, zf_, zf_};
    bf16x8 At[4][2], B0[2][2], B1[2][2];
    const char* cA = (const char*)g.A + (size_t)cur.pm * tstep + (size_t)cur.koff * 2; const char* cB = (const char*)g.Bt + (size_t)cur.pn * tstep + (size_t)cur.koff * 2;
    S.a_ready(cur);
    if constexpr (SP2) {
        PG8_STAGE(PG8_SB(0, 0), cB, voffB); PG8_STAGE(PG8_SB(0, 1), cB + hstep, voffB); PG8_STAGE(PG8_SA(0, 0), cA, voffA); PG8_STAGE(PG8_SA(0, 1), cA + hstep, voffA);
        if (wr == 1) PG8_BAR;
        PG8_WAIT_V(2); PG8_BAR;
        PG8_STAGE(PG8_SB(1, 0), cB + kstep, voffB); PG8_STAGE(PG8_SA(1, 0), cA + kstep, voffA); PG8_STAGE(PG8_SB(1, 1), cB + hstep + kstep, voffB);
        PG8_WAIT_V(6); PG8_BAR;
    } else {
        PG8_STAGE(PG8_SB(0, 0), cB, voffB); PG8_STAGE(PG8_SA(0, 0), cA, voffA); PG8_STAGE(PG8_SB(0, 1), cB + hstep, voffB); PG8_STAGE(PG8_SA(0, 1), cA + hstep, voffA);
        if (wr == 1) PG8_BAR;
        PG8_WAIT_V(4); PG8_BAR;
        PG8_STAGE(PG8_SB(1, 0), cB + kstep, voffB); PG8_STAGE(PG8_SA(1, 0), cA + kstep, voffA); PG8_STAGE(PG8_SB(1, 1), cB + hstep + kstep, voffB);
        PG8_WAIT_V(6); PG8_BAR;
    }
    for (;;) {
        const bool has_next = S.next(ui + 1, nxt);
        const char* nA = has_next ? (const char*)g.A + (size_t)nxt.pm * tstep + (size_t)nxt.koff * 2 : cA; const char* nB = has_next ? (const char*)g.Bt + (size_t)nxt.pn * tstep + (size_t)nxt.koff * 2 : cB;
        for (int t = 0; t < nt; t += 2) {
            const bool last = (t == nt - 2);
            const char* a1 = cA + (size_t)(t + 1) * kstep;
            const char* a2 = last ? nA : cA + (size_t)(t + 2) * kstep; const char* b2 = last ? nB : cB + (size_t)(t + 2) * kstep;
            const char* a3 = a2 + kstep; const char* b3 = b2 + kstep;
            if (last && has_next) S.a_ready(nxt);
            if constexpr (SP2) {
            PG8_LDB(B0, 0, 0); PG8_LDB(B1, 0, 1); PG8_SCHED; PG8_LDA(At, 0, 0); PG8_STAGE(PG8_SA(1, 1), a1 + hstep, voffA);
            PG8_WAIT_V(8); PG8_WAIT_L(0); PG8_BAR; PG8_MMA(0, 0, At, B0); PG8_MMA(0, 1, At, B1); PG8_BAR; PG8_SCHED;
            PG8_LDA(At, 0, 1); PG8_STAGE(PG8_SB(0, 0), b2, voffB); PG8_STAGE(PG8_SB(0, 1), b2 + hstep, voffB); PG8_STAGE(PG8_SA(0, 0), a2, voffA);
            PG8_WAIT_V(8); PG8_WAIT_L(0); PG8_BAR; PG8_MMA(1, 0, At, B0); PG8_MMA(1, 1, At, B1); PG8_BAR; PG8_SCHED;
            PG8_LDB(B0, 1, 0); PG8_LDB(B1, 1, 1); PG8_SCHED; PG8_LDA(At, 1, 0); PG8_STAGE(PG8_SA(0, 1), a2 + hstep, voffA);
            PG8_WAIT_V(8); PG8_WAIT_L(0); PG8_BAR; PG8_MMA(0, 0, At, B0); PG8_MMA(0, 1, At, B1); PG8_BAR; PG8_SCHED;
            PG8_LDA(At, 1, 1); PG8_STAGE(PG8_SB(1, 0), b3, voffB); PG8_STAGE(PG8_SB(1, 1), b3 + hstep, voffB); PG8_STAGE(PG8_SA(1, 0), a3, voffA);
            PG8_WAIT_V(8); PG8_WAIT_L(0); PG8_BAR; PG8_MMA(1, 0, At, B0); PG8_MMA(1, 1, At, B1); PG8_BAR; PG8_SCHED;
            } else {
            PG8_LDB(B0, 0, 0); PG8_SCHED; PG8_LDA(At, 0, 0); PG8_STAGE(PG8_SA(1, 1), a1 + hstep, voffA);
            PG8_WAIT_L(8); PG8_BAR; PG8_WAIT_L(0); PG8_MMA(0, 0, At, B0); PG8_BAR; PG8_SCHED;
            PG8_LDB(B1, 0, 1); PG8_STAGE(PG8_SB(0, 0), b2, voffB);
            PG8_BAR; PG8_WAIT_L(0); PG8_MMA(0, 1, At, B1); PG8_BAR;
            PG8_LDA(At, 0, 1); PG8_STAGE(PG8_SA(0, 0), a2, voffA);
            PG8_BAR; PG8_WAIT_L(0); PG8_MMA(1, 0, At, B0); PG8_BAR; PG8_SCHED;
            PG8_STAGE(PG8_SB(0, 1), b2 + hstep, voffB);
            PG8_WAIT_V(6); PG8_BAR; PG8_MMA(1, 1, At, B1); PG8_BAR;
            PG8_LDB(B0, 1, 0); PG8_SCHED; PG8_LDA(At, 1, 0); PG8_STAGE(PG8_SA(0, 1), a2 + hstep, voffA);
            PG8_WAIT_L(8); PG8_BAR; PG8_WAIT_L(0); PG8_MMA(0, 0, At, B0); PG8_BAR; PG8_SCHED;
            PG8_LDB(B1, 1, 1); PG8_STAGE(PG8_SB(1, 0), b3, voffB);
            PG8_BAR; PG8_WAIT_L(0); PG8_MMA(0, 1, At, B1); PG8_BAR;
            PG8_LDA(At, 1, 1); PG8_STAGE(PG8_SA(1, 0), a3, voffA);
            PG8_BAR; PG8_WAIT_L(0); PG8_MMA(1, 0, At, B0); PG8_BAR; PG8_SCHED;
            PG8_STAGE(PG8_SB(1, 1), b3 + hstep, voffB);
            PG8_WAIT_V(6); PG8_BAR; PG8_MMA(1, 1, At, B1); PG8_BAR;
            }
        }
        if constexpr (ALIGN_EPI) { if (wr == 0) PG8_BAR; }
        if constexpr (!Epi::AFTER_DRAIN) { const int ln_ = lane_fresh(); const int fr_ = ln_ & 15, fq_ = ln_ >> 4;
            E(acc, cur, wr, wc, fr_, fq_); S.done(cur); }
        if (!has_next) break;
        float zg_ = 0.f; asm volatile("" : "+v"(zg_));
#pragma unroll
        for (int a = 0; a < 2; ++a)
#pragma unroll
            for (int b = 0; b < 2; ++b)
#pragma unroll
                for (int m = 0; m < 4; ++m)
#pragma unroll
                    for (int n = 0; n < 2; ++n) acc[a][b][m][n] = (f32x4){zg_, zg_, zg_, zg_};
        cur = nxt; cA = nA; cB = nB; ++ui;
        if constexpr (ALIGN_EPI) { if (wr == 1) PG8_BAR; }
    }
    PG8_WAIT_V(0);
    if constexpr (!ALIGN_EPI) { if (wr == 0) PG8_BAR; }
    PG8_BAR;
    if constexpr (Epi::AFTER_DRAIN) { E.fused(acc, cur, wr, wc, fr, fq, lds, wid, lane); S.done(cur); }
#undef PG8_SA
#undef PG8_SB
#undef PG8_STAGE
#undef PG8_LDA
#undef PG8_LDB
#undef PG8_MMA
#undef PG8_WAIT_V
#undef PG8_WAIT_L
#undef PG8_BAR
#undef PG8_SCHED
}
}
#define GAS __attribute__((address_space(1)))
#define LAS __attribute__((address_space(3)))
typedef unsigned short bf16;
typedef unsigned v4u __attribute__((ext_vector_type(4)));
typedef float f32x4 __attribute__((ext_vector_type(4)));
typedef short bf16x8 __attribute__((ext_vector_type(8)));
typedef GAS unsigned gu32;
typedef GAS unsigned long long gu64;
#define RLX_AGENT __ATOMIC_RELAXED, __HIP_MEMORY_SCOPE_AGENT
#define LDS_WAIT() asm volatile("s_waitcnt lgkmcnt(0)" ::: "memory")
#define VM_WAIT() asm volatile("s_waitcnt vmcnt(0)" ::: "memory")
__device__ __forceinline__ unsigned long long rt() { return __builtin_amdgcn_s_memrealtime(); }
__device__ __forceinline__ unsigned f2bf(float f) { unsigned u = __builtin_bit_cast(unsigned, f); return (u + 0x7fffu + ((u >> 16) & 1u)) >> 16; }
__device__ __forceinline__ unsigned pk2(float lo, float hi) { return f2bf(lo) | (f2bf(hi) << 16); }

#define XB_TMO      128
#define XB_XCNT(j)  (256  + 64 * (j))
#define XB_XSUB(j)  (1280 + 64 * (j))
#define XB_XGEN(j)  (2304 + 64 * (j))
#define XB_TOP      3328
#define XB_TOPGEN   3392
#define XCD_BAR_WORDS 3456
#define XB_SPIN_CAP (1u << 18)

__device__ __forceinline__ unsigned xb_ld(unsigned* p)              { return __hip_atomic_load(p, __ATOMIC_RELAXED, __HIP_MEMORY_SCOPE_AGENT); }
__device__ __forceinline__ unsigned xb_add(unsigned* p, unsigned v) { return __hip_atomic_fetch_add(p, v, __ATOMIC_RELAXED, __HIP_MEMORY_SCOPE_AGENT); }
__device__ __forceinline__ unsigned xb_xcc_id() { return (unsigned)__builtin_amdgcn_s_getreg((3 << 11) | 20) & 0xFu; }
#define XB_SPIN(cond, bar) do { unsigned _sp = 0; while (cond) { __builtin_amdgcn_s_sleep(1); \
    if ((++_sp & 255u) == 0u) { if (xb_ld(&(bar)[XB_TMO])) break; if (_sp > XB_SPIN_CAP) { atomicAdd(&(bar)[XB_TMO], 1u); break; } } } } while (0)

struct XcdBarrier {
    unsigned* bar; unsigned x;
    volatile LAS unsigned* st;
};

__device__ __forceinline__ XcdBarrier xcd_barrier_post(unsigned* bar, volatile LAS unsigned* st, const bool is_t0) {
    XcdBarrier b; b.bar = bar; b.x = xb_xcc_id(); b.st = st;
    if (is_t0) (void)xb_add(&bar[XB_XCNT(b.x)], 1u);
    return b;
}
__device__ __forceinline__ void xcd_barrier_complete(unsigned* bar, unsigned x, unsigned& nloc, unsigned& nx) {
    const unsigned G = gridDim.x * gridDim.y * gridDim.z;
    unsigned sum, cnt, mine, sp = 0u;
    for (;;) {
        sum = 0u; cnt = 0u; mine = 0u;
#pragma unroll
        for (unsigned j = 0; j < 16; ++j) { const unsigned c = xb_ld(&bar[XB_XCNT(j)]); sum += c; cnt += (c > 0u) ? 1u : 0u; mine = (j == x) ? c : mine; }
        if (sum == G) break;
        __builtin_amdgcn_s_sleep(1);
        if ((++sp & 255u) == 0u) { if (xb_ld(&bar[XB_TMO])) break; if (sp > XB_SPIN_CAP) { atomicAdd(&bar[XB_TMO], 1u); break; } }
    }
    nloc = mine > 0u ? mine : 1u; nx = cnt > 0u ? cnt : 1u;
}

__device__ __forceinline__ void xcd_barrier(const XcdBarrier& b, const bool is_t0) {
    asm volatile("s_waitcnt vmcnt(0)" ::: "memory");
    __syncthreads();
    if (is_t0) {
        unsigned* bar = b.bar;
        __builtin_amdgcn_s_waitcnt(0);
        unsigned nloc = b.st[0], nx = b.st[1];
        if (nloc == 0u) { xcd_barrier_complete(bar, b.x, nloc, nx); b.st[0] = nloc; b.st[1] = nx; }
        const unsigned old = xb_add(&bar[XB_XSUB(b.x)], 1u);
        const unsigned gen = old / nloc;
        if (old + 1u == (gen + 1u) * nloc) {
            __builtin_amdgcn_fence(__ATOMIC_RELEASE, "agent");
            asm volatile("s_waitcnt vmcnt(0)" ::: "memory");
            const unsigned og = xb_add(&bar[XB_TOP], 1u);
            const unsigned tg = og / nx;
            if (og + 1u == (tg + 1u) * nx) xb_add(&bar[XB_TOPGEN], 1u);
            else XB_SPIN(xb_ld(&bar[XB_TOPGEN]) == tg, bar);
            __builtin_amdgcn_fence(__ATOMIC_ACQUIRE, "agent");
            xb_add(&bar[XB_XGEN(b.x)], 1u);
            asm volatile("s_waitcnt vmcnt(0)" ::: "memory");
        } else {
            XB_SPIN(xb_ld(&bar[XB_XGEN(b.x)]) == gen, bar);
            __builtin_amdgcn_fence(__ATOMIC_ACQUIRE, "agent");
            asm volatile("s_waitcnt vmcnt(0)" ::: "memory");
        }
    }
    __syncthreads();
}

constexpr size_t MiB = 1u << 20;
constexpr size_t WS_CTL = 0, CTL_ZERO_BYTES = 64 * 1024;
constexpr int CW_BAR = 1024;
constexpr int CW_Q = 8192;
constexpr size_t WS_COS = 1 * MiB;
constexpr size_t WS_SIN = WS_COS + 512 * 1024;
constexpr size_t WS_WIN  = 2 * MiB;
constexpr size_t WS_WOC  = WS_WIN + 16 * MiB;
constexpr size_t WS_WA0  = WS_WOC + 4 * MiB;
constexpr size_t WS_WA1  = WS_WA0 + 4 * MiB;
constexpr size_t WS_WUKV = WS_WA1 + 3 * MiB;
constexpr size_t WS_WUQ  = WS_WUKV + 1 * MiB;
constexpr size_t WS_WOM  = WS_WUQ + 3 * MiB;
constexpr size_t WS_WUKB = WS_WOM + 4 * MiB;
constexpr size_t WS_ACT  = 40 * MiB;
constexpr size_t SZ_F32R = (size_t)NROWS * 1024 * 4, SZ_BFR = (size_t)NROWS * 1024 * 2;
constexpr size_t WS_X    = WS_ACT;
constexpr size_t WS_XH   = WS_X + SZ_F32R;
constexpr size_t WS_V1   = WS_XH + SZ_BFR;
constexpr size_t WS_GZ   = WS_V1 + SZ_BFR;
constexpr size_t WS_G    = WS_GZ + SZ_BFR;
constexpr size_t WS_MB   = WS_G + SZ_BFR;
constexpr size_t WS_CKR  = WS_MB + SZ_BFR;
constexpr size_t WS_CB   = WS_CKR + (size_t)NROWS * 512 * 4;
constexpr size_t WS_KRB  = WS_CB + (size_t)NROWS * 256 * 2;
constexpr size_t WS_KN   = WS_KRB + (size_t)NROWS * 32 * 2;
constexpr size_t WS_VV   = WS_KN + SZ_BFR;
constexpr size_t WS_QL   = WS_VV + SZ_BFR;
constexpr size_t WS_SSQ  = WS_QL + (size_t)NROWS * 512 * 2;
constexpr size_t WS_SZ   = WS_SSQ + (size_t)NROWS * 8 * 4;
constexpr size_t WS_QN   = WS_SZ + SZ_BFR;
constexpr size_t WS_QR   = WS_QN + SZ_BFR;
constexpr size_t WS_OG   = WS_QR + (size_t)NROWS * 512 * 2;
constexpr size_t WS_PART = WS_OG + SZ_BFR;
constexpr size_t WS_PML  = WS_PART + (size_t)DECB * 4 * 64 * 256 * 4;
constexpr size_t WS_QABS = WS_PML + (size_t)DECB * 4 * 2 * 64 * 4;
constexpr int GOUT_SPLITK = 8;
constexpr size_t WS_PARTG = WS_QABS + (size_t)DECB * 64 * 288 * 2;
constexpr size_t WS_END  = WS_PARTG + (size_t)GOUT_SPLITK * 768 * 1024 * 4;
static_assert(WS_WUKB + 1 * MiB <= WS_ACT && WS_END < 1024 * MiB, "d_ws map");

constexpr size_t O_YP = 0, O_YS = O_YP + (size_t)NB * SEQ * DM, O_CKP = O_YS + (size_t)NSAMP * DM, O_KRP = O_CKP + (size_t)NB * TTOT * KVL,
                 O_CVP = O_KRP + (size_t)NB * TTOT * QKR, O_CKS = O_CVP + (size_t)2 * NB * 2 * DM, O_KRS = O_CKS + (size_t)NSAMP * KVL,
                 O_CVS = O_KRS + (size_t)NSAMP * QKR, O_END = O_CVS + (size_t)2 * DECB * 2 * DM;

#ifndef TAIL_CONV
#define TAIL_CONV 1
#endif
constexpr size_t WS_RS = WS_XH;
constexpr int RING_BYTES = 131072;
constexpr int LDS_BYTES = 163840;
constexpr int LDSCTL_OFF = LDS_BYTES - 64;
constexpr int NWAVES = 8;

struct Args {
    const float* x_prompt; const float* x_sample; const float* cache_ckv; const float* cache_krope; const float* state_conv; const int* page_table;
    const float* meta; const float* pre_g; const float* post_g; const float* w_in_conv; const float* conv_w; const float* w_out_conv;
    const float* kv_norm_g; const float* w_dkv; const float* kv_lat_g; const float* w_uk; const float* w_uv; const float* w_in_mla;
    const float* q_norm_g; const float* w_uq; const float* w_out_mla;
    float* out; unsigned char* ws;
};

typedef unsigned short bf16;
typedef short bf16x8 __attribute__((ext_vector_type(8)));
typedef float f32x4 __attribute__((ext_vector_type(4)));
typedef float f32x8 __attribute__((ext_vector_type(8)));
typedef float f32x16 __attribute__((ext_vector_type(16)));
typedef unsigned u32x4 __attribute__((ext_vector_type(4)));
typedef unsigned u32x2 __attribute__((ext_vector_type(2)));
typedef short s16x4 __attribute__((ext_vector_type(4)));
#define LDS_WAIT() asm volatile("s_waitcnt lgkmcnt(0)" ::: "memory")
#define VM_WAIT() asm volatile("s_waitcnt vmcnt(0)" ::: "memory")
#define SBAR() __builtin_amdgcn_sched_barrier(0)
typedef float f32x2_t __attribute__((ext_vector_type(2))); typedef __bf16 bf16x2_t __attribute__((ext_vector_type(2)));
__device__ __forceinline__ unsigned cvtpk(float lo, float hi) { f32x2_t v = {lo, hi}; bf16x2_t b = __builtin_convertvector(v, bf16x2_t); return __builtin_bit_cast(unsigned, b); }
__device__ __forceinline__ float bf2f(unsigned short b) { return __uint_as_float((unsigned)b << 16); }
__device__ __forceinline__ float bflo(unsigned w) { return __uint_as_float(w << 16); }
__device__ __forceinline__ float bfhi(unsigned w) { return __uint_as_float(w & 0xffff0000u); }
__device__ __forceinline__ float wave_sum(float v, int lane) {
#pragma unroll
    for (int o = 1; o < 64; o <<= 1) v += shfl_xor_f(v, o, lane);
    return v;
}

template <class DestRow>
__device__ __forceinline__ void transpose_item(const float* __restrict__ W, int K, int N, const float* __restrict__ gain, bf16* WT, const DestRow& dest, LAS float* scr, int item, int lane) {
    const int nblk = N / 32, kb = item / nblk, nb = item % nblk, k0 = 64 * kb, n0 = 32 * nb;
#pragma unroll 8
    for (int i = 0; i < 32; ++i) { const int kk = 2 * i + (lane >> 5); float w = W[(size_t)(k0 + kk) * N + n0 + (lane & 31)]; if (gain) w *= gain[k0 + kk]; scr[kk * 33 + (lane & 31)] = w; }
    LDS_WAIT(); asm volatile("" ::: "memory");
    const int c = lane & 7;
#pragma unroll
    for (int j = 0; j < 4; ++j) { const int n = (lane >> 3) + 8 * j; const LAS float* s = scr + (8 * c) * 33 + n;
        u32x4 o; o.x = cvtpk(s[0 * 33], s[1 * 33]); o.y = cvtpk(s[2 * 33], s[3 * 33]); o.z = cvtpk(s[4 * 33], s[5 * 33]); o.w = cvtpk(s[6 * 33], s[7 * 33]);
        *(u32x4*)(WT + (size_t)dest(n0 + n) * K + k0 + 8 * c) = o; }
    LDS_WAIT(); asm volatile("" ::: "memory");
}
struct DestIdent { int off; __device__ __forceinline__ int operator()(int n) const { return off + n; } };
struct DestConvIn {
    __device__ __forceinline__ int operator()(int n) const { const int p = n >> 10, ch = n & 1023, cl = ch & 63; return (ch >> 6) * 256 + (p >> 1) * 128 + (cl >> 4) * 32 + ((cl >> 2) & 3) * 8 + (p & 1) * 4 + (cl & 3); } };
struct DestUq {
    __device__ __forceinline__ int operator()(int n) const { const int h = n / 96, t = n - h * 96; if (t < 64) return h * 64 + t; const int el = t - 64, i = el & 15;
        return 1024 + (h >> 3) * 256 + ((h & 7) >> 2) * 128 + (h & 3) * 32 + (i >> 2) * 8 + (el >> 4) * 4 + (i & 3); } };

__device__ __forceinline__ void x_row_store(const f32x4 (&v)[4], bf16* xrow, float* rs, int lane) {
    float s = 0.f;
#pragma unroll
    for (int j = 0; j < 4; ++j) s += (v[j].x * v[j].x + v[j].y * v[j].y) + (v[j].z * v[j].z + v[j].w * v[j].w);
    const float r = 1.0f / sqrtf(wave_sum(s, lane) * (1.0f / 1024.0f) + RMS_EPS);
    u32x2* o8 = (u32x2*)xrow + lane;
#pragma unroll
    for (int j = 0; j < 4; ++j) { u32x2 w; w.x = cvtpk(v[j].x, v[j].y); w.y = cvtpk(v[j].z, v[j].w); o8[64 * j] = w; }
    if (lane == 0) *rs = r;
}

template <class DestRow>
__device__ __forceinline__ void transpose_item64(const float* __restrict__ W, int K, int N, const float* __restrict__ gain, bf16* WT, const DestRow& dest, LAS float* scr, int item, int lane) {
    const int nblk = N / 64, kb = item / nblk, nb = item % nblk, k0 = 64 * kb, n0 = 64 * nb;
    float wv[64];
#pragma unroll
    for (int i = 0; i < 64; ++i) wv[i] = W[(size_t)(k0 + i) * N + n0 + lane];
#pragma unroll
    for (int i = 0; i < 64; ++i) { float w = wv[i]; if (gain) w *= gain[k0 + i]; scr[i * 65 + lane] = w; }
    LDS_WAIT(); asm volatile("" ::: "memory");
#pragma unroll
    for (int jj = 0; jj < 8; ++jj) { const int p = lane + 64 * jj, n = p >> 3, c = p & 7; const LAS float* s = scr + (8 * c) * 65 + n;
        u32x4 o; o.x = cvtpk(s[0 * 65], s[1 * 65]); o.y = cvtpk(s[2 * 65], s[3 * 65]); o.z = cvtpk(s[4 * 65], s[5 * 65]); o.w = cvtpk(s[6 * 65], s[7 * 65]);
        *(u32x4*)(WT + (size_t)dest(n0 + n) * K + k0 + 8 * c) = o; }
    LDS_WAIT(); asm volatile("" ::: "memory");
}
__device__ __forceinline__ void convert_set(const Args& A, const int set, LAS unsigned char* lds, int iw, int nw, int wave, int lane) {
    unsigned char* ws = A.ws;
    LAS float* scr = (LAS float*)(lds + wave * 16640);
    constexpr int I_WIN = 16 * 64, I_SQ = 16 * 16, I_DKV = (1024 / 64) * (288 / 32), I_INM = 16 * 24, I_UKV = 4 * 16, I_UQ = 8 * 24;
    if (set == 0 || set == 1) { const int l = set;
        for (int it = iw; it < I_WIN + I_SQ; it += nw) {
            if (it < I_WIN) transpose_item64(A.w_in_conv + (size_t)l * 1024 * 4096, 1024, 4096, A.pre_g + l * 1024, (bf16*)(ws + WS_WIN) + (size_t)l * 4096 * 1024, DestConvIn{}, scr, it, lane);
            else transpose_item64(A.w_out_conv + (size_t)l * 1024 * 1024, 1024, 1024, nullptr, (bf16*)(ws + WS_WOC) + (size_t)l * 1024 * 1024, DestIdent{0}, scr, it - I_WIN, lane); }
    } else if (set == 2) {
        for (int it = iw; it < I_DKV + 2 * I_INM; it += nw) {
            if (it < I_DKV) transpose_item(A.w_dkv, 1024, 288, A.kv_norm_g, (bf16*)(ws + WS_WA0), DestIdent{0}, scr, it, lane);
            else { const int r = it - I_DKV, j = r / I_INM; transpose_item64(A.w_in_mla + (size_t)j * 1024 * 1536, 1024, 1536, A.pre_g + (2 + j) * 1024, (bf16*)(ws + (j ? WS_WA1 : WS_WA0)), DestIdent{j ? 0 : 512}, scr, r % I_INM, lane); } }
        { unsigned z_ = 0u; asm volatile("" : "+v"(z_));
          for (int i = iw * 64 + lane; i < 224 * 128; i += nw * 64) ((u32x4*)((bf16*)(ws + WS_WA0) + 288 * 1024))[i] = (u32x4){z_, z_, z_, z_}; }
    } else if (set == 3) {
        for (int it = iw; it < 2 * I_UKV + 2 * I_UQ; it += nw) {
            if (it < 2 * I_UKV) { const int j = it / I_UKV; transpose_item64(j ? A.w_uv : A.w_uk, 256, 1024, nullptr, (bf16*)(ws + WS_WUKV), DestIdent{j * 1024}, scr, it % I_UKV, lane); }
            else { const int r = it - 2 * I_UKV, j = r / I_UQ; transpose_item64(A.w_uq + (size_t)j * 512 * 1536, 512, 1536, A.q_norm_g + j * 512, (bf16*)(ws + WS_WUQ) + (size_t)j * 1536 * 512, DestUq{}, scr, r % I_UQ, lane); } }
        for (int i = iw * 64 + lane; i < 256 * 1024 / 8; i += nw * 64) { const f32x4 a = ((const f32x4*)A.w_uk)[2 * i], b = ((const f32x4*)A.w_uk)[2 * i + 1];
            u32x4 w; w.x = cvtpk(a.x, a.y); w.y = cvtpk(a.z, a.w); w.z = cvtpk(b.x, b.y); w.w = cvtpk(b.z, b.w); ((u32x4*)(ws + WS_WUKB))[i] = w; }
    } else {
        for (int it = iw; it < 2 * I_SQ; it += nw) { const int j = it / I_SQ; transpose_item64(A.w_out_mla + (size_t)j * 1024 * 1024, 1024, 1024, nullptr, (bf16*)(ws + WS_WOM) + (size_t)j * 1024 * 1024, DestIdent{0}, scr, it % I_SQ, lane); }
    }
}

__device__ __forceinline__ void p0_prologue(const Args& A, LAS unsigned char* lds, int gw, int NGW, int wave, int lane) {
    unsigned char* ws = A.ws;
    convert_set(A, 0, lds, gw, NGW, wave, lane);
#if !TAIL_CONV
    convert_set(A, 1, lds, gw, NGW, wave, lane); convert_set(A, 2, lds, gw, NGW, wave, lane); convert_set(A, 3, lds, gw, NGW, wave, lane); convert_set(A, 4, lds, gw, NGW, wave, lane);
#endif
    for (int i = gw * 64 + lane; i < NPOS * 16; i += NGW * 64) { const int p = i >> 4, e = i & 15; const float pos = (float)(p < TTOT ? p : PAST + (p - TTOT));
        const float inv = powf(10000.0f, -(float)e / 16.0f); const float ang = pos * inv; ((float*)(ws + WS_COS))[i] = cosf(ang); ((float*)(ws + WS_SIN))[i] = sinf(ang); }
    for (int row0 = gw; row0 < NROWS; row0 += 4 * NGW) {
        f32x4 v[4][4];
#pragma unroll
        for (int k = 0; k < 4; ++k) { const int row = row0 + k * NGW < NROWS ? row0 + k * NGW : row0;
            const float* src = row < NMAIN ? A.x_prompt + (size_t)row * 1024 : (row < META0 ? A.x_sample + (size_t)(row - SAMP0) * 1024 : (row < META0 + NMETA ? A.meta + (size_t)(row - META0) * 1024 : nullptr));
#pragma unroll
            for (int j = 0; j < 4; ++j) v[k][j] = src ? ((const f32x4*)src)[lane + 64 * j] : (f32x4){0.f, 0.f, 0.f, 0.f}; }
#pragma unroll
        for (int k = 0; k < 4; ++k) { const int row = row0 + k * NGW; if (row < NROWS) {
            x_row_store(v[k], (bf16*)(ws + WS_X) + (size_t)row * 1024, (float*)(ws + WS_RS) + row, lane); } }
    }
}

__device__ __forceinline__ void conv_phase(const Args& A, int layer, int gw, int NGW, int lane) {
    unsigned char* ws = A.ws; const bf16* V = (const bf16*)(ws + WS_V1); const bf16* GZ = (const bf16*)(ws + WS_GZ); bf16* G = (bf16*)(ws + WS_G);
    const float* cw = A.conv_w + (size_t)layer * 3 * 1024;
    const int c0 = (gw & 1) * 512 + lane * 8, gr = gw >> 1, NGR = NGW >> 1;
    float w0[8], w1[8], w2[8];
#pragma unroll
    for (int k = 0; k < 2; ++k) { const f32x4 t0 = *(const f32x4*)(cw + c0 + 4 * k), t1 = *(const f32x4*)(cw + 1024 + c0 + 4 * k), t2 = *(const f32x4*)(cw + 2048 + c0 + 4 * k);
#pragma unroll
        for (int e = 0; e < 4; ++e) { w0[4 * k + e] = t0[e]; w1[4 * k + e] = t1[e]; w2[4 * k + e] = t2[e]; } }
    for (int row0 = gr; row0 < NROWS; row0 += 4 * NGR) {
        u32x4 v0[4], gz[4]; float a1[4][8], a2[4][8];
#pragma unroll
        for (int q = 0; q < 4; ++q) { const int row = row0 + q * NGR < NROWS ? row0 + q * NGR : row0;
            int r1, r2; const float* s1 = nullptr; const float* s2 = nullptr;
            if (row < NMAIN) { const int i = row & (SEQ - 1); r1 = i >= 1 ? row - 1 : META0 + 15; r2 = i >= 2 ? row - 2 : META0 + 14 + i; }
            else if (row < META0) { const int s = row - SAMP0, b = s >> 2, l = s & 3; const float* st = A.state_conv + ((size_t)layer * DECB + b) * 2 * 1024;
                if (l >= 1) r1 = row - 1; else { r1 = -2; s1 = st + 1024; }
                if (l >= 2) r2 = row - 2; else { r2 = -2; s2 = st + l * 1024; } }
            else if (row < META0 + NMETA) { const int j = row - META0; r1 = j >= 1 ? row - 1 : -1; r2 = j >= 2 ? row - 2 : -1; }
            else { r1 = -1; r2 = -1; }
            v0[q] = *(const u32x4*)(V + (size_t)row * 1024 + c0); gz[q] = *(const u32x4*)(GZ + (size_t)row * 1024 + c0);
            if (r1 >= 0) { const u32x4 t = *(const u32x4*)(V + (size_t)r1 * 1024 + c0);
#pragma unroll
                for (int k = 0; k < 4; ++k) { a1[q][2 * k] = bflo(t[k]); a1[q][2 * k + 1] = bfhi(t[k]); } }
            else if (r1 == -2) { const f32x4 t0 = *(const f32x4*)(s1 + c0), t1 = *(const f32x4*)(s1 + c0 + 4);
#pragma unroll
                for (int k = 0; k < 4; ++k) { a1[q][k] = t0[k]; a1[q][4 + k] = t1[k]; } }
            else {
#pragma unroll
                for (int k = 0; k < 8; ++k) a1[q][k] = 0.f; }
            if (r2 >= 0) { const u32x4 t = *(const u32x4*)(V + (size_t)r2 * 1024 + c0);
#pragma unroll
                for (int k = 0; k < 4; ++k) { a2[q][2 * k] = bflo(t[k]); a2[q][2 * k + 1] = bfhi(t[k]); } }
            else if (r2 == -2) { const f32x4 t0 = *(const f32x4*)(s2 + c0), t1 = *(const f32x4*)(s2 + c0 + 4);
#pragma unroll
                for (int k = 0; k < 4; ++k) { a2[q][k] = t0[k]; a2[q][4 + k] = t1[k]; } }
            else {
#pragma unroll
                for (int k = 0; k < 8; ++k) a2[q][k] = 0.f; } }
#pragma unroll
        for (int q = 0; q < 4; ++q) { const int row = row0 + q * NGR; if (row < NROWS) {
            float vc[8], gg[8], o[8];
#pragma unroll
            for (int k = 0; k < 4; ++k) { vc[2 * k] = bflo(v0[q][k]); vc[2 * k + 1] = bfhi(v0[q][k]); gg[2 * k] = bflo(gz[q][k]); gg[2 * k + 1] = bfhi(gz[q][k]); }
#pragma unroll
            for (int k = 0; k < 8; ++k) o[k] = gg[k] * (w0[k] * a2[q][k] + w1[k] * a1[q][k] + w2[k] * vc[k]);
            u32x4 w; w.x = cvtpk(o[0], o[1]); w.y = cvtpk(o[2], o[3]); w.z = cvtpk(o[4], o[5]); w.w = cvtpk(o[6], o[7]);
            *(u32x4*)(G + (size_t)row * 1024 + c0) = w;
            float* dst = nullptr;
            if (row < NMAIN) { const int i = row & (SEQ - 1), b = row >> 12; if (i >= SEQ - 2) dst = A.out + O_CVP + (((size_t)layer * NB + b) * 2 + (i - (SEQ - 2))) * 1024; }
            else if (row < META0) { const int s = row - SAMP0, b = s >> 2, l = s & 3; if (l >= 2) dst = A.out + O_CVS + (((size_t)layer * DECB + b) * 2 + (l - 2)) * 1024; }
            if (dst) { *(f32x4*)(dst + c0) = (f32x4){vc[0], vc[1], vc[2], vc[3]}; *(f32x4*)(dst + c0 + 4) = (f32x4){vc[4], vc[5], vc[6], vc[7]}; }
        } }
    }
}

__device__ __forceinline__ void norm_row_finish(const Args& A, int layer, int row, const f32x4 (&m)[4], const u32x2 (&xw)[4], const f32x4 (&g)[4], int lane) {
    unsigned char* ws = A.ws; float s = 0.f;
#pragma unroll
    for (int j = 0; j < 4; ++j) s += (m[j].x * m[j].x + m[j].y * m[j].y) + (m[j].z * m[j].z + m[j].w * m[j].w);
    const float r = 1.0f / sqrtf(wave_sum(s, lane) * (1.0f / 1024.0f) + RMS_EPS);
    f32x4 xn[4];
#pragma unroll
    for (int j = 0; j < 4; ++j) xn[j] = (f32x4){bflo(xw[j].x), bfhi(xw[j].x), bflo(xw[j].y), bfhi(xw[j].y)} + m[j] * r * g[j];
    if (layer == 3) { if (row < META0) {
#pragma unroll
            for (int j = 0; j < 4; ++j) ((f32x4*)(A.out + (size_t)row * 1024))[lane + 64 * j] = xn[j]; } }
    else x_row_store(xn, (bf16*)(ws + WS_X) + (size_t)row * 1024, (float*)(ws + WS_RS) + row, lane);
}
__device__ __forceinline__ void norm_phase(const Args& A, int layer, int gw, int NGW, int lane) {
    unsigned char* ws = A.ws; const bf16* MB = (const bf16*)(ws + WS_MB); const bf16* X = (const bf16*)(ws + WS_X); const float* pg = A.post_g + (size_t)layer * 1024;
    f32x4 g[4];
#pragma unroll
    for (int j = 0; j < 4; ++j) g[j] = ((const f32x4*)pg)[lane + 64 * j];
    for (int row0 = gw; row0 < NMAIN; row0 += 4 * NGW) {
        u32x2 mw[4][4], xw[4][4];
#pragma unroll
        for (int k = 0; k < 4; ++k) { const int row = row0 + k * NGW < NMAIN ? row0 + k * NGW : row0;
#pragma unroll
            for (int j = 0; j < 4; ++j) { mw[k][j] = ((const u32x2*)(MB + (size_t)row * 1024))[lane + 64 * j]; xw[k][j] = ((const u32x2*)(X + (size_t)row * 1024))[lane + 64 * j]; } }
#pragma unroll
        for (int k = 0; k < 4; ++k) { const int row = row0 + k * NGW; if (row < NMAIN) {
            f32x4 m[4];
#pragma unroll
            for (int j = 0; j < 4; ++j) m[j] = (f32x4){bflo(mw[k][j].x), bfhi(mw[k][j].x), bflo(mw[k][j].y), bfhi(mw[k][j].y)};
            norm_row_finish(A, layer, row, m, xw[k], g, lane); } }
    }
    const float* PG = (const float*)(ws + WS_PARTG);
    for (int row = NMAIN + gw; row < NROWS; row += NGW) {
        u32x2 xw[4]; f32x4 m[4];
#pragma unroll
        for (int j = 0; j < 4; ++j) xw[j] = ((const u32x2*)(X + (size_t)row * 1024))[lane + 64 * j];
#pragma unroll
        for (int s2 = 0; s2 < GOUT_SPLITK; s2 += 2) { f32x4 t0[4], t1[4];
#pragma unroll
            for (int j = 0; j < 4; ++j) { t0[j] = ((const f32x4*)(PG + ((size_t)s2 * 768 + (row - NMAIN)) * 1024))[lane + 64 * j]; t1[j] = ((const f32x4*)(PG + ((size_t)(s2 + 1) * 768 + (row - NMAIN)) * 1024))[lane + 64 * j]; }
#pragma unroll
            for (int j = 0; j < 4; ++j) m[j] = s2 == 0 ? t0[j] + t1[j] : m[j] + (t0[j] + t1[j]); }
        norm_row_finish(A, layer, row, m, xw, g, lane);
    }
}

__device__ __forceinline__ void latent_phase(const Args& A, int gw, int NGW, int lane) {
    unsigned char* ws = A.ws; const float* CKR = (const float*)(ws + WS_CKR); bf16* CB = (bf16*)(ws + WS_CB); bf16* KRB = (bf16*)(ws + WS_KRB);
    const float* COS = (const float*)(ws + WS_COS); const float* SIN = (const float*)(ws + WS_SIN);
    const f32x4 g = ((const f32x4*)A.kv_lat_g)[lane];
    for (int row0 = gw; row0 < NROWS; row0 += 4 * NGW) {
        f32x4 cc[4]; float x1[4], x2[4], cs[4], sn[4];
#pragma unroll
        for (int k = 0; k < 4; ++k) { const int row = row0 + k * NGW < NROWS ? row0 + k * NGW : row0; const int pi = pg8::posidx_of_row(row); const int l16 = lane & 15;
            cc[k] = ((const f32x4*)(CKR + (size_t)row * 512))[lane]; x1[k] = CKR[(size_t)row * 512 + 256 + l16]; x2[k] = CKR[(size_t)row * 512 + 272 + l16]; cs[k] = COS[pi * 16 + l16]; sn[k] = SIN[pi * 16 + l16]; }
#pragma unroll
        for (int k = 0; k < 4; ++k) { const int row = row0 + k * NGW; if (row < NROWS) {
            const f32x4 c = cc[k];
            const float r = 1.0f / sqrtf(wave_sum((c.x * c.x + c.y * c.y) + (c.z * c.z + c.w * c.w), lane) * (1.0f / 256.0f) + RMS_EPS);
            const f32x4 cn = c * r * g;
            u32x2 w; w.x = cvtpk(cn.x, cn.y); w.y = cvtpk(cn.z, cn.w); ((u32x2*)(CB + (size_t)row * 256))[lane] = w;
            const float o1 = x1[k] * cs[k] - x2[k] * sn[k], o2 = x1[k] * sn[k] + x2[k] * cs[k];
            if (lane < 16) { KRB[(size_t)row * 32 + lane] = (bf16)(cvtpk(o1, o1) & 0xffffu); KRB[(size_t)row * 32 + 16 + lane] = (bf16)(cvtpk(o2, o2) & 0xffffu); }
            if (row < NMAIN) { const int b = row >> 12, i = row & (SEQ - 1); const size_t t = (size_t)b * TTOT + NMETA + i;
                ((f32x4*)(A.out + O_CKP + t * KVL))[lane] = cn; if (lane < 16) { A.out[O_KRP + t * QKR + lane] = o1; A.out[O_KRP + t * QKR + 16 + lane] = o2; } }
            else if (row < META0) { const size_t t = row - SAMP0; ((f32x4*)(A.out + O_CKS + t * KVL))[lane] = cn; if (lane < 16) { A.out[O_KRS + t * QKR + lane] = o1; A.out[O_KRS + t * QKR + 16 + lane] = o2; } }
            else if (row < META0 + NMETA) { const int j = row - META0;
#pragma unroll
                for (int b = 0; b < NB; ++b) { const size_t t = (size_t)b * TTOT + j; ((f32x4*)(A.out + O_CKP + t * KVL))[lane] = cn; if (lane < 16) { A.out[O_KRP + t * QKR + lane] = o1; A.out[O_KRP + t * QKR + 16 + lane] = o2; } } }
        } }
    }
}

namespace ap {
constexpr int NW = 8, QBLK = 32, KVBLK = 64;
constexpr int SLOTB = 8192;
constexpr int LDS_K = 0, LDS_V = 3 * SLOTB, LDS_R = 6 * SLOTB, OFF_WS = LDS_R + 3 * (SLOTB / 2), LDS_BYTES_AP = OFF_WS + NW * 64 * 4;
constexpr float THR = 8.0f;
typedef __attribute__((address_space(3))) const char* lds_cptr;
typedef short v4i16_t __attribute__((ext_vector_type(4)));
__device__ __forceinline__ int crow(int r, int hi) { return (r & 3) + 8 * (r >> 2) + 4 * hi; }
#define PK4(P, BASE, OUT) do { unsigned a0 = cvtpk(P[BASE + 0], P[BASE + 1]), a1 = cvtpk(P[BASE + 2], P[BASE + 3]);   \
    unsigned b0 = cvtpk(P[BASE + 4], P[BASE + 5]), b1 = cvtpk(P[BASE + 6], P[BASE + 7]);                              \
    auto r0 = __builtin_amdgcn_permlane32_swap(a0, b0, false, false); auto r1 = __builtin_amdgcn_permlane32_swap(a1, b1, false, false); \
    u32x4 w = {r0[0], r1[0], r0[1], r1[1]}; OUT = *reinterpret_cast<bf16x8*>(&w); } while (0)
__device__ __forceinline__ void glds16(const void* sbase, unsigned voff, unsigned lds_base) {
    unsigned sv; asm volatile("s_mov_b32 %0, m0\n\ts_mov_b32 m0, %3\n\ts_nop 0\n\tglobal_load_lds_dwordx4 %1, %2\n\ts_mov_b32 m0, %0" : "=&s"(sv) : "v"(voff), "s"(sbase), "s"(lds_base) : "memory"); }
__device__ __forceinline__ void kload2(bf16x8* kf, lds_cptr kp, int j) { kf[2 * j] = *(const __attribute__((address_space(3))) bf16x8*)(kp + j * 2048); kf[2 * j + 1] = *(const __attribute__((address_space(3))) bf16x8*)(kp + j * 2048 + 512); }
__device__ __forceinline__ s16x4 vtr(lds_cptr p) { return __builtin_bit_cast(s16x4, __builtin_amdgcn_ds_read_tr16_b64_v4i16((__attribute__((address_space(3))) v4i16_t*)p)); }
__device__ __forceinline__ void mask_tile(f32x16& p0, f32x16& p1, int lim, int hi) {
    const int d = lim - 4 * hi;
#pragma unroll
    for (int r = 0; r < 16; ++r) { const int c = (r & 3) + 8 * (r >> 2); if (c > d) p0[r] = -INFINITY; if (c + 32 > d) p1[r] = -INFINITY; }
}
#define MFMA32(a, b, c) __builtin_amdgcn_mfma_f32_32x32x16_bf16(a, b, c, 0, 0, 0)
#define WAIT_BAR(N) asm volatile("s_waitcnt vmcnt(" #N ") lgkmcnt(0)\n\ts_barrier" ::: "memory")
#define PIN(x) asm volatile("" : "+v"(x))
#define MX3(a, b, c) __builtin_fmaxf(__builtin_fmaxf((a), (b)), (c))
__device__ __forceinline__ float rowmax(const f32x16& p0, const f32x16& p1) {
    float a = MX3(p0[0], p0[1], p1[0]), b = MX3(p0[2], p0[3], p1[1]); a = MX3(a, p1[2], p1[3]);
#pragma unroll
    for (int r = 4; r < 16; r += 4) { a = MX3(a, p0[r], p0[r + 1]); b = MX3(b, p0[r + 2], p0[r + 3]); a = MX3(a, p1[r], p1[r + 1]); b = MX3(b, p1[r + 2], p1[r + 3]); }
    float m = __builtin_fmaxf(a, b); auto rr = __builtin_amdgcn_permlane32_swap(__float_as_uint(m), __float_as_uint(m), false, false);
    return __builtin_fmaxf(__uint_as_float(rr[0]), __uint_as_float(rr[1])); }

__device__ __forceinline__ void attn_unit(unsigned char* ws_, int b_, int h_, int qb_, bool meta_, char* lds, const int wave) {
    unsigned char* ws = opaque_global(ws_); int wid = wave; asm volatile("" : "+s"(wid));
    const bf16* __restrict__ QN = (const bf16*)(ws + WS_QN); const bf16* __restrict__ QR = (const bf16*)(ws + WS_QR); const bf16* __restrict__ KN = (const bf16*)(ws + WS_KN);
    const bf16* __restrict__ KRB = (const bf16*)(ws + WS_KRB); const bf16* __restrict__ VV = (const bf16*)(ws + WS_VV);
    const int b = __builtin_amdgcn_readfirstlane(b_), h = __builtin_amdgcn_readfirstlane(h_), qb = __builtin_amdgcn_readfirstlane(qb_); const bool meta = __builtin_amdgcn_readfirstlane((int)meta_) != 0;
    const int lane = lane_fresh(), r32 = lane & 31, hi = lane >> 5;
    const unsigned lds0 = (unsigned)(uintptr_t)lds; const lds_cptr lds3 = (lds_cptr)lds;
    float* wsf = (float*)(lds + OFF_WS) + wid * 64;
    const int qrow0 = meta ? META0 : b * SEQ + qb * 256;
    const int NT = meta ? 1 : 4 * qb + 5;
    const int qrel = wid * QBLK + r32;
    const size_t krow1 = (size_t)b * SEQ;
    const bf16* ksrc = KN + krow1 * 1024 + h * 64 + wid * 8;
    const bf16* rsrc = KRB + krow1 * 32 + (wid & 3) * 8;
    const bf16* vsrc = VV + (krow1 + 16 * (wid & 3)) * 1024 + h * 64 + (wid >> 2) * 32;
    const unsigned kdst = lds0 + LDS_K + wid * 1024, vdst = lds0 + LDS_V + wid * 1024, rdst = lds0 + LDS_R + (wid & 3) * 1024;
#define KOFF ((unsigned)lane * 2048u)
#define ROFF ((unsigned)lane * 64u)
#define VOFF ((unsigned)(lane >> 2) * 2048u + (unsigned)(lane & 3) * 16u)
#define RFL(x) ((unsigned)__builtin_amdgcn_readfirstlane((int)(x)))
#define DMA_K(t, slot) glds16(ksrc + (long)((t) - 1) * (KVBLK * 1024), KOFF, RFL(kdst + (slot)))
#define DMA_V(t, slot) glds16(vsrc + (long)((t) - 1) * (KVBLK * 1024), VOFF, RFL(vdst + (slot)))
#define DMA_R(t, slot) do { if (wid < 4) glds16(rsrc + (long)((t) - 1) * (KVBLK * 32), ROFF, RFL(rdst + ((slot) >> 1))); } while (0)
#define WAITB(a, b) do { if (wid < 4) { WAIT_BAR(a); } else { WAIT_BAR(b); } } while (0)
    const lds_cptr kp0 = lds3 + LDS_K + hi * 1024 + r32 * 16, rp0 = lds3 + LDS_R + hi * 1024 + r32 * 16;
    const lds_cptr vp0 = lds3 + LDS_V + ((lane >> 4) & 1) * 32 + (lane & 3) * 8 + (4 * hi + ((lane & 15) >> 2)) * 64;
    glds16(KN + (size_t)META0 * 1024 + h * 64 + wid * 8, KOFF, RFL(kdst));
    if (wid < 4) glds16(KRB + (size_t)META0 * 32 + (wid & 3) * 8, ROFF, RFL(rdst));
    glds16(VV + ((size_t)META0 + 16 * (wid & 3)) * 1024 + h * 64 + (wid >> 2) * 32, VOFF, RFL(vdst));
    if (NT > 1) { DMA_K(1, SLOTB); DMA_R(1, SLOTB); }
    bf16x8 qr[6];
    { const size_t qrow = (size_t)(qrow0 + wid * QBLK + r32);
#pragma unroll
      for (int d0 = 0; d0 < 4; ++d0) qr[d0] = *reinterpret_cast<const bf16x8*>(QN + qrow * 1024 + h * 64 + d0 * 16 + hi * 8);
#pragma unroll
      for (int d0 = 0; d0 < 2; ++d0) qr[4 + d0] = *reinterpret_cast<const bf16x8*>(QR + qrow * 512 + h * 32 + d0 * 16 + hi * 8); }
    float mhat = 0.f, l_reg = 0.f; f32x16 o[2]; o[0] = f32x16{}; o[1] = f32x16{}; f32x16 negm = f32x16{}; PIN(negm);
    bool resc = false;
    f32x16 pA0, pA1, pB0, pB1; bf16x8 kf[8], kr[4]; s16x4 vlo[8], vhi[8]; u32x4 pw0, pw1, pw2, pw3;
    int sl_prev = 0, sl_cur = 0, sl_next = SLOTB;
#define ROT() do { sl_prev = sl_cur; sl_cur = sl_next; sl_next = (sl_next == 2 * SLOTB) ? 0 : sl_next + SLOTB; } while (0)
#define RESC() do { if (resc) { asm volatile("s_waitcnt lgkmcnt(0)" ::: "memory"); _Pragma("unroll") for (int d_ = 0; d_ < 2; ++d_) _Pragma("unroll") for (int r = 0; r < 16; ++r) o[d_][r] *= wsf[crow(r, hi)]; } } while (0)
    if (NT > 1) { DMA_K(2, 2 * SLOTB); WAITB(4, 3); } else { WAIT_BAR(0); }
    _Pragma("unroll") for (int j = 0; j < 4; ++j) kload2(kf, kp0, j);
    _Pragma("unroll") for (int j = 0; j < 2; ++j) kload2(kr, rp0, j);
    pA0 = MFMA32(kf[0], qr[0], negm); pA1 = MFMA32(kf[1], qr[0], negm); pA0 = MFMA32(kf[2], qr[1], pA0); pA1 = MFMA32(kf[3], qr[1], pA1);
    pA0 = MFMA32(kf[4], qr[2], pA0); pA1 = MFMA32(kf[5], qr[2], pA1); pA0 = MFMA32(kf[6], qr[3], pA0); pA1 = MFMA32(kf[7], qr[3], pA1);
    pA0 = MFMA32(kr[0], qr[4], pA0); pA1 = MFMA32(kr[1], qr[4], pA1); pA0 = MFMA32(kr[2], qr[5], pA0); pA1 = MFMA32(kr[3], qr[5], pA1);
    mask_tile(pA0, pA1, meta ? (qrel < 15 ? qrel : 15) : 15, hi);
    { const float rm = rowmax(pA0, pA1); mhat = rm;
#pragma unroll
      for (int r = 0; r < 16; ++r) { pA0[r] -= rm; pA1[r] -= rm; }
#pragma unroll
      for (int r = 0; r < 16; ++r) negm[r] = -mhat;
      PIN(negm);
#pragma unroll
      for (int r = 0; r < 16; ++r) { pA0[r] = __builtin_amdgcn_exp2f(pA0[r]); pA1[r] = __builtin_amdgcn_exp2f(pA1[r]); } }
    WAIT_BAR(0);
    if (NT > 1) {
        DMA_K(3, 0); DMA_R(2, 2 * SLOTB); DMA_V(1, SLOTB); ROT();
        _Pragma("unroll") for (int j = 0; j < 4; ++j) kload2(kf, kp0 + sl_cur, j);
        WAITB(3, 2);
    }
#define PKW(P, i) cvtpk(P[i], P[i + 1])
#define PAF(k) __builtin_bit_cast(bf16x8, pw##k)
#define VFR(i) (bf16x8){vlo[i][0], vlo[i][1], vlo[i][2], vlo[i][3], vhi[i][0], vhi[i][1], vhi[i][2], vhi[i][3]}
#define VRD(i) do { vlo[i] = vtr(vp_ + (((i) >> 2) * 4096 + ((i) & 3) * 1024)); vhi[i] = vtr(vp_ + (((i) >> 2) * 4096 + ((i) & 3) * 1024 + 512)); } while (0)
#define KRD(G, j) do { if (G) { kload2(kf, kp0 + sl_next, j); SBAR(); } } while (0)
#define GAPA(MF, a0, a1, a2, a3, W0, W1, PW) do { MF; sacc += a0; sacc += a1; sacc += a2; sacc += a3; PIN(sacc); W0; W1; PIN(PW); SBAR(); } while (0)
#define GAPR(MF) do { MF; SBAR(); } while (0)
#define EX(v) __builtin_amdgcn_exp2f(v)
#define GAPB(MF, X, i) do { MF; X[i] = EX(X[i]); X[i + 1] = EX(X[i + 1]); X[i + 2] = EX(X[i + 2]); X[i + 3] = EX(X[i + 3]); PIN(X); SBAR(); } while (0)
#define STEP(C0, C1, P0, P1, t, MSK, GK, GR, GV, GL) do { SBAR(); \
    const lds_cptr vp_ = vp0 + sl_prev; const lds_cptr rp_ = rp0 + (sl_cur >> 1); \
    VRD(0); SBAR(); float sacc = P0[0] + P0[1]; \
                    GAPA(C0 = MFMA32(kf[0], qr[0], negm), P0[2], P0[3], P0[4], P0[5],     pw0[0] = PKW(P0, 0),  pw0[1] = PKW(P0, 2),  pw0); \
    VRD(4); SBAR(); GAPA(C1 = MFMA32(kf[1], qr[0], negm), P0[6], P0[7], P0[8], P0[9],     pw0[2] = PKW(P0, 4),  pw0[3] = PKW(P0, 6),  pw0); \
    VRD(1); SBAR(); GAPA(C0 = MFMA32(kf[2], qr[1], C0),   P0[10], P0[11], P0[12], P0[13], pw1[0] = PKW(P0, 8),  pw1[1] = PKW(P0, 10), pw1); \
    VRD(5); SBAR(); GAPA(C1 = MFMA32(kf[3], qr[1], C1),   P0[14], P0[15], P1[0], P1[1],   pw1[2] = PKW(P0, 12), pw1[3] = PKW(P0, 14), pw1); \
    kload2(kf, rp_, 0); VRD(2); SBAR(); GAPA(C0 = MFMA32(kf[4], qr[2], C0),   P1[2], P1[3], P1[4], P1[5],     pw2[0] = PKW(P1, 0),  pw2[1] = PKW(P1, 2),  pw2); \
    kload2(kf, rp_, 1); VRD(6); SBAR(); GAPA(C1 = MFMA32(kf[5], qr[2], C1),   P1[6], P1[7], P1[8], P1[9],     pw2[2] = PKW(P1, 4),  pw2[3] = PKW(P1, 6),  pw2); \
    VRD(3); SBAR(); GAPA(C0 = MFMA32(kf[6], qr[3], C0),   P1[10], P1[11], P1[12], P1[13], pw3[0] = PKW(P1, 8),  pw3[1] = PKW(P1, 10), pw3); \
    VRD(7); SBAR(); GAPA(C1 = MFMA32(kf[7], qr[3], C1),   P1[14], P1[15], 0.f, 0.f,       pw3[2] = PKW(P1, 12), pw3[3] = PKW(P1, 14), pw3); \
    GAPR(C0 = MFMA32(kf[0], qr[4], C0)); GAPR(C1 = MFMA32(kf[1], qr[4], C1)); GAPR(C0 = MFMA32(kf[2], qr[5], C0)); GAPR(C1 = MFMA32(kf[3], qr[5], C1)); \
    l_reg += sacc; \
    if (GK) DMA_K((t) + 3, sl_cur); if (GR) DMA_R((t) + 2, sl_prev); if (GV) DMA_V((t) + 1, sl_next);            \
    if (MSK) mask_tile(C0, C1, qrel - 64 * ((t) - (NT - 4)), hi); \
    { const float rm = rowmax(C0, C1); resc = false;                                                              \
      if (__builtin_expect(__any(rm > THR), 0)) { const float dl = __builtin_fmaxf(rm, 0.f); mhat += dl;          \
          _Pragma("unroll") for (int r = 0; r < 16; ++r) { C0[r] -= dl; C1[r] -= dl; } \
          _Pragma("unroll") for (int r = 0; r < 16; ++r) negm[r] = -mhat; \
          PIN(negm); \
          const float f = __builtin_amdgcn_exp2f(-dl); l_reg *= f; if (hi == 0) wsf[r32] = f; resc = true; } } \
    SBAR(); \
    GAPB(o[0] = MFMA32(PAF(0), VFR(0), o[0]), C0, 0);              GAPB(o[1] = MFMA32(PAF(0), VFR(4), o[1]), C0, 4); \
    KRD(GL, 0); GAPB(o[0] = MFMA32(PAF(1), VFR(1), o[0]), C0, 8);  KRD(GL, 1); GAPB(o[1] = MFMA32(PAF(1), VFR(5), o[1]), C0, 12); \
    KRD(GL, 2); GAPB(o[0] = MFMA32(PAF(2), VFR(2), o[0]), C1, 0);  KRD(GL, 3); GAPB(o[1] = MFMA32(PAF(2), VFR(6), o[1]), C1, 4); \
    GAPB(o[0] = MFMA32(PAF(3), VFR(3), o[0]), C1, 8);              GAPB(o[1] = MFMA32(PAF(3), VFR(7), o[1]), C1, 12); \
    } while (0)
    int t = 1;
    for (; t + 5 < NT; t += 2) {
        STEP(pB0, pB1, pA0, pA1, t, false, true, true, true, true);     WAITB(3, 2); RESC(); ROT();
        STEP(pA0, pA1, pB0, pB1, t + 1, false, true, true, true, true); WAITB(3, 2); RESC(); ROT();
    }
#define ENDW(tt) do { if ((tt) + 3 < NT) { WAITB(3, 2); } else if ((tt) + 2 < NT) { WAITB(2, 1); } else if ((tt) + 1 < NT) { WAIT_BAR(1); } else { WAIT_BAR(0); } } while (0)
    for (; t + 1 < NT; t += 2) {
        STEP(pB0, pB1, pA0, pA1, t, true, (t + 3 < NT), (t + 2 < NT), (t + 1 < NT), (t + 1 < NT));         ENDW(t);     RESC(); ROT();
        STEP(pA0, pA1, pB0, pB1, t + 1, true, (t + 4 < NT), (t + 3 < NT), (t + 2 < NT), (t + 2 < NT));     ENDW(t + 1); RESC(); ROT();
    }
    { float sacc = pA0[0] + pA0[1];
#pragma unroll
      for (int r = 2; r < 16; ++r) sacc += pA0[r];
#pragma unroll
      for (int r = 0; r < 16; ++r) sacc += pA1[r];
      l_reg += sacc;
      pw0 = (u32x4){PKW(pA0, 0), PKW(pA0, 2), PKW(pA0, 4), PKW(pA0, 6)}; pw1 = (u32x4){PKW(pA0, 8), PKW(pA0, 10), PKW(pA0, 12), PKW(pA0, 14)};
      pw2 = (u32x4){PKW(pA1, 0), PKW(pA1, 2), PKW(pA1, 4), PKW(pA1, 6)}; pw3 = (u32x4){PKW(pA1, 8), PKW(pA1, 10), PKW(pA1, 12), PKW(pA1, 14)};
      const lds_cptr vp_ = vp0 + sl_prev; _Pragma("unroll") for (int i = 0; i < 8; ++i) VRD(i);
      o[0] = MFMA32(PAF(0), VFR(0), o[0]); o[1] = MFMA32(PAF(0), VFR(4), o[1]); o[0] = MFMA32(PAF(1), VFR(1), o[0]); o[1] = MFMA32(PAF(1), VFR(5), o[1]);
      o[0] = MFMA32(PAF(2), VFR(2), o[0]); o[1] = MFMA32(PAF(2), VFR(6), o[1]); o[0] = MFMA32(PAF(3), VFR(3), o[0]); o[1] = MFMA32(PAF(3), VFR(7), o[1]); }
    { auto rr = __builtin_amdgcn_permlane32_swap(__float_as_uint(l_reg), __float_as_uint(l_reg), false, false); l_reg = __uint_as_float(rr[0]) + __uint_as_float(rr[1]); }
    if (hi == 0) wsf[32 + r32] = l_reg; asm volatile("s_waitcnt lgkmcnt(0)" ::: "memory");
    { float* stg = (float*)(lds + 65536) + wid * 2048;
#pragma unroll
      for (int r = 0; r < 16; ++r) { const int orow = crow(r, hi); const float rl = __builtin_amdgcn_rcpf(wsf[32 + orow]);
#pragma unroll
          for (int d0 = 0; d0 < 2; ++d0) stg[orow * 64 + d0 * 32 + r32] = o[d0][r] * rl; }
      asm volatile("s_waitcnt lgkmcnt(0)" ::: "memory");
      const bf16* __restrict__ SZ = (const bf16*)(ws + WS_SZ); bf16* __restrict__ OG = (bf16*)(ws + WS_OG);
      u32x4 zz[4];
#pragma unroll
      for (int i = 0; i < 4; ++i) { const int row = i * 8 + (lane >> 3), ch = lane & 7; zz[i] = *(const u32x4*)(SZ + (size_t)(qrow0 + wid * QBLK + row) * 1024 + h * 64 + ch * 8); }
#pragma unroll
      for (int i = 0; i < 4; ++i) { const int row = i * 8 + (lane >> 3), ch = lane & 7; const f32x4 a = *(const f32x4*)(stg + row * 64 + ch * 8), c = *(const f32x4*)(stg + row * 64 + ch * 8 + 4);
          u32x4 w; w.x = cvtpk(a[0] * bflo(zz[i].x), a[1] * bfhi(zz[i].x)); w.y = cvtpk(a[2] * bflo(zz[i].y), a[3] * bfhi(zz[i].y)); w.z = cvtpk(c[0] * bflo(zz[i].z), c[1] * bfhi(zz[i].z)); w.w = cvtpk(c[2] * bflo(zz[i].w), c[3] * bfhi(zz[i].w));
          *(u32x4*)(OG + (size_t)(qrow0 + wid * QBLK + row) * 1024 + h * 64 + ch * 8) = w; } }
    asm volatile("s_waitcnt lgkmcnt(0)\n\ts_barrier" ::: "memory");
#undef RFL
#undef KOFF
#undef ROFF
#undef VOFF
#undef DMA_K
#undef DMA_V
#undef DMA_R
#undef WAITB
#undef ROT
#undef RESC
#undef PKW
#undef PAF
#undef VFR
#undef VRD
#undef KRD
#undef GAPA
#undef GAPR
#undef EX
#undef GAPB
#undef STEP
#undef ENDW
}
#undef MFMA32
#undef WAIT_BAR
#undef PIN
#undef MX3
}

namespace as {
constexpr int IMG_HALF = 16384, IMG_ROPE = 32768, IMG_BYTES = 36864;
constexpr int OFF_Q = 0, OFF_K0 = IMG_BYTES, OFF_WS = OFF_K0 + 3 * IMG_BYTES, LDS_BYTES_AS = OFF_WS + 8 * 64 * 4 + 8 * 64 * 4;
constexpr float THR = 8.0f;
constexpr int NTILE = 2 * AS_PAGES;
__device__ __forceinline__ unsigned off_a(unsigned row, unsigned ch) { return 2048u * (row >> 3) + 512u * (ch >> 2) + 64u * (row & 7) + 16u * ((ch & 3) ^ ((row >> 2) & 3)); }
__device__ __forceinline__ unsigned off_rope(unsigned row, unsigned ch) { return IMG_ROPE + 64u * row + 16u * (ch ^ ((row >> 2) & 3)); }
__device__ __forceinline__ unsigned img_off(unsigned row, unsigned c8) { return c8 < 32 ? (c8 >> 4) * IMG_HALF + off_a(row, c8 & 15) : off_rope(row, c8 - 32); }
__device__ __forceinline__ s16x4 tr_read_dyn(unsigned addr) { s16x4 r; asm volatile("ds_read_b64_tr_b16 %0, %1" : "=&v"(r) : "v"(addr) : "memory"); return r; }

__device__ __forceinline__ void attn_s_unit(const Args& A, int b, int s, char* lds, const int wave) {
    unsigned char* ws = opaque_global(A.ws);
    const int lane = lane_fresh(), wid = wave, tid = wave * 64 + lane, r32 = lane & 31, hi = lane >> 5;
    const int qg = wid & 1, kh = (wid >> 1) & 1, chh = wid >> 2;
    const int* pt = A.page_table + (size_t)b * NPAGES + s * AS_PAGES;
    float* wsf = (float*)(lds + OFF_WS) + wid * 64;
    struct Stage { f32x4 c[8]; f32x4 r; } sA, sB;
#define TLOAD(S, t) do { const int t_ = (t) < NTILE ? (t) : NTILE - 1; const int pg_ = __builtin_amdgcn_readfirstlane(pgl[t_ >> 1]); const size_t k0_ = (size_t)pg_ * PAGE + (t_ & 1) * 64; \
    const int live_ = (t) < NTILE ? 1 : 0;        \
    const float* cb_ = A.cache_ckv + (k0_ + wid) * KVL + live_ * lane * 4; const float* rb_ = A.cache_krope + k0_ * QKR + live_ * tid * 4; \
    _Pragma("unroll") for (int i_ = 0; i_ < 8; ++i_) S.c[i_] = __builtin_nontemporal_load((const f32x4*)(cb_ + (size_t)(live_ * 8 * i_) * KVL)); S.r = __builtin_nontemporal_load((const f32x4*)rb_); } while (0)
#define TWRITE(bufoff, S) do { _Pragma("unroll") for (int i_ = 0; i_ < 8; ++i_) { u32x2 w_; w_.x = cvtpk(S.c[i_][0], S.c[i_][1]); w_.y = cvtpk(S.c[i_][2], S.c[i_][3]); \
        *(u32x2*)(lds + (bufoff) + img_off(8 * i_ + wid, lane >> 1) + (lane & 1) * 8) = w_; } \
    { const int rrow_ = tid >> 3, rc4 = tid & 7; u32x2 w_; w_.x = cvtpk(S.r[0], S.r[1]); w_.y = cvtpk(S.r[2], S.r[3]); *(u32x2*)(lds + (bufoff) + off_rope(rrow_, rc4 >> 1) + (rc4 & 1) * 8) = w_; } } while (0)
    __attribute__((address_space(3))) int* pgl = (__attribute__((address_space(3))) int*)(lds + OFF_WS + 2048) + wid * 64;
    if (lane < AS_PAGES) pgl[lane] = pt[lane];
    asm volatile("s_waitcnt vmcnt(0) lgkmcnt(0)" ::: "memory");
    TLOAD(sA, 0); TLOAD(sB, 1);
    {
        const bf16* QN = (const bf16*)(ws + WS_QN); const bf16* QR = (const bf16*)(ws + WS_QR); const bf16* WUKB = (const bf16*)(ws + WS_WUKB);
        bf16* QABS = (bf16*)(ws + WS_QABS) + (size_t)b * 64 * 288;
        const size_t qrow0 = (size_t)(SAMP0 + b * 4);
        const int l15 = lane & 15, l4 = lane >> 4, tok = l15 & 3;
#pragma unroll 1
        for (int hh = 0; hh < 2; ++hh) { const int h = 2 * wid + hh;
            const bf16x8 bq0 = *(const bf16x8*)(QN + (qrow0 + tok) * 1024 + h * 64 + 8 * l4), bq1 = *(const bf16x8*)(QN + (qrow0 + tok) * 1024 + h * 64 + 32 + 8 * l4);
#pragma unroll 4
            for (int nt = 0; nt < 16; ++nt) { const bf16* wp = WUKB + (size_t)(nt * 16 + l15) * 1024 + h * 64 + 8 * l4;
                const bf16x8 a0 = *(const bf16x8*)wp, a1 = *(const bf16x8*)(wp + 32);
                f32x4 acc = (f32x4){0.f, 0.f, 0.f, 0.f};
                acc = __builtin_amdgcn_mfma_f32_16x16x32_bf16(a0, bq0, acc, 0, 0, 0);
                acc = __builtin_amdgcn_mfma_f32_16x16x32_bf16(a1, bq1, acc, 0, 0, 0);
                if (l15 < 4) { const int q = l15 * 16 + h, c0 = nt * 16 + l4 * 4; u32x2 w; w.x = cvtpk(acc[0], acc[1]); w.y = cvtpk(acc[2], acc[3]);
                    *(u32x2*)(lds + OFF_Q + img_off(q, c0 >> 3) + (c0 & 7) * 2) = w; if (s == 0) *(u32x2*)(QABS + (size_t)q * 288 + c0) = w; } }
        }
        if (tid < 256) { const int q = tid >> 2, c = tid & 3; const u32x4 w = *(const u32x4*)(QR + (qrow0 + (q >> 4)) * 512 + (q & 15) * 32 + c * 8);
            *(u32x4*)(lds + OFF_Q + off_rope(q, c)) = w; if (s == 0) *(u32x4*)(QABS + (size_t)q * 288 + 256 + c * 8) = w; }
    }
    unsigned kaddr[2], qaddr[2], kraddr, qraddr;
    { const unsigned krow = kh * 32 + r32, qrow = qg * 32 + r32;
#pragma unroll
      for (int od = 0; od < 2; ++od) { kaddr[od] = off_a(krow, 2 * od + hi); qaddr[od] = OFF_Q + off_a(qrow, 2 * od + hi); }
      kraddr = off_rope(krow, hi); qraddr = OFF_Q + off_rope(qrow, hi); }
    const unsigned kr2 = IMG_ROPE + 64u * (kh * 32 + r32) + 16u * ((2 + hi) ^ (((kh * 32 + r32) >> 2) & 3)), qr2 = OFF_Q + IMG_ROPE + 64u * (qg * 32 + r32) + 16u * ((2 + hi) ^ (((qg * 32 + r32) >> 2) & 3));
    unsigned vaddr[2];
    { const unsigned blk = (lane >> 4) & 1, q = (lane & 15) >> 2, p = lane & 3;
#pragma unroll
      for (int t = 0; t < 2; ++t) vaddr[t] = chh * IMG_HALF + off_a(32 * kh + 8 * hi + 4 * t + q, 2 * blk + (p >> 1)) + 8 * (p & 1); }
    float m_reg = -1e30f, l_reg = 0.f; f32x16 o[4] = {};
    const unsigned ldsb = (unsigned)(uintptr_t)lds;
#define KQ_LD(X, pp) do { constexpr unsigned so_ = 512u * ((pp) & 3) + (unsigned)IMG_HALF * ((pp) >> 2); \
        k##X##0 = *(const bf16x8*)(lds + bo_ + kaddr[0] + so_); q##X##0 = *(const bf16x8*)(lds + qaddr[0] + so_); k##X##1 = *(const bf16x8*)(lds + bo_ + kaddr[1] + so_); q##X##1 = *(const bf16x8*)(lds + qaddr[1] + so_); } while (0)
#define KQ_LDR(X) do { k##X##0 = *(const bf16x8*)(lds + bo_ + kraddr); q##X##0 = *(const bf16x8*)(lds + qraddr); k##X##1 = *(const bf16x8*)(lds + bo_ + kr2); q##X##1 = *(const bf16x8*)(lds + qr2); } while (0)
#define KQ_MM(X) do { p = __builtin_amdgcn_mfma_f32_32x32x16_bf16(k##X##0, q##X##0, p, 0, 0, 0); p = __builtin_amdgcn_mfma_f32_32x32x16_bf16(k##X##1, q##X##1, p, 0, 0, 0); } while (0)
#define PV_RD(X, nt) do { v##X##0 = tr_read_dyn(ldsb + bo_ + vaddr[0] + 512 * (nt)); v##X##1 = tr_read_dyn(ldsb + bo_ + vaddr[1] + 512 * (nt)); \
        v##X##2 = tr_read_dyn(ldsb + bo_ + vaddr[0] + 512 * (nt) + 4096); v##X##3 = tr_read_dyn(ldsb + bo_ + vaddr[1] + 512 * (nt) + 4096); } while (0)
#define PV_MM(X, nt) do { o[nt] = __builtin_amdgcn_mfma_f32_32x32x16_bf16(pa0, ((bf16x8){v##X##0[0], v##X##0[1], v##X##0[2], v##X##0[3], v##X##1[0], v##X##1[1], v##X##1[2], v##X##1[3]}), o[nt], 0, 0, 0); \
        o[nt] = __builtin_amdgcn_mfma_f32_32x32x16_bf16(pa1, ((bf16x8){v##X##2[0], v##X##2[1], v##X##2[2], v##X##2[3], v##X##3[0], v##X##3[1], v##X##3[2], v##X##3[3]}), o[nt], 0, 0, 0); } while (0)
#define LGKM_WAIT(N) do { asm volatile("s_waitcnt lgkmcnt(" #N ")" ::: "memory"); SBAR(); } while (0)
#define COMPUTE(bufoff) do { f32x16 p = f32x16{}; const unsigned bo_ = (bufoff); bf16x8 kA0, qA0, kA1, qA1, kB0, qB0, kB1, qB1; \
    KQ_LD(A, 0); KQ_LD(B, 1); SBAR(); KQ_MM(A); KQ_LD(A, 2); SBAR(); KQ_MM(B); KQ_LD(B, 3); SBAR(); KQ_MM(A); KQ_LD(A, 4); SBAR(); KQ_MM(B); KQ_LD(B, 5); SBAR(); \
    KQ_MM(A); KQ_LD(A, 6); SBAR(); KQ_MM(B); KQ_LD(B, 7); SBAR(); KQ_MM(A); KQ_LDR(A); SBAR(); KQ_MM(B); SBAR(); KQ_MM(A); SBAR(); \
    float pmax = p[0]; _Pragma("unroll") for (int r = 1; r < 16; ++r) pmax = fmaxf(pmax, p[r]); \
    { auto rr = __builtin_amdgcn_permlane32_swap(__float_as_uint(pmax), __float_as_uint(pmax), false, false); pmax = fmaxf(__uint_as_float(rr[0]), __uint_as_float(rr[1])); } \
    float alpha = 1.f; \
    if (!__all(pmax - m_reg <= THR)) { const float mn = fmaxf(m_reg, pmax); alpha = __builtin_amdgcn_exp2f(m_reg - mn); m_reg = mn; \
        if (hi == 0) wsf[r32] = alpha; asm volatile("s_waitcnt lgkmcnt(0)" ::: "memory"); \
        _Pragma("unroll") for (int n = 0; n < 4; ++n) _Pragma("unroll") for (int r = 0; r < 16; ++r) o[n][r] *= wsf[ap::crow(r, hi)]; } \
    s16x4 vA0, vA1, vA2, vA3, vB0, vB1, vB2, vB3; asm volatile("s_waitcnt lgkmcnt(0)" ::: "memory"); SBAR(); PV_RD(A, 0); SBAR();        \
    float ps = 0.f; _Pragma("unroll") for (int r = 0; r < 16; ++r) { p[r] = __builtin_amdgcn_exp2f(p[r] - m_reg); ps += p[r]; } \
    { auto rr = __builtin_amdgcn_permlane32_swap(__float_as_uint(ps), __float_as_uint(ps), false, false); ps = __uint_as_float(rr[0]) + __uint_as_float(rr[1]); } \
    l_reg = l_reg * alpha + ps; \
    bf16x8 pa0, pa1; PK4(p, 0, pa0); PK4(p, 8, pa1); SBAR(); \
    PV_RD(B, 1); LGKM_WAIT(4); PV_MM(A, 0); SBAR(); PV_RD(A, 2); LGKM_WAIT(4); PV_MM(B, 1); SBAR(); PV_RD(B, 3); LGKM_WAIT(4); PV_MM(A, 2); SBAR(); LGKM_WAIT(0); PV_MM(B, 3); SBAR(); } while (0)
    TWRITE(OFF_K0, sA); TLOAD(sA, 2); TWRITE(OFF_K0 + IMG_BYTES, sB); TLOAD(sB, 3); __syncthreads();
    { unsigned bc = OFF_K0, bn = OFF_K0 + IMG_BYTES, bw = OFF_K0 + 2 * IMG_BYTES;
#pragma unroll 1
      for (int t = 0; t < NTILE; t += 2) {
        SBAR(); COMPUTE(bc); SBAR();
        TWRITE(bw, sA); TLOAD(sA, t + 4);
        __syncthreads();
        { const unsigned x_ = bc; bc = bn; bn = bw; bw = x_; }
        SBAR(); COMPUTE(bc); SBAR();
        TWRITE(bw, sB); TLOAD(sB, t + 5);
        __syncthreads();
        { const unsigned x_ = bc; bc = bn; bn = bw; bw = x_; }
      } }
    { float* xo = (float*)lds + (size_t)(chh * 2 + qg) * 4096;
      float* xml = (float*)(lds + 65536) + (chh * 2 + qg) * 128;
      if (kh == 1) {
#pragma unroll
          for (int nt = 0; nt < 4; ++nt)
#pragma unroll
              for (int r = 0; r < 16; ++r) xo[(nt * 16 + r) * 64 + lane] = o[nt][r];
          xml[lane] = m_reg; xml[64 + lane] = l_reg; }
      __syncthreads();
      if (kh == 0) {
          const float m2 = xml[lane], l2 = xml[64 + lane]; const float mn = fmaxf(m_reg, m2); const float a1 = __builtin_amdgcn_exp2f(m_reg - mn), a2 = __builtin_amdgcn_exp2f(m2 - mn);
          l_reg = l_reg * a1 + l2 * a2; m_reg = mn;
          if (hi == 0) { wsf[r32] = a1; wsf[32 + r32] = a2; } asm volatile("s_waitcnt lgkmcnt(0)" ::: "memory");
          float* PO = (float*)(ws + WS_PART) + ((size_t)(b * 4 + s) * 64) * 256; float* PML = (float*)(ws + WS_PML) + (size_t)(b * 4 + s) * 128;
#pragma unroll
          for (int nt = 0; nt < 4; ++nt)
#pragma unroll
              for (int r = 0; r < 16; ++r) { const int qr_ = ap::crow(r, hi); PO[(size_t)(qg * 32 + qr_) * 256 + chh * 128 + nt * 32 + r32] = o[nt][r] * wsf[qr_] + xo[(nt * 16 + r) * 64 + lane] * wsf[32 + qr_]; }
          if (chh == 0 && hi == 0) { PML[qg * 32 + r32] = m_reg; PML[64 + qg * 32 + r32] = l_reg; } }
    }
    __syncthreads();
#undef TLOAD
#undef TWRITE
#undef COMPUTE
#undef KQ_LD
#undef KQ_LDR
#undef KQ_MM
#undef PV_RD
#undef PV_MM
#undef LGKM_WAIT
}
#undef PK4
#undef PKV
#undef KSWZ
}

__device__ __forceinline__ void comb_unit(const Args& A, int b, int hq, char* lds, const int wave) {
    unsigned char* ws = A.ws; const int tid = wave * 64 + lane_fresh(), lq = tid >> 5, l = lq >> 2, h = hq * 4 + (lq & 3), j = tid & 31, q = l * 16 + h;
    const bf16* QABS = (const bf16*)(ws + WS_QABS) + ((size_t)b * 64 + q) * 288; const bf16* CB = (const bf16*)(ws + WS_CB); const bf16* KRB = (const bf16*)(ws + WS_KRB);
    const float* PO = (const float*)(ws + WS_PART) + ((size_t)b * 4 * 64 + q) * 256; const float* PML = (const float*)(ws + WS_PML) + (size_t)b * 4 * 128;
    float* olds = (float*)lds;
    float qv[8], qrv[8];
    { const u32x4 w = *(const u32x4*)(QABS + j * 8);
#pragma unroll
      for (int k = 0; k < 4; ++k) { qv[2 * k] = bflo(w[k]); qv[2 * k + 1] = bfhi(w[k]); }
      u32x4 wr = (u32x4){0u, 0u, 0u, 0u}; if (j < 4) wr = *(const u32x4*)(QABS + 256 + j * 8);
#pragma unroll
      for (int k = 0; k < 4; ++k) { qrv[2 * k] = bflo(wr[k]); qrv[2 * k + 1] = bfhi(wr[k]); } }
    float sc[4], cn[4][8];
#pragma unroll
    for (int jn = 0; jn < 4; ++jn) { const size_t row = (size_t)(SAMP0 + b * 4 + jn); const u32x4 w = *(const u32x4*)(CB + row * 256 + j * 8); float d = 0.f;
#pragma unroll
        for (int k = 0; k < 4; ++k) { cn[jn][2 * k] = bflo(w[k]); cn[jn][2 * k + 1] = bfhi(w[k]); d += qv[2 * k] * cn[jn][2 * k] + qv[2 * k + 1] * cn[jn][2 * k + 1]; }
        if (j < 4) { const u32x4 wr = *(const u32x4*)(KRB + row * 32 + j * 8);
#pragma unroll
            for (int k = 0; k < 4; ++k) d += qrv[2 * k] * bflo(wr[k]) + qrv[2 * k + 1] * bfhi(wr[k]); }
#pragma unroll
        for (int o = 1; o < 32; o <<= 1) d = d + shfl_xor_f(d, o, tid & 63);
        sc[jn] = jn <= l ? d : -INFINITY; }
    float mp[4], lp[4], M = -INFINITY;
#pragma unroll
    for (int p = 0; p < AS_SPLITS; ++p) { mp[p] = PML[p * 128 + q]; lp[p] = PML[p * 128 + 64 + q]; M = fmaxf(M, mp[p]); }
#pragma unroll
    for (int jn = 0; jn < 4; ++jn) M = fmaxf(M, sc[jn]);
    float L = 0.f, acc[8];
#pragma unroll
    for (int k = 0; k < 8; ++k) acc[k] = 0.f;
#pragma unroll
    for (int p = 0; p < AS_SPLITS; ++p) { const float w = __builtin_amdgcn_exp2f(mp[p] - M); L += w * lp[p]; const f32x4 a = *(const f32x4*)(PO + (size_t)p * 64 * 256 + j * 8), c = *(const f32x4*)(PO + (size_t)p * 64 * 256 + j * 8 + 4);
#pragma unroll
        for (int k = 0; k < 4; ++k) { acc[k] += w * a[k]; acc[4 + k] += w * c[k]; } }
#pragma unroll
    for (int jn = 0; jn < 4; ++jn) { const float w = __builtin_amdgcn_exp2f(sc[jn] - M); L += w;
#pragma unroll
        for (int k = 0; k < 8; ++k) acc[k] += w * cn[jn][k]; }
    const float rl = 1.0f / L;
    *(f32x4*)(olds + lq * 256 + j * 8) = (f32x4){acc[0] * rl, acc[1] * rl, acc[2] * rl, acc[3] * rl}; *(f32x4*)(olds + lq * 256 + j * 8 + 4) = (f32x4){acc[4] * rl, acc[5] * rl, acc[6] * rl, acc[7] * rl};
    __syncthreads();
    const bf16* WUV = (const bf16*)(ws + WS_WUKV) + (size_t)(1024 + h * 64 + 2 * j) * 256;
    float o0 = 0.f, o1 = 0.f;
    for (int c = 0; c < 256; c += 8) { const u32x4 w0 = *(const u32x4*)(WUV + c), w1 = *(const u32x4*)(WUV + 256 + c); const f32x4 x0 = *(const f32x4*)(olds + lq * 256 + c), x1 = *(const f32x4*)(olds + lq * 256 + c + 4);
        o0 += x0[0] * bflo(w0[0]) + x0[1] * bfhi(w0[0]) + x0[2] * bflo(w0[1]) + x0[3] * bfhi(w0[1]) + x1[0] * bflo(w0[2]) + x1[1] * bfhi(w0[2]) + x1[2] * bflo(w0[3]) + x1[3] * bfhi(w0[3]);
        o1 += x0[0] * bflo(w1[0]) + x0[1] * bfhi(w1[0]) + x0[2] * bflo(w1[1]) + x0[3] * bfhi(w1[1]) + x1[0] * bflo(w1[2]) + x1[1] * bfhi(w1[2]) + x1[2] * bflo(w1[3]) + x1[3] * bfhi(w1[3]); }
    const size_t orow = (size_t)(SAMP0 + b * 4 + l) * 1024 + h * 64 + 2 * j;
    const unsigned z = *(const unsigned*)((const bf16*)(ws + WS_SZ) + orow);
    *(unsigned*)((bf16*)(ws + WS_OG) + orow) = cvtpk(o0 * bflo(z), o1 * bfhi(z));
    __syncthreads();
}
constexpr int N_AS_ITEMS = DECB * AS_SPLITS;
#ifndef PREF_DIV
#define PREF_DIV 4
#endif
#ifndef PREF_NUM
#define PREF_NUM 0
#endif
#ifndef ARGS_RELOAD
#define ARGS_RELOAD 1
#endif
#ifndef REP_BAR
#define REP_BAR 1
#endif
#ifndef REP_ELT
#define REP_ELT 1
#endif
#ifndef TAIL_CONV
#define TAIL_CONV 1
#endif
#ifndef STATIC_SCHED
#define STATIC_SCHED 0
#endif
#ifndef REP_AS
#define REP_AS 1
#endif
#ifndef REP_AP
#define REP_AP 1
#endif
#ifndef REP_GEMM
#define REP_GEMM 1
#endif
#ifndef EN_P0
#define EN_P0 1
#endif
#ifndef EN_G1
#define EN_G1 1
#endif
#ifndef EN_CONV
#define EN_CONV 1
#endif
#ifndef EN_G4
#define EN_G4 1
#endif
#ifndef EN_LAT
#define EN_LAT 1
#endif
#ifndef EN_G5
#define EN_G5 1
#endif
#ifndef EN_G6
#define EN_G6 1
#endif
#ifndef EN_AP
#define EN_AP 1
#endif
#ifndef EN_AS
#define EN_AS 1
#endif
#ifndef EN_COMB
#define EN_COMB 1
#endif
#ifndef EN_GOUT
#define EN_GOUT 1
#endif
#ifndef EN_NORM
#define EN_NORM 1
#endif

__device__ __forceinline__ Args fresh_args() {
    const __attribute__((address_space(4))) unsigned long long* p = (const __attribute__((address_space(4))) unsigned long long*)__builtin_amdgcn_kernarg_segment_ptr();
    asm volatile("" : "+s"(p));
#define GP(T, i) ((T*)(__attribute__((address_space(1))) T*)p[i])
    Args a;
    a.x_prompt = GP(const float, 0); a.x_sample = GP(const float, 1); a.cache_ckv = GP(const float, 2); a.cache_krope = GP(const float, 3); a.state_conv = GP(const float, 4); a.page_table = GP(const int, 5);
    a.meta = GP(const float, 6); a.pre_g = GP(const float, 7); a.post_g = GP(const float, 8); a.w_in_conv = GP(const float, 9); a.conv_w = GP(const float, 10); a.w_out_conv = GP(const float, 11);
    a.kv_norm_g = GP(const float, 12); a.w_dkv = GP(const float, 13); a.kv_lat_g = GP(const float, 14); a.w_uk = GP(const float, 15); a.w_uv = GP(const float, 16); a.w_in_mla = GP(const float, 17);
    a.q_norm_g = GP(const float, 18); a.w_uq = GP(const float, 19); a.w_out_mla = GP(const float, 20); a.out = GP(float, 21); a.ws = GP(unsigned char, 22);
#undef GP
    return a;
}
static_assert(sizeof(Args) == 23 * 8, "Args = 23 pointers, no padding: fresh_args() reads them by index");
__global__ void __launch_bounds__(NWAVES * 64, 2) yoco_fwd(Args args_unused_directly) {
    extern __shared__ __attribute__((aligned(16))) unsigned char lds[];
    LAS unsigned char* ldsl = (LAS unsigned char*)lds;
    const int wave = __builtin_amdgcn_readfirstlane(threadIdx.x >> 6) & 7;
#define LANE_OPAQUE() const int lane = lane_fresh()
#define IS_T0() (wave == 0 && lane_fresh() == 0)
#if ARGS_RELOAD
#define PHASE_ARGS() const Args args = fresh_args(); unsigned char* const ws = args.ws; (void)ws; PHASE_IDS()
#else
#define PHASE_ARGS() Args args = args_unused_directly; asm volatile("" : "+s"(args.ws), "+s"(args.out)); unsigned char* const ws = args.ws; (void)ws; PHASE_IDS()
#endif
    const int G0 = gridDim.x, bx0 = blockIdx.x;
#define PHASE_IDS() int G = G0, bx = bx0; asm volatile("" : "+s"(G), "+s"(bx)); const int vcu = (G % 8 == 0) ? (bx % 8) * (G / 8) + bx / 8 : bx; const int gw = vcu * NWAVES + wave, NGW = G * NWAVES; (void)vcu; (void)gw; (void)NGW
    { const int t_ = wave * 64 + lane_fresh(); if (t_ < 8) ((LAS unsigned*)(ldsl + LDSCTL_OFF))[t_] = 0u; }
    __syncthreads();
    { PHASE_ARGS(); (void)xcd_barrier_post((unsigned*)(ws + WS_CTL) + CW_BAR, (volatile LAS unsigned*)(ldsl + LDSCTL_OFF), IS_T0()); }
#define GRID_BAR() do { PHASE_ARGS(); XcdBarrier b_; b_.bar = (unsigned*)(ws + WS_CTL) + CW_BAR; b_.x = xb_xcc_id(); b_.st = (volatile LAS unsigned*)(ldsl + LDSCTL_OFF); for (int rb_ = 0; rb_ < REP_BAR; ++rb_) xcd_barrier(b_, IS_T0()); } while (0)
#if EN_P0
    { PHASE_ARGS(); LANE_OPAQUE(); for (int re_ = 0; re_ < REP_ELT; ++re_) p0_prologue(args, ldsl, gw, NGW, wave, lane); }
#endif
    GRID_BAR();

#pragma unroll 1
    for (int l = 0; l < 4; ++l) {
        if (l < 2) {
            { PHASE_ARGS(); pg8::Gemm g{(const bf16*)(ws + WS_X), (const bf16*)(ws + WS_WIN) + (size_t)l * 4096 * 1024, NROWS, 4096, 1024}; pg8::RepOrder<REP_GEMM> S; S.init(NROWS, 4096, G, bx);
              pg8::EpiConvSplit E{(bf16*)(ws + WS_V1), (bf16*)(ws + WS_GZ), (const float*)(ws + WS_RS)};
#if EN_G1
              pg8::gemm_phase<pg8::EpiConvSplit, pg8::RepOrder<REP_GEMM>, true, true>(ldsl, g, S, E, wave);
#endif
              { constexpr int r_ = (67 * 16) % 256; if (TAIL_CONV && G == 256 && bx >= r_) { LANE_OPAQUE(); convert_set(args, l == 0 ? 1 : 3, ldsl, (bx - r_) * NWAVES + wave, (256 - r_) * NWAVES, wave, lane); }
                else if (TAIL_CONV && G != 256 && l == 0) { LANE_OPAQUE(); convert_set(args, 1, ldsl, gw, NGW, wave, lane); convert_set(args, 3, ldsl, gw, NGW, wave, lane); } }
 }
            GRID_BAR();
#if EN_CONV
            { PHASE_ARGS(); LANE_OPAQUE(); for (int re_ = 0; re_ < REP_ELT; ++re_) conv_phase(args, l, gw, NGW, lane); }
#endif
            GRID_BAR();
        } else {
            const int j = l - 2;
            { PHASE_ARGS(); pg8::Gemm g{(const bf16*)(ws + WS_X), (const bf16*)(ws + (j ? WS_WA1 : WS_WA0)), NROWS, j ? 1536 : 2048, 1024}; pg8::RepOrder<REP_GEMM> S; S.init(NROWS, j ? 1536 : 2048, G, bx);
              pg8::EpiMlaIn E{(float*)(ws + WS_CKR), (bf16*)(ws + WS_QL), (float*)(ws + WS_SSQ), (bf16*)(ws + WS_SZ), j ? 0 : 2, (const float*)(ws + WS_RS)};
#if EN_G4
              pg8::gemm_phase<pg8::EpiMlaIn, pg8::RepOrder<REP_GEMM>, true, true>(ldsl, g, S, E, wave);
#endif
 }
            GRID_BAR();
            if (j == 0) {
#if EN_LAT
                { PHASE_ARGS(); LANE_OPAQUE(); for (int re_ = 0; re_ < REP_ELT; ++re_) latent_phase(args, gw, NGW, lane); }
#endif
                GRID_BAR();
                { PHASE_ARGS(); pg8::Gemm g{(const bf16*)(ws + WS_CB), (const bf16*)(ws + WS_WUKV), NROWS, 2048, 256}; pg8::RepOrder<REP_GEMM> S; S.init(NROWS, 2048, G, bx);
                  pg8::EpiBf16 E{(bf16*)(ws + WS_KN), 1024, 1024, (size_t)(WS_VV - WS_KN) / 2};
#if EN_G5
                  pg8::gemm_phase<pg8::EpiBf16, pg8::RepOrder<REP_GEMM>, true, true>(ldsl, g, S, E, wave);
#endif
 }
            }
            { PHASE_ARGS(); pg8::Gemm g{(const bf16*)(ws + WS_QL), (const bf16*)(ws + WS_WUQ) + (size_t)j * 1536 * 512, NROWS, 1536, 512}; pg8::RepOrder<REP_GEMM> S; S.init(NROWS, 1536, G, bx);
              pg8::EpiQUp E{(bf16*)(ws + WS_QN), (bf16*)(ws + WS_QR), (const float*)(ws + WS_SSQ), (const float*)(ws + WS_COS), (const float*)(ws + WS_SIN)};
#if EN_G6
              pg8::gemm_phase<pg8::EpiQUp, pg8::RepOrder<REP_GEMM>, true, true>(ldsl, g, S, E, wave);
#endif
 }
            GRID_BAR();
            {
                PHASE_ARGS();
                unsigned* qh = (unsigned*)(ws + WS_CTL) + CW_Q + j * 16 * 64;
                volatile LAS int* slot = (volatile LAS int*)(ldsl + LDSCTL_OFF + 16);
                const int myq = bx & 7; const bool prefS = ((bx >> 3) % PREF_DIV) < PREF_NUM;
                bool s_open = true, own_open = true; unsigned steal = 0xffffffffu;
#define DEQUEUE(dst, word) do { if (IS_T0()) *slot = (int)__hip_atomic_fetch_add(qh + (word) * 64, 1u, __ATOMIC_RELAXED, __HIP_MEMORY_SCOPE_AGENT); __syncthreads(); dst = *slot; __syncthreads(); } while (0)
#pragma unroll 1
                for (;;) {
                    int type = -1, id = 0, q = 0;
                    if (prefS && s_open) { DEQUEUE(id, 8); if (id < N_AS_ITEMS * REP_AS) type = 0; else s_open = false; }
                    if (type < 0 && own_open) { q = myq; DEQUEUE(id, q); if (id < 130 * REP_AP) { id = id % 130; type = id < 128 ? 1 : 2; } else own_open = false; }
                    if (type < 0 && s_open) { DEQUEUE(id, 8); if (id < N_AS_ITEMS * REP_AS) type = 0; else s_open = false; }
                    if (type < 0) {
                        if (steal == 0xffffffffu) { if (IS_T0()) { unsigned m_ = 0u;
#pragma unroll
                                for (int k_ = 0; k_ < 8; ++k_) if (__hip_atomic_load(qh + k_ * 64, __ATOMIC_RELAXED, __HIP_MEMORY_SCOPE_AGENT) < 130u * REP_AP) m_ |= 1u << k_;
                                *slot = (int)m_; } __syncthreads(); steal = (unsigned)*slot & ~(1u << myq); __syncthreads(); }
                        while (steal) { q = __builtin_ctz(steal); DEQUEUE(id, q); if (id < 130 * REP_AP) { id = id % 130; type = id < 128 ? 1 : 2; break; } steal &= ~(1u << q); }
                    }
                    if (type < 0) break;
#if EN_AS
                    if (type == 0) { id = id % N_AS_ITEMS; as::attn_s_unit(args, id / AS_SPLITS, id % AS_SPLITS, (char*)lds, wave); }
#endif
#if EN_AP
                    if (type >= 1) { const bool mt = type == 2; const int bh = q * 8 + (id & 7);
                        ap::attn_unit(ws, mt ? 0 : bh >> 4, mt ? q * 2 + (id - 128) : bh & 15, mt ? 0 : 15 - (id >> 3), mt, (char*)lds, wave); }
#endif
                }
#undef DEQUEUE
            }
            GRID_BAR();
#if EN_COMB
            { PHASE_ARGS(); for (int u = vcu; u < NSAMP * REP_ELT; u += G) comb_unit(args, (u % NSAMP) >> 2, u & 3, (char*)lds, wave); }
#endif
            GRID_BAR();
        }
        { PHASE_ARGS(); const bf16* Ag = (const bf16*)(ws + (l < 2 ? WS_G : WS_OG)); const bf16* Wl = (const bf16*)(ws + (l < 2 ? WS_WOC : WS_WOM)) + (size_t)(l & 1) * 1024 * 1024;
#if EN_GOUT
          { pg8::Gemm g{Ag, Wl, NMAIN, 1024, 1024}; pg8::StaticOrder S; S.init(NMAIN, 1024, G, bx); pg8::EpiBf16 E{(bf16*)(ws + WS_MB), 1024, 0, 0};
            pg8::gemm_phase<pg8::EpiBf16, pg8::StaticOrder, true, true>(ldsl, g, S, E, wave); }
          { pg8::Gemm g{Ag, Wl, NROWS, 1024, 1024 / GOUT_SPLITK, 1024}; pg8::SplitKSmallOrder<GOUT_SPLITK> S; S.init(1024, 1024, G, bx); pg8::EpiPartF32 E{(float*)(ws + WS_PARTG), 1024 / GOUT_SPLITK};
            pg8::gemm_phase<pg8::EpiPartF32, pg8::SplitKSmallOrder<GOUT_SPLITK>, true, true>(ldsl, g, S, E, wave); }
#endif
          if (l < 2) { constexpr int r_ = 96; if (TAIL_CONV && G == 256 && bx >= r_) { LANE_OPAQUE(); convert_set(args, l == 0 ? 2 : 4, ldsl, (bx - r_) * NWAVES + wave, (256 - r_) * NWAVES, wave, lane); }
                       else if (TAIL_CONV && G != 256 && l == 0) { LANE_OPAQUE(); convert_set(args, 2, ldsl, gw, NGW, wave, lane); convert_set(args, 4, ldsl, gw, NGW, wave, lane); } }
 }
        GRID_BAR();
#if EN_NORM
        { PHASE_ARGS(); LANE_OPAQUE(); norm_phase(args, l, gw, NGW, lane); }
#endif
        if (l < 3) GRID_BAR();
    }
}

extern "C" void kernel_launch(void* const* d_in, const int* in_sizes, int n_in, void* d_out, int out_size, void* d_ws, size_t ws_size, hipStream_t stream) {
    static int grid = 0;
    if (grid == 0) {
        if (n_in != 21 || out_size != (int)O_END || ws_size < WS_END) { fprintf(stderr, "kernel_launch: unexpected shapes: n_in %d out %d (want %zu) ws %zu (want >= %zu)\n", n_in, out_size, (size_t)O_END, ws_size, (size_t)WS_END); grid = -1; return; }
        int dev = 0, cus = 0, per_cu = 0;
        if (hipGetDevice(&dev) != hipSuccess || hipDeviceGetAttribute(&cus, hipDeviceAttributeMultiprocessorCount, dev) != hipSuccess) { grid = -1; return; }
        if (hipFuncSetAttribute((const void*)yoco_fwd, hipFuncAttributeMaxDynamicSharedMemorySize, LDS_BYTES) != hipSuccess) { fprintf(stderr, "kernel_launch: hipFuncSetAttribute failed\n"); grid = -1; return; }
        if (hipOccupancyMaxActiveBlocksPerMultiprocessor(&per_cu, (const void*)yoco_fwd, NWAVES * 64, LDS_BYTES) != hipSuccess || per_cu < 1) { fprintf(stderr, "kernel_launch: occupancy query says %d blocks per CU\n", per_cu); }
        (void)hipGetLastError();
        grid = cus;
    }
    if (grid < 0) return;
    if (hipMemsetAsync((char*)d_ws + WS_CTL, 0, CTL_ZERO_BYTES, stream) != hipSuccess) return;
    Args a{};
    a.x_prompt = (const float*)d_in[0]; a.x_sample = (const float*)d_in[1]; a.cache_ckv = (const float*)d_in[2]; a.cache_krope = (const float*)d_in[3]; a.state_conv = (const float*)d_in[4];
    a.page_table = (const int*)d_in[5]; a.meta = (const float*)d_in[6]; a.pre_g = (const float*)d_in[7]; a.post_g = (const float*)d_in[8]; a.w_in_conv = (const float*)d_in[9];
    a.conv_w = (const float*)d_in[10]; a.w_out_conv = (const float*)d_in[11]; a.kv_norm_g = (const float*)d_in[12]; a.w_dkv = (const float*)d_in[13]; a.kv_lat_g = (const float*)d_in[14];
    a.w_uk = (const float*)d_in[15]; a.w_uv = (const float*)d_in[16]; a.w_in_mla = (const float*)d_in[17]; a.q_norm_g = (const float*)d_in[18]; a.w_uq = (const float*)d_in[19]; a.w_out_mla = (const float*)d_in[20];
    a.out = (float*)d_out; a.ws = (unsigned char*)d_ws;
    hipLaunchKernelGGL(yoco_fwd, dim3(grid), dim3(NWAVES * 64), LDS_BYTES, stream, a);
    const hipError_t le = hipPeekAtLastError();
    if (le != hipSuccess) fprintf(stderr, "kernel_launch: launch failed: %s\n", hipGetErrorName(le));
}
```

```cpp
#define PREF_NUM 2
#include <hip/hip_runtime.h>
#include <hip/hip_bf16.h>
#include <cstdio>
#include <cstdint>
#include <cmath>

constexpr int DM = 1024, NB = 4, SEQ = 4096, NMETA = 16, TTOT = SEQ + NMETA;
constexpr int DECB = 128, DECS = 4, PAST = 8192, PAGE = 128, NPAGES = PAST / PAGE;
constexpr int NH = 16, QKN = 64, QKR = 32, VH = 64, QLORA = 512, KVL = 256;
constexpr int NMAIN = NB * SEQ;
constexpr int SAMP0 = NMAIN, NSAMP = DECB * DECS;
constexpr int META0 = SAMP0 + NSAMP;
constexpr int NROWS = META0 + 256;
constexpr int NPOS = TTOT + DECS;
constexpr float RMS_EPS = 1e-6f;
#ifndef AS_SPLITS_N
#define AS_SPLITS_N 2
#endif
constexpr int AS_SPLITS = AS_SPLITS_N, AS_PAGES = NPAGES / AS_SPLITS;
constexpr float QSCALE = 0.10206207261596575f * 1.4426950408889634f;

__device__ __forceinline__ float shfl_xor_f(float v, int mask, int lane) { return __int_as_float(__builtin_amdgcn_ds_bpermute((lane ^ mask) << 2, __float_as_int(v))); }

__device__ __forceinline__ int lane_fresh() { int l; asm volatile("v_mbcnt_lo_u32_b32 %0, -1, 0\n\tv_mbcnt_hi_u32_b32 %0, -1, %0" : "=v"(l)); return l & 63; }

template <class T> __device__ __forceinline__ T* opaque_global(T* p) { unsigned long long v = (unsigned long long)p; asm volatile("" : "+s"(v)); return (T*)(__attribute__((address_space(1))) T*)v; }

namespace pg8 {
#define PG8_LAS __attribute__((address_space(3)))
typedef unsigned short bf16_t;
typedef short bf16x8 __attribute__((ext_vector_type(8)));
typedef float f32x4 __attribute__((ext_vector_type(4)));
typedef unsigned u32x4 __attribute__((ext_vector_type(4)));
constexpr int BM = 256, BK = 64, HALF = 128, HTB = HALF * BK * 2  , STAGE_BYTES = 8 * HTB, NXCD = 8, WGM = 8;

__host__ __device__ __forceinline__ int lds_byte(int r, int c) { const int st = (r >> 4) * 2 + (c >> 5), rr = r & 15, cc = c & 31, ob = rr * 64 + cc * 2; return st * 1024 + (ob ^ (((ob >> 9) & 1) << 5)); }
__host__ __device__ __forceinline__ void stage_rc(int b, int& R, int& C) { const int st = b / 1024, sb = b % 1024, swz = sb ^ (((sb >> 9) & 1) << 5); R = (st >> 1) * 16 + swz / 64; C = (st & 1) * 32 + (swz % 64) / 2; }
__host__ __device__ __forceinline__ int perm32(int rho) { const int n = rho >> 4, i = rho & 15; return 8 * (i >> 2) + 4 * n + (i & 3); }

struct Unit { int pm, pn; int koff = 0; };
struct Gemm { const bf16_t* A; const bf16_t* Bt; int M, N, K; int ld = 0; };

struct StaticOrder {
    int nM, nN, nwg, G, c;
    __host__ __device__ void init(int M, int N, int G_, int c_) { nM = M / BM; nN = N / BM; nwg = nM * nN; G = G_; c = c_; }
    __host__ __device__ bool next(int i, Unit& u) const {
        const long L = (long)i * G + c; if (L >= nwg) return false;
        int wgid = (int)L; { const int q = nwg / NXCD, r = nwg % NXCD, xcd = wgid % NXCD, off = wgid / NXCD; wgid = (xcd < r ? xcd * (q + 1) : r * (q + 1) + (xcd - r) * q) + off; }
        const int nig = WGM * nN, gid = wgid / nig, fm = gid * WGM, gsz = (nM - fm) < WGM ? (nM - fm) : WGM;
        u.pm = fm + ((wgid % nig) % gsz); u.pn = (wgid % nig) / gsz; return true;
    }
    __device__ __forceinline__ void a_ready(const Unit&) const {}
    __device__ __forceinline__ void done(const Unit&) const {}
};


template <int R> struct RepOrder {
    StaticOrder base; int cnt;
    __host__ __device__ void init(int M, int N, int G_, int c_) { base.init(M, N, G_, c_); cnt = (base.nwg - c_ + G_ - 1) / G_; if (cnt < 0) cnt = 0; }
    __host__ __device__ bool next(int i, Unit& u) const { if (i >= R * cnt) return false; return base.next(i % cnt, u); }
    __device__ __forceinline__ void a_ready(const Unit&) const {}
    __device__ __forceinline__ void done(const Unit&) const {}
};

template <int S> struct SplitKSmallOrder {
    int nN, G, c, ksub;
    __host__ __device__ void init(int N, int K, int G_, int c_) { nN = N / BM; G = G_; c = c_; ksub = K / S; }
    __host__ __device__ bool next(int i, Unit& u) const { const long L = (long)i * G + c; if (L >= 3L * nN * S) return false; const int r = (int)(L / S); u.koff = (int)(L % S) * ksub; u.pm = 64 + r % 3; u.pn = r / 3; return true; }
    __device__ __forceinline__ void a_ready(const Unit&) const {}
    __device__ __forceinline__ void done(const Unit&) const {}
};

typedef float f32x2_t __attribute__((ext_vector_type(2))); typedef __bf16 bf16x2_t __attribute__((ext_vector_type(2)));
__device__ __forceinline__ unsigned cvt_pk_bf16(float lo, float hi) { f32x2_t v = {lo, hi}; bf16x2_t b = __builtin_convertvector(v, bf16x2_t); return __builtin_bit_cast(unsigned, b); }
typedef unsigned u32x2 __attribute__((ext_vector_type(2)));
__device__ __forceinline__ float sigmoidf_fast(float z) { return __builtin_amdgcn_rcpf(1.0f + __builtin_amdgcn_exp2f(-1.4426950408889634f * z)); }

struct EpiBf16 {
    static constexpr bool PERM = true, AFTER_DRAIN = false;
    bf16_t* O; int ldc; int split_cols; size_t split_stride;
    __device__ __forceinline__ void operator()(const f32x4 (&acc)[2][2][4][2], const Unit& u, int wr, int wc, int fr, int fq) const {
        const int row0 = u.pm * BM + wr * 64 + fr; int colt = u.pn * BM; bf16_t* base = O;
        if (split_cols && colt >= split_cols) { base += split_stride; colt -= split_cols; }
        const int col0 = colt + wc * 32 + 8 * fq;
#pragma unroll
        for (int ai = 0; ai < 2; ++ai)
#pragma unroll
            for (int m = 0; m < 4; ++m) { bf16_t* rowp = base + (size_t)(row0 + ai * HALF + m * 16) * ldc + col0;
#pragma unroll
                for (int bj = 0; bj < 2; ++bj) { const f32x4 v0 = acc[ai][bj][m][0], v1 = acc[ai][bj][m][1];
                    u32x4 w; w.x = cvt_pk_bf16(v0[0], v0[1]); w.y = cvt_pk_bf16(v0[2], v0[3]); w.z = cvt_pk_bf16(v1[0], v1[1]); w.w = cvt_pk_bf16(v1[2], v1[3]);
                    *(u32x4*)(rowp + bj * HALF) = w; } }
    }
};

struct EpiConvSplit {
    static constexpr bool PERM = true, AFTER_DRAIN = false;
    bf16_t* V; bf16_t* GZ; const float* RS;
    __device__ __forceinline__ void operator()(const f32x4 (&acc)[2][2][4][2], const Unit& u, int wr, int wc, int fr, int fq) const {
        const int row0 = u.pm * BM + wr * 64 + fr, ch0 = u.pn * 64 + wc * 16 + fq * 4;
#pragma unroll
        for (int ai = 0; ai < 2; ++ai)
#pragma unroll
            for (int m = 0; m < 4; ++m) { const size_t off = (size_t)(row0 + ai * HALF + m * 16) * 1024 + ch0;
                const float rs = RS[row0 + ai * HALF + m * 16];
                const f32x4 bg = acc[ai][0][m][0] * rs, cg = acc[ai][0][m][1] * rs, uu = acc[ai][1][m][0] * rs, zz = acc[ai][1][m][1] * rs;
                const f32x4 v = cg * uu; f32x4 g;
#pragma unroll
                for (int e = 0; e < 4; ++e) g[e] = bg[e] * zz[e] * sigmoidf_fast(zz[e]);
                u32x2 wv, wg; wv.x = cvt_pk_bf16(v[0], v[1]); wv.y = cvt_pk_bf16(v[2], v[3]); wg.x = cvt_pk_bf16(g[0], g[1]); wg.y = cvt_pk_bf16(g[2], g[3]);
                *(u32x2*)(V + off) = wv; *(u32x2*)(GZ + off) = wg; }
    }
};

struct EpiMlaIn {
    static constexpr bool PERM = true, AFTER_DRAIN = false;
    float* CKR; bf16_t* QL; float* SSQ; bf16_t* SZ; int nck; const float* RS;
    __device__ __forceinline__ void operator()(const f32x4 (&acc)[2][2][4][2], const Unit& u, int wr, int wc, int fr, int fq) const {
        const int row0 = u.pm * BM + wr * 64 + fr; const int t = u.pn - nck;
        if (t < 0) {
            const int col0 = u.pn * BM + wc * 32 + 8 * fq;
#pragma unroll
            for (int ai = 0; ai < 2; ++ai)
#pragma unroll
                for (int m = 0; m < 4; ++m) { float* rowp = CKR + (size_t)(row0 + ai * HALF + m * 16) * 512 + col0; const float rs = RS[row0 + ai * HALF + m * 16];
#pragma unroll
                    for (int bj = 0; bj < 2; ++bj) { *(f32x4*)(rowp + bj * HALF) = acc[ai][bj][m][0] * rs; *(f32x4*)(rowp + bj * HALF + 4) = acc[ai][bj][m][1] * rs; } }
        } else if (t < 2) {
            const int col0 = t * BM + wc * 32 + 8 * fq;
#pragma unroll
            for (int ai = 0; ai < 2; ++ai)
#pragma unroll
                for (int m = 0; m < 4; ++m) { const int row = row0 + ai * HALF + m * 16; bf16_t* rowp = QL + (size_t)row * 512 + col0; float s = 0.f; const float rs = RS[row];
#pragma unroll
                    for (int bj = 0; bj < 2; ++bj) { const f32x4 v0 = acc[ai][bj][m][0] * rs, v1 = acc[ai][bj][m][1] * rs;
                        s += (v0[0] * v0[0] + v0[1] * v0[1]) + (v0[2] * v0[2] + v0[3] * v0[3]) + (v1[0] * v1[0] + v1[1] * v1[1]) + (v1[2] * v1[2] + v1[3] * v1[3]);
                        u32x4 w; w.x = cvt_pk_bf16(v0[0], v0[1]); w.y = cvt_pk_bf16(v0[2], v0[3]); w.z = cvt_pk_bf16(v1[0], v1[1]); w.w = cvt_pk_bf16(v1[2], v1[3]);
                        *(u32x4*)(rowp + bj * HALF) = w; }
                    { const int ln = fq * 16 + fr; s += shfl_xor_f(s, 16, ln); s += shfl_xor_f(s, 32, ln); }
                    if (fq == 0) SSQ[(size_t)row * 8 + t * 4 + wc] = s; }
        } else {
            const int col0 = (t - 2) * BM + wc * 32 + 8 * fq;
#pragma unroll
            for (int ai = 0; ai < 2; ++ai)
#pragma unroll
                for (int m = 0; m < 4; ++m) { bf16_t* rowp = SZ + (size_t)(row0 + ai * HALF + m * 16) * 1024 + col0; const float rs = RS[row0 + ai * HALF + m * 16];
#pragma unroll
                    for (int bj = 0; bj < 2; ++bj) { f32x4 v0 = acc[ai][bj][m][0] * rs, v1 = acc[ai][bj][m][1] * rs;
#pragma unroll
                        for (int e = 0; e < 4; ++e) { v0[e] = v0[e] * sigmoidf_fast(v0[e]); v1[e] = v1[e] * sigmoidf_fast(v1[e]); }
                        u32x4 w; w.x = cvt_pk_bf16(v0[0], v0[1]); w.y = cvt_pk_bf16(v0[2], v0[3]); w.z = cvt_pk_bf16(v1[0], v1[1]); w.w = cvt_pk_bf16(v1[2], v1[3]);
                        *(u32x4*)(rowp + bj * HALF) = w; } }
        }
    }
};

__device__ __forceinline__ int posidx_of_row(int row) {
    return row < NMAIN ? (row & (SEQ - 1)) + NMETA : (row < META0 ? TTOT + ((row - SAMP0) & 3) : (row < META0 + NMETA ? row - META0 : 0));
}
struct EpiQUp {
    static constexpr bool PERM = true, AFTER_DRAIN = false;
    bf16_t* QN; bf16_t* QR; const float* SSQ; const float* COS; const float* SIN;
    __device__ __forceinline__ void operator()(const f32x4 (&acc)[2][2][4][2], const Unit& u, int wr, int wc, int fr, int fq) const {
        const int row0 = u.pm * BM + wr * 64 + fr;
#pragma unroll
        for (int ai = 0; ai < 2; ++ai)
#pragma unroll
            for (int m = 0; m < 4; ++m) { const int row = row0 + ai * HALF + m * 16;
                const f32x4 s0 = *(const f32x4*)(SSQ + (size_t)row * 8), s1 = *(const f32x4*)(SSQ + (size_t)row * 8 + 4);
                const float ss = ((s0[0] + s0[1]) + (s0[2] + s0[3])) + ((s1[0] + s1[1]) + (s1[2] + s1[3]));
                const float sc = QSCALE / sqrtf(ss * (1.0f / 512.0f) + RMS_EPS);
                if (u.pn < 4) { bf16_t* rowp = QN + (size_t)row * 1024 + u.pn * BM + wc * 32 + 8 * fq;
#pragma unroll
                    for (int bj = 0; bj < 2; ++bj) { const f32x4 v0 = acc[ai][bj][m][0] * sc, v1 = acc[ai][bj][m][1] * sc;
                        u32x4 w; w.x = cvt_pk_bf16(v0[0], v0[1]); w.y = cvt_pk_bf16(v0[2], v0[3]); w.z = cvt_pk_bf16(v1[0], v1[1]); w.w = cvt_pk_bf16(v1[2], v1[3]);
                        *(u32x4*)(rowp + bj * HALF) = w; }
                } else { const int pi = posidx_of_row(row);
                    const f32x4 cs = *(const f32x4*)(COS + pi * 16 + 4 * fq), sn = *(const f32x4*)(SIN + pi * 16 + 4 * fq);
#pragma unroll
                    for (int bj = 0; bj < 2; ++bj) { const f32x4 x1 = acc[ai][bj][m][0] * sc, x2 = acc[ai][bj][m][1] * sc;
                        const f32x4 o1 = x1 * cs - x2 * sn, o2 = x1 * sn + x2 * cs;
                        bf16_t* hp = QR + (size_t)row * 512 + ((u.pn - 4) * 8 + 4 * bj + wc) * 32 + 4 * fq;
                        u32x2 w1, w2; w1.x = cvt_pk_bf16(o1[0], o1[1]); w1.y = cvt_pk_bf16(o1[2], o1[3]); w2.x = cvt_pk_bf16(o2[0], o2[1]); w2.y = cvt_pk_bf16(o2[2], o2[3]);
                        *(u32x2*)hp = w1; *(u32x2*)(hp + 16) = w2; } }
            }
    }
};


struct EpiPartF32 {
    static constexpr bool PERM = true, AFTER_DRAIN = false;
    float* P; int ksub;
    __device__ __forceinline__ void operator()(const f32x4 (&acc)[2][2][4][2], const Unit& u, int wr, int wc, int fr, int fq) const {
        float* base = P + ((size_t)(u.koff / ksub) * 768 + (size_t)(u.pm - 64) * BM + wr * 64 + fr) * 1024 + u.pn * BM + wc * 32 + 8 * fq;
#pragma unroll
        for (int ai = 0; ai < 2; ++ai)
#pragma unroll
            for (int m = 0; m < 4; ++m) { float* rowp = base + (size_t)(ai * HALF + m * 16) * 1024;
#pragma unroll
                for (int bj = 0; bj < 2; ++bj) { *(f32x4*)(rowp + bj * HALF) = acc[ai][bj][m][0]; *(f32x4*)(rowp + bj * HALF + 4) = acc[ai][bj][m][1]; } }
    }
};
template <class Epi, class Sched, bool ALIGN_EPI = false, bool SP2 = false>
__device__ __forceinline__ void gemm_phase(PG8_LAS unsigned char* lds, const Gemm g, const Sched& S, const Epi& E, const int wave) {
    int wave_ = wave; asm volatile("" : "+s"(wave_)); wave_ &= 7;
    const int lane = lane_fresh(), tid = wave_ * 64 + lane, wid = wave_, wr = wid >> 2, wc = wid & 3, fr = lane & 15, fq = lane >> 4;
    const int K = g.K, nt = K / BK, ld = g.ld ? g.ld : g.K;
    unsigned voffA[2], voffB[2];
#pragma unroll
    for (int i = 0; i < 2; ++i) { int R, C; stage_rc(tid * 16 + i * 8192, R, C); const int Rb = Epi::PERM ? ((R & ~31) + perm32(R & 31)) : R;
        voffA[i] = (unsigned)(R * ld + C) * 2u; voffB[i] = (unsigned)(Rb * ld + C) * 2u; }
    const size_t kstep = (size_t)(BK * 2);
    const size_t hstep = (size_t)HALF * ld * 2;
    const size_t tstep = 2 * hstep;
    const unsigned ldsw = (unsigned)wid * 1024u;
    const int aoff = lds_byte(wr * 64 + fr, fq * 8), boff = lds_byte(wc * 32 + fr, fq * 8);
#define PG8_SA(b, h) (((b) * 2 + (h)) * HTB)
#define PG8_SB(b, h) ((4 + (b) * 2 + (h)) * HTB)
#define PG8_STAGE(bufoff, gbase, voff) do { _Pragma("unroll") for (int _i = 0; _i < 2; ++_i) \
        __builtin_amdgcn_global_load_lds((const unsigned*)((const char*)(gbase) + (voff)[_i]), (PG8_LAS unsigned*)(lds + (bufoff) + ldsw + _i * 8192), 16, 0, 0); } while (0)
#define PG8_LDA(dst, b, h) do { _Pragma("unroll") for (int m = 0; m < 4; ++m) _Pragma("unroll") for (int k = 0; k < 2; ++k) dst[m][k] = *(const PG8_LAS bf16x8*)(lds + PG8_SA(b, h) + aoff + m * 2048 + k * 1024); } while (0)
#define PG8_LDB(dst, b, h) do { _Pragma("unroll") for (int n = 0; n < 2; ++n) _Pragma("unroll") for (int k = 0; k < 2; ++k) dst[n][k] = *(const PG8_LAS bf16x8*)(lds + PG8_SB(b, h) + boff + n * 2048 + k * 1024); } while (0)
#define PG8_MMA(ai, bj, At, Bt) do { __builtin_amdgcn_s_setprio(1); _Pragma("unroll") for (int m = 0; m < 4; ++m) _Pragma("unroll") for (int n = 0; n < 2; ++n) _Pragma("unroll") for (int k = 0; k < 2; ++k) \
        acc[ai][bj][m][n] = __builtin_amdgcn_mfma_f32_16x16x32_bf16(Bt[n][k], At[m][k], acc[ai][bj][m][n], 0, 0, 0); __builtin_amdgcn_s_setprio(0); } while (0)
#define PG8_WAIT_V(n) asm volatile("s_waitcnt vmcnt(" #n ")" ::: "memory")
#define PG8_WAIT_L(n) asm volatile("s_waitcnt lgkmcnt(" #n ")" ::: "memory")
#define PG8_BAR __builtin_amdgcn_s_barrier()
#define PG8_SCHED __builtin_amdgcn_sched_barrier(0)
    Unit cur, nxt; int ui = 0;
    if (!S.next(0, cur)) return;
    f32x4 acc[2][2][4][2];
    float zf_ = 0.f; asm volatile("" : "+v"(zf_));
#pragma unroll
    for (int a = 0; a < 2; ++a)
#pragma unroll
        for (int b = 0; b < 2; ++b)
#pragma unroll
            for (int m = 0; m < 4; ++m)
#pragma unroll
                for (int n = 0; n < 2; ++n) acc[a][b][m][n] = (f32x4){zf_, zf_, zf_, zf_};
    bf16x8 At[4][2], B0[2][2], B1[2][2];
    const char* cA = (const char*)g.A + (size_t)cur.pm * tstep + (size_t)cur.koff * 2; const char* cB = (const char*)g.Bt + (size_t)cur.pn * tstep + (size_t)cur.koff * 2;
    S.a_ready(cur);
    if constexpr (SP2) {
        PG8_STAGE(PG8_SB(0, 0), cB, voffB); PG8_STAGE(PG8_SB(0, 1), cB + hstep, voffB); PG8_STAGE(PG8_SA(0, 0), cA, voffA); PG8_STAGE(PG8_SA(0, 1), cA + hstep, voffA);
        if (wr == 1) PG8_BAR;
        PG8_WAIT_V(2); PG8_BAR;
        PG8_STAGE(PG8_SB(1, 0), cB + kstep, voffB); PG8_STAGE(PG8_SA(1, 0), cA + kstep, voffA); PG8_STAGE(PG8_SB(1, 1), cB + hstep + kstep, voffB);
        PG8_WAIT_V(6); PG8_BAR;
    } else {
        PG8_STAGE(PG8_SB(0, 0), cB, voffB); PG8_STAGE(PG8_SA(0, 0), cA, voffA); PG8_STAGE(PG8_SB(0, 1), cB + hstep, voffB); PG8_STAGE(PG8_SA(0, 1), cA + hstep, voffA);
        if (wr == 1) PG8_BAR;
        PG8_WAIT_V(4); PG8_BAR;
        PG8_STAGE(PG8_SB(1, 0), cB + kstep, voffB); PG8_STAGE(PG8_SA(1, 0), cA + kstep, voffA); PG8_STAGE(PG8_SB(1, 1), cB + hstep + kstep, voffB);
        PG8_WAIT_V(6); PG8_BAR;
    }
    for (;;) {
        const bool has_next = S.next(ui + 1, nxt);
        const char* nA = has_next ? (const char*)g.A + (size_t)nxt.pm * tstep + (size_t)nxt.koff * 2 : cA; const char* nB = has_next ? (const char*)g.Bt + (size_t)nxt.pn * tstep + (size_t)nxt.koff * 2 : cB;
        for (int t = 0; t < nt; t += 2) {
            const bool last = (t == nt - 2);
            const char* a1 = cA + (size_t)(t + 1) * kstep;
            const char* a2 = last ? nA : cA + (size_t)(t + 2) * kstep; const char* b2 = last ? nB : cB + (size_t)(t + 2) * kstep;
            const char* a3 = a2 + kstep; const char* b3 = b2 + kstep;
            if (last && has_next) S.a_ready(nxt);
            if constexpr (SP2) {
            PG8_LDB(B0, 0, 0); PG8_LDB(B1, 0, 1); PG8_SCHED; PG8_LDA(At, 0, 0); PG8_STAGE(PG8_SA(1, 1), a1 + hstep, voffA);
            PG8_WAIT_V(8); PG8_WAIT_L(0); PG8_BAR; PG8_MMA(0, 0, At, B0); PG8_MMA(0, 1, At, B1); PG8_BAR; PG8_SCHED;
            PG8_LDA(At, 0, 1); PG8_STAGE(PG8_SB(0, 0), b2, voffB); PG8_STAGE(PG8_SB(0, 1), b2 + hstep, voffB); PG8_STAGE(PG8_SA(0, 0), a2, voffA);
            PG8_WAIT_V(8); PG8_WAIT_L(0); PG8_BAR; PG8_MMA(1, 0, At, B0); PG8_MMA(1, 1, At, B1); PG8_BAR; PG8_SCHED;
            PG8_LDB(B0, 1, 0); PG8_LDB(B1, 1, 1); PG8_SCHED; PG8_LDA(At, 1, 0); PG8_STAGE(PG8_SA(0, 1), a2 + hstep, voffA);
            PG8_WAIT_V(8); PG8_WAIT_L(0); PG8_BAR; PG8_MMA(0, 0, At, B0); PG8_MMA(0, 1, At, B1); PG8_BAR; PG8_SCHED;
            PG8_LDA(At, 1, 1); PG8_STAGE(PG8_SB(1, 0), b3, voffB); PG8_STAGE(PG8_SB(1, 1), b3 + hstep, voffB); PG8_STAGE(PG8_SA(1, 0), a3, voffA);
            PG8_WAIT_V(8); PG8_WAIT_L(0); PG8_BAR; PG8_MMA(1, 0, At, B0); PG8_MMA(1, 1, At, B1); PG8_BAR; PG8_SCHED;
            } else {
            PG8_LDB(B0, 0, 0); PG8_SCHED; PG8_LDA(At, 0, 0); PG8_STAGE(PG8_SA(1, 1), a1 + hstep, voffA);
            PG8_WAIT_L(8); PG8_BAR; PG8_WAIT_L(0); PG8_MMA(0, 0, At, B0); PG8_BAR; PG8_SCHED;
            PG8_LDB(B1, 0, 1); PG8_STAGE(PG8_SB(0, 0), b2, voffB);
            PG8_BAR; PG8_WAIT_L(0); PG8_MMA(0, 1, At, B1); PG8_BAR;
            PG8_LDA(At, 0, 1); PG8_STAGE(PG8_SA(0, 0), a2, voffA);
            PG8_BAR; PG8_WAIT_L(0); PG8_MMA(1, 0, At, B0); PG8_BAR; PG8_SCHED;
            PG8_STAGE(PG8_SB(0, 1), b2 + hstep, voffB);
            PG8_WAIT_V(6); PG8_BAR; PG8_MMA(1, 1, At, B1); PG8_BAR;
            PG8_LDB(B0, 1, 0); PG8_SCHED; PG8_LDA(At, 1, 0); PG8_STAGE(PG8_SA(0, 1), a2 + hstep, voffA);
            PG8_WAIT_L(8); PG8_BAR; PG8_WAIT_L(0); PG8_MMA(0, 0, At, B0); PG8_BAR; PG8_SCHED;
            PG8_LDB(B1, 1, 1); PG8_STAGE(PG8_SB(1, 0), b3, voffB);
            PG8_BAR; PG8_WAIT_L(0); PG8_MMA(0, 1, At, B1); PG8_BAR;
            PG8_LDA(At, 1, 1); PG8_STAGE(PG8_SA(1, 0), a3, voffA);
            PG8_BAR; PG8_WAIT_L(0); PG8_MMA(1, 0, At, B0); PG8_BAR; PG8_SCHED;
            PG8_STAGE(PG8_SB(1, 1), b3 + hstep, voffB);
            PG8_WAIT_V(6); PG8_BAR; PG8_MMA(1, 1, At, B1); PG8_BAR;
            }
        }
        if constexpr (ALIGN_EPI) { if (wr == 0) PG8_BAR; }
        if constexpr (!Epi::AFTER_DRAIN) { const int ln_ = lane_fresh(); const int fr_ = ln_ & 15, fq_ = ln_ >> 4;
            E(acc, cur, wr, wc, fr_, fq_); S.done(cur); }
        if (!has_next) break;
        float zg_ = 0.f; asm volatile("" : "+v"(zg_));
#pragma unroll
        for (int a = 0; a < 2; ++a)
#pragma unroll
            for (int b = 0; b < 2; ++b)
#pragma unroll
                for (int m = 0; m < 4; ++m)
#pragma unroll
                    for (int n = 0; n < 2; ++n) acc[a][b][m][n] = (f32x4){zg_, zg_, zg_, zg_};
        cur = nxt; cA = nA; cB = nB; ++ui;
        if constexpr (ALIGN_EPI) { if (wr == 1) PG8_BAR; }
    }
    PG8_WAIT_V(0);
    if constexpr (!ALIGN_EPI) { if (wr == 0) PG8_BAR; }
    PG8_BAR;
    if constexpr (Epi::AFTER_DRAIN) { E.fused(acc, cur, wr, wc, fr, fq, lds, wid, lane); S.done(cur); }
#undef PG8_SA
#undef PG8_SB
#undef PG8_STAGE
#undef PG8_LDA
#undef PG8_LDB
#undef PG8_MMA
#undef PG8_WAIT_V
#undef PG8_WAIT_L
#undef PG8_BAR
#undef PG8_SCHED
}
}
#define GAS __attribute__((address_space(1)))
#define LAS __attribute__((address_space(3)))
typedef unsigned short bf16;
typedef unsigned v4u __attribute__((ext_vector_type(4)));
typedef float f32x4 __attribute__((ext_vector_type(4)));
typedef short bf16x8 __attribute__((ext_vector_type(8)));
typedef GAS unsigned gu32;
typedef GAS unsigned long long gu64;
#define RLX_AGENT __ATOMIC_RELAXED, __HIP_MEMORY_SCOPE_AGENT
#define LDS_WAIT() asm volatile("s_waitcnt lgkmcnt(0)" ::: "memory")
#define VM_WAIT() asm volatile("s_waitcnt vmcnt(0)" ::: "memory")
__device__ __forceinline__ unsigned long long rt() { return __builtin_amdgcn_s_memrealtime(); }
__device__ __forceinline__ unsigned f2bf(float f) { unsigned u = __builtin_bit_cast(unsigned, f); return (u + 0x7fffu + ((u >> 16) & 1u)) >> 16; }
__device__ __forceinline__ unsigned pk2(float lo, float hi) { return f2bf(lo) | (f2bf(hi) << 16); }

#define XB_TMO      128
#define XB_XCNT(j)  (256  + 64 * (j))
#define XB_XSUB(j)  (1280 + 64 * (j))
#define XB_XGEN(j)  (2304 + 64 * (j))
#define XB_TOP      3328
#define XB_TOPGEN   3392
#define XCD_BAR_WORDS 3456
#define XB_SPIN_CAP (1u << 18)

__device__ __forceinline__ unsigned xb_ld(unsigned* p)              { return __hip_atomic_load(p, __ATOMIC_RELAXED, __HIP_MEMORY_SCOPE_AGENT); }
__device__ __forceinline__ unsigned xb_add(unsigned* p, unsigned v) { return __hip_atomic_fetch_add(p, v, __ATOMIC_RELAXED, __HIP_MEMORY_SCOPE_AGENT); }
__device__ __forceinline__ unsigned xb_xcc_id() { return (unsigned)__builtin_amdgcn_s_getreg((3 << 11) | 20) & 0xFu; }
#define XB_SPIN(cond, bar) do { unsigned _sp = 0; while (cond) { __builtin_amdgcn_s_sleep(1); \
    if ((++_sp & 255u) == 0u) { if (xb_ld(&(bar)[XB_TMO])) break; if (_sp > XB_SPIN_CAP) { atomicAdd(&(bar)[XB_TMO], 1u); break; } } } } while (0)

struct XcdBarrier {
    unsigned* bar; unsigned x;
    volatile LAS unsigned* st;
};

__device__ __forceinline__ XcdBarrier xcd_barrier_post(unsigned* bar, volatile LAS unsigned* st, const bool is_t0) {
    XcdBarrier b; b.bar = bar; b.x = xb_xcc_id(); b.st = st;
    if (is_t0) (void)xb_add(&bar[XB_XCNT(b.x)], 1u);
    return b;
}
__device__ __forceinline__ void xcd_barrier_complete(unsigned* bar, unsigned x, unsigned& nloc, unsigned& nx) {
    const unsigned G = gridDim.x * gridDim.y * gridDim.z;
    unsigned sum, cnt, mine, sp = 0u;
    for (;;) {
        sum = 0u; cnt = 0u; mine = 0u;
#pragma unroll
        for (unsigned j = 0; j < 16; ++j) { const unsigned c = xb_ld(&bar[XB_XCNT(j)]); sum += c; cnt += (c > 0u) ? 1u : 0u; mine = (j == x) ? c : mine; }
        if (sum == G) break;
        __builtin_amdgcn_s_sleep(1);
        if ((++sp & 255u) == 0u) { if (xb_ld(&bar[XB_TMO])) break; if (sp > XB_SPIN_CAP) { atomicAdd(&bar[XB_TMO], 1u); break; } }
    }
    nloc = mine > 0u ? mine : 1u; nx = cnt > 0u ? cnt : 1u;
}

__device__ __forceinline__ void xcd_barrier(const XcdBarrier& b, const bool is_t0) {
    asm volatile("s_waitcnt vmcnt(0)" ::: "memory");
    __syncthreads();
    if (is_t0) {
        unsigned* bar = b.bar;
        __builtin_amdgcn_s_waitcnt(0);
        unsigned nloc = b.st[0], nx = b.st[1];
        if (nloc == 0u) { xcd_barrier_complete(bar, b.x, nloc, nx); b.st[0] = nloc; b.st[1] = nx; }
        const unsigned old = xb_add(&bar[XB_XSUB(b.x)], 1u);
        const unsigned gen = old / nloc;
        if (old + 1u == (gen + 1u) * nloc) {
            __builtin_amdgcn_fence(__ATOMIC_RELEASE, "agent");
            asm volatile("s_waitcnt vmcnt(0)" ::: "memory");
            const unsigned og = xb_add(&bar[XB_TOP], 1u);
            const unsigned tg = og / nx;
            if (og + 1u == (tg + 1u) * nx) xb_add(&bar[XB_TOPGEN], 1u);
            else XB_SPIN(xb_ld(&bar[XB_TOPGEN]) == tg, bar);
            __builtin_amdgcn_fence(__ATOMIC_ACQUIRE, "agent");
            xb_add(&bar[XB_XGEN(b.x)], 1u);
            asm volatile("s_waitcnt vmcnt(0)" ::: "memory");
        } else {
            XB_SPIN(xb_ld(&bar[XB_XGEN(b.x)]) == gen, bar);
            __builtin_amdgcn_fence(__ATOMIC_ACQUIRE, "agent");
            asm volatile("s_waitcnt vmcnt(0)" ::: "memory");
        }
    }
    __syncthreads();
}

constexpr size_t MiB = 1u << 20;
constexpr size_t WS_CTL = 0, CTL_ZERO_BYTES = 64 * 1024;
constexpr int CW_BAR = 1024;
constexpr int CW_Q = 8192;
constexpr size_t WS_COS = 1 * MiB;
constexpr size_t WS_SIN = WS_COS + 512 * 1024;
constexpr size_t WS_WIN  = 2 * MiB;
constexpr size_t WS_WOC  = WS_WIN + 16 * MiB;
constexpr size_t WS_WA0  = WS_WOC + 4 * MiB;
constexpr size_t WS_WA1  = WS_WA0 + 4 * MiB;
constexpr size_t WS_WUKV = WS_WA1 + 3 * MiB;
constexpr size_t WS_WUQ  = WS_WUKV + 1 * MiB;
constexpr size_t WS_WOM  = WS_WUQ + 3 * MiB;
constexpr size_t WS_WUKB = WS_WOM + 4 * MiB;
constexpr size_t WS_ACT  = 40 * MiB;
constexpr size_t SZ_F32R = (size_t)NROWS * 1024 * 4, SZ_BFR = (size_t)NROWS * 1024 * 2;
constexpr size_t WS_X    = WS_ACT;
constexpr size_t WS_XH   = WS_X + SZ_F32R;
constexpr size_t WS_V1   = WS_XH + SZ_BFR;
constexpr size_t WS_GZ   = WS_V1 + SZ_BFR;
constexpr size_t WS_G    = WS_GZ + SZ_BFR;
constexpr size_t WS_MB   = WS_G + SZ_BFR;
constexpr size_t WS_CKR  = WS_MB + SZ_BFR;
constexpr size_t WS_CB   = WS_CKR + (size_t)NROWS * 512 * 4;
constexpr size_t WS_KRB  = WS_CB + (size_t)NROWS * 256 * 2;
constexpr size_t WS_KN   = WS_KRB + (size_t)NROWS * 32 * 2;
constexpr size_t WS_VV   = WS_KN + SZ_BFR;
constexpr size_t WS_QL   = WS_VV + SZ_BFR;
constexpr size_t WS_SSQ  = WS_QL + (size_t)NROWS * 512 * 2;
constexpr size_t WS_SZ   = WS_SSQ + (size_t)NROWS * 8 * 4;
constexpr size_t WS_QN   = WS_SZ + SZ_BFR;
constexpr size_t WS_QR   = WS_QN + SZ_BFR;
constexpr size_t WS_OG   = WS_QR + (size_t)NROWS * 512 * 2;
constexpr size_t WS_PART = WS_OG + SZ_BFR;
constexpr size_t WS_PML  = WS_PART + (size_t)DECB * 4 * 64 * 256 * 4;
constexpr size_t WS_QABS = WS_PML + (size_t)DECB * 4 * 2 * 64 * 4;
constexpr int GOUT_SPLITK = 8;
constexpr size_t WS_PARTG = WS_QABS + (size_t)DECB * 64 * 288 * 2;
constexpr size_t WS_END  = WS_PARTG + (size_t)GOUT_SPLITK * 768 * 1024 * 4;
static_assert(WS_WUKB + 1 * MiB <= WS_ACT && WS_END < 1024 * MiB, "d_ws map");

constexpr size_t O_YP = 0, O_YS = O_YP + (size_t)NB * SEQ * DM, O_CKP = O_YS + (size_t)NSAMP * DM, O_KRP = O_CKP + (size_t)NB * TTOT * KVL,
                 O_CVP = O_KRP + (size_t)NB * TTOT * QKR, O_CKS = O_CVP + (size_t)2 * NB * 2 * DM, O_KRS = O_CKS + (size_t)NSAMP * KVL,
                 O_CVS = O_KRS + (size_t)NSAMP * QKR, O_END = O_CVS + (size_t)2 * DECB * 2 * DM;

#ifndef TAIL_CONV
#define TAIL_CONV 1
#endif
constexpr size_t WS_RS = WS_XH;
constexpr int RING_BYTES = 131072;
constexpr int LDS_BYTES = 163840;
constexpr int LDSCTL_OFF = LDS_BYTES - 64;
constexpr int NWAVES = 8;

struct Args {
    const float* x_prompt; const float* x_sample; const float* cache_ckv; const float* cache_krope; const float* state_conv; const int* page_table;
    const float* meta; const float* pre_g; const float* post_g; const float* w_in_conv; const float* conv_w; const float* w_out_conv;
    const float* kv_norm_g; const float* w_dkv; const float* kv_lat_g; const float* w_uk; const float* w_uv; const float* w_in_mla;
    const float* q_norm_g; const float* w_uq; const float* w_out_mla;
    float* out; unsigned char* ws;
};

typedef unsigned short bf16;
typedef short bf16x8 __attribute__((ext_vector_type(8)));
typedef float f32x4 __attribute__((ext_vector_type(4)));
typedef float f32x8 __attribute__((ext_vector_type(8)));
typedef float f32x16 __attribute__((ext_vector_type(16)));
typedef unsigned u32x4 __attribute__((ext_vector_type(4)));
typedef unsigned u32x2 __attribute__((ext_vector_type(2)));
typedef short s16x4 __attribute__((ext_vector_type(4)));
#define LDS_WAIT() asm volatile("s_waitcnt lgkmcnt(0)" ::: "memory")
#define VM_WAIT() asm volatile("s_waitcnt vmcnt(0)" ::: "memory")
#define SBAR() __builtin_amdgcn_sched_barrier(0)
typedef float f32x2_t __attribute__((ext_vector_type(2))); typedef __bf16 bf16x2_t __attribute__((ext_vector_type(2)));
__device__ __forceinline__ unsigned cvtpk(float lo, float hi) { f32x2_t v = {lo, hi}; bf16x2_t b = __builtin_convertvector(v, bf16x2_t); return __builtin_bit_cast(unsigned, b); }
__device__ __forceinline__ float bf2f(unsigned short b) { return __uint_as_float((unsigned)b << 16); }
__device__ __forceinline__ float bflo(unsigned w) { return __uint_as_float(w << 16); }
__device__ __forceinline__ float bfhi(unsigned w) { return __uint_as_float(w & 0xffff0000u); }
__device__ __forceinline__ float wave_sum(float v, int lane) {
#pragma unroll
    for (int o = 1; o < 64; o <<= 1) v += shfl_xor_f(v, o, lane);
    return v;
}

template <class DestRow>
__device__ __forceinline__ void transpose_item(const float* __restrict__ W, int K, int N, const float* __restrict__ gain, bf16* WT, const DestRow& dest, LAS float* scr, int item, int lane) {
    const int nblk = N / 32, kb = item / nblk, nb = item % nblk, k0 = 64 * kb, n0 = 32 * nb;
#pragma unroll 8
    for (int i = 0; i < 32; ++i) { const int kk = 2 * i + (lane >> 5); float w = W[(size_t)(k0 + kk) * N + n0 + (lane & 31)]; if (gain) w *= gain[k0 + kk]; scr[kk * 33 + (lane & 31)] = w; }
    LDS_WAIT(); asm volatile("" ::: "memory");
    const int c = lane & 7;
#pragma unroll
    for (int j = 0; j < 4; ++j) { const int n = (lane >> 3) + 8 * j; const LAS float* s = scr + (8 * c) * 33 + n;
        u32x4 o; o.x = cvtpk(s[0 * 33], s[1 * 33]); o.y = cvtpk(s[2 * 33], s[3 * 33]); o.z = cvtpk(s[4 * 33], s[5 * 33]); o.w = cvtpk(s[6 * 33], s[7 * 33]);
        *(u32x4*)(WT + (size_t)dest(n0 + n) * K + k0 + 8 * c) = o; }
    LDS_WAIT(); asm volatile("" ::: "memory");
}
struct DestIdent { int off; __device__ __forceinline__ int operator()(int n) const { return off + n; } };
struct DestConvIn {
    __device__ __forceinline__ int operator()(int n) const { const int p = n >> 10, ch = n & 1023, cl = ch & 63; return (ch >> 6) * 256 + (p >> 1) * 128 + (cl >> 4) * 32 + ((cl >> 2) & 3) * 8 + (p & 1) * 4 + (cl & 3); } };
struct DestUq {
    __device__ __forceinline__ int operator()(int n) const { const int h = n / 96, t = n - h * 96; if (t < 64) return h * 64 + t; const int el = t - 64, i = el & 15;
        return 1024 + (h >> 3) * 256 + ((h & 7) >> 2) * 128 + (h & 3) * 32 + (i >> 2) * 8 + (el >> 4) * 4 + (i & 3); } };

__device__ __forceinline__ void x_row_store(const f32x4 (&v)[4], bf16* xrow, float* rs, int lane) {
    float s = 0.f;
#pragma unroll
    for (int j = 0; j < 4; ++j) s += (v[j].x * v[j].x + v[j].y * v[j].y) + (v[j].z * v[j].z + v[j].w * v[j].w);
    const float r = 1.0f / sqrtf(wave_sum(s, lane) * (1.0f / 1024.0f) + RMS_EPS);
    u32x2* o8 = (u32x2*)xrow + lane;
#pragma unroll
    for (int j = 0; j < 4; ++j) { u32x2 w; w.x = cvtpk(v[j].x, v[j].y); w.y = cvtpk(v[j].z, v[j].w); o8[64 * j] = w; }
    if (lane == 0) *rs = r;
}

template <class DestRow>
__device__ __forceinline__ void transpose_item64(const float* __restrict__ W, int K, int N, const float* __restrict__ gain, bf16* WT, const DestRow& dest, LAS float* scr, int item, int lane) {
    const int nblk = N / 64, kb = item / nblk, nb = item % nblk, k0 = 64 * kb, n0 = 64 * nb;
    float wv[64];
#pragma unroll
    for (int i = 0; i < 64; ++i) wv[i] = W[(size_t)(k0 + i) * N + n0 + lane];
#pragma unroll
    for (int i = 0; i < 64; ++i) { float w = wv[i]; if (gain) w *= gain[k0 + i]; scr[i * 65 + lane] = w; }
    LDS_WAIT(); asm volatile("" ::: "memory");
#pragma unroll
    for (int jj = 0; jj < 8; ++jj) { const int p = lane + 64 * jj, n = p >> 3, c = p & 7; const LAS float* s = scr + (8 * c) * 65 + n;
        u32x4 o; o.x = cvtpk(s[0 * 65], s[1 * 65]); o.y = cvtpk(s[2 * 65], s[3 * 65]); o.z = cvtpk(s[4 * 65], s[5 * 65]); o.w = cvtpk(s[6 * 65], s[7 * 65]);
        *(u32x4*)(WT + (size_t)dest(n0 + n) * K + k0 + 8 * c) = o; }
    LDS_WAIT(); asm volatile("" ::: "memory");
}
__device__ __forceinline__ void convert_set(const Args& A, const int set, LAS unsigned char* lds, int iw, int nw, int wave, int lane) {
    unsigned char* ws = A.ws;
    LAS float* scr = (LAS float*)(lds + wave * 16640);
    constexpr int I_WIN = 16 * 64, I_SQ = 16 * 16, I_DKV = (1024 / 64) * (288 / 32), I_INM = 16 * 24, I_UKV = 4 * 16, I_UQ = 8 * 24;
    if (set == 0 || set == 1) { const int l = set;
        for (int it = iw; it < I_WIN + I_SQ; it += nw) {
            if (it < I_WIN) transpose_item64(A.w_in_conv + (size_t)l * 1024 * 4096, 1024, 4096, A.pre_g + l * 1024, (bf16*)(ws + WS_WIN) + (size_t)l * 4096 * 1024, DestConvIn{}, scr, it, lane);
            else transpose_item64(A.w_out_conv + (size_t)l * 1024 * 1024, 1024, 1024, nullptr, (bf16*)(ws + WS_WOC) + (size_t)l * 1024 * 1024, DestIdent{0}, scr, it - I_WIN, lane); }
    } else if (set == 2) {
        for (int it = iw; it < I_DKV + 2 * I_INM; it += nw) {
            if (it < I_DKV) transpose_item(A.w_dkv, 1024, 288, A.kv_norm_g, (bf16*)(ws + WS_WA0), DestIdent{0}, scr, it, lane);
            else { const int r = it - I_DKV, j = r / I_INM; transpose_item64(A.w_in_mla + (size_t)j * 1024 * 1536, 1024, 1536, A.pre_g + (2 + j) * 1024, (bf16*)(ws + (j ? WS_WA1 : WS_WA0)), DestIdent{j ? 0 : 512}, scr, r % I_INM, lane); } }
        { unsigned z_ = 0u; asm volatile("" : "+v"(z_));
          for (int i = iw * 64 + lane; i < 224 * 128; i += nw * 64) ((u32x4*)((bf16*)(ws + WS_WA0) + 288 * 1024))[i] = (u32x4){z_, z_, z_, z_}; }
    } else if (set == 3) {
        for (int it = iw; it < 2 * I_UKV + 2 * I_UQ; it += nw) {
            if (it < 2 * I_UKV) { const int j = it / I_UKV; transpose_item64(j ? A.w_uv : A.w_uk, 256, 1024, nullptr, (bf16*)(ws + WS_WUKV), DestIdent{j * 1024}, scr, it % I_UKV, lane); }
            else { const int r = it - 2 * I_UKV, j = r / I_UQ; transpose_item64(A.w_uq + (size_t)j * 512 * 1536, 512, 1536, A.q_norm_g + j * 512, (bf16*)(ws + WS_WUQ) + (size_t)j * 1536 * 512, DestUq{}, scr, r % I_UQ, lane); } }
        for (int i = iw * 64 + lane; i < 256 * 1024 / 8; i += nw * 64) { const f32x4 a = ((const f32x4*)A.w_uk)[2 * i], b = ((const f32x4*)A.w_uk)[2 * i + 1];
            u32x4 w; w.x = cvtpk(a.x, a.y); w.y = cvtpk(a.z, a.w); w.z = cvtpk(b.x, b.y); w.w = cvtpk(b.z, b.w); ((u32x4*)(ws + WS_WUKB))[i] = w; }
    } else {
        for (int it = iw; it < 2 * I_SQ; it += nw) { const int j = it / I_SQ; transpose_item64(A.w_out_mla + (size_t)j * 1024 * 1024, 1024, 1024, nullptr, (bf16*)(ws + WS_WOM) + (size_t)j * 1024 * 1024, DestIdent{0}, scr, it % I_SQ, lane); }
    }
}

__device__ __forceinline__ void p0_prologue(const Args& A, LAS unsigned char* lds, int gw, int NGW, int wave, int lane) {
    unsigned char* ws = A.ws;
    convert_set(A, 0, lds, gw, NGW, wave, lane);
#if !TAIL_CONV
    convert_set(A, 1, lds, gw, NGW, wave, lane); convert_set(A, 2, lds, gw, NGW, wave, lane); convert_set(A, 3, lds, gw, NGW, wave, lane); convert_set(A, 4, lds, gw, NGW, wave, lane);
#endif
    for (int i = gw * 64 + lane; i < NPOS * 16; i += NGW * 64) { const int p = i >> 4, e = i & 15; const float pos = (float)(p < TTOT ? p : PAST + (p - TTOT));
        const float inv = powf(10000.0f, -(float)e / 16.0f); const float ang = pos * inv; ((float*)(ws + WS_COS))[i] = cosf(ang); ((float*)(ws + WS_SIN))[i] = sinf(ang); }
    for (int row0 = gw; row0 < NROWS; row0 += 4 * NGW) {
        f32x4 v[4][4];
#pragma unroll
        for (int k = 0; k < 4; ++k) { const int row = row0 + k * NGW < NROWS ? row0 + k * NGW : row0;
            const float* src = row < NMAIN ? A.x_prompt + (size_t)row * 1024 : (row < META0 ? A.x_sample + (size_t)(row - SAMP0) * 1024 : (row < META0 + NMETA ? A.meta + (size_t)(row - META0) * 1024 : nullptr));
#pragma unroll
            for (int j = 0; j < 4; ++j) v[k][j] = src ? ((const f32x4*)src)[lane + 64 * j] : (f32x4){0.f, 0.f, 0.f, 0.f}; }
#pragma unroll
        for (int k = 0; k < 4; ++k) { const int row = row0 + k * NGW; if (row < NROWS) {
            x_row_store(v[k], (bf16*)(ws + WS_X) + (size_t)row * 1024, (float*)(ws + WS_RS) + row, lane); } }
    }
}

__device__ __forceinline__ void conv_phase(const Args& A, int layer, int gw, int NGW, int lane) {
    unsigned char* ws = A.ws; const bf16* V = (const bf16*)(ws + WS_V1); const bf16* GZ = (const bf16*)(ws + WS_GZ); bf16* G = (bf16*)(ws + WS_G);
    const float* cw = A.conv_w + (size_t)layer * 3 * 1024;
    const int c0 = (gw & 1) * 512 + lane * 8, gr = gw >> 1, NGR = NGW >> 1;
    float w0[8], w1[8], w2[8];
#pragma unroll
    for (int k = 0; k < 2; ++k) { const f32x4 t0 = *(const f32x4*)(cw + c0 + 4 * k), t1 = *(const f32x4*)(cw + 1024 + c0 + 4 * k), t2 = *(const f32x4*)(cw + 2048 + c0 + 4 * k);
#pragma unroll
        for (int e = 0; e < 4; ++e) { w0[4 * k + e] = t0[e]; w1[4 * k + e] = t1[e]; w2[4 * k + e] = t2[e]; } }
    for (int row0 = gr; row0 < NROWS; row0 += 4 * NGR) {
        u32x4 v0[4], gz[4]; float a1[4][8], a2[4][8];
#pragma unroll
        for (int q = 0; q < 4; ++q) { const int row = row0 + q * NGR < NROWS ? row0 + q * NGR : row0;
            int r1, r2; const float* s1 = nullptr; const float* s2 = nullptr;
            if (row < NMAIN) { const int i = row & (SEQ - 1); r1 = i >= 1 ? row - 1 : META0 + 15; r2 = i >= 2 ? row - 2 : META0 + 14 + i; }
            else if (row < META0) { const int s = row - SAMP0, b = s >> 2, l = s & 3; const float* st = A.state_conv + ((size_t)layer * DECB + b) * 2 * 1024;
                if (l >= 1) r1 = row - 1; else { r1 = -2; s1 = st + 1024; }
                if (l >= 2) r2 = row - 2; else { r2 = -2; s2 = st + l * 1024; } }
            else if (row < META0 + NMETA) { const int j = row - META0; r1 = j >= 1 ? row - 1 : -1; r2 = j >= 2 ? row - 2 : -1; }
            else { r1 = -1; r2 = -1; }
            v0[q] = *(const u32x4*)(V + (size_t)row * 1024 + c0); gz[q] = *(const u32x4*)(GZ + (size_t)row * 1024 + c0);
            if (r1 >= 0) { const u32x4 t = *(const u32x4*)(V + (size_t)r1 * 1024 + c0);
#pragma unroll
                for (int k = 0; k < 4; ++k) { a1[q][2 * k] = bflo(t[k]); a1[q][2 * k + 1] = bfhi(t[k]); } }
            else if (r1 == -2) { const f32x4 t0 = *(const f32x4*)(s1 + c0), t1 = *(const f32x4*)(s1 + c0 + 4);
#pragma unroll
                for (int k = 0; k < 4; ++k) { a1[q][k] = t0[k]; a1[q][4 + k] = t1[k]; } }
            else {
#pragma unroll
                for (int k = 0; k < 8; ++k) a1[q][k] = 0.f; }
            if (r2 >= 0) { const u32x4 t = *(const u32x4*)(V + (size_t)r2 * 1024 + c0);
#pragma unroll
                for (int k = 0; k < 4; ++k) { a2[q][2 * k] = bflo(t[k]); a2[q][2 * k + 1] = bfhi(t[k]); } }
            else if (r2 == -2) { const f32x4 t0 = *(const f32x4*)(s2 + c0), t1 = *(const f32x4*)(s2 + c0 + 4);
#pragma unroll
                for (int k = 0; k < 4; ++k) { a2[q][k] = t0[k]; a2[q][4 + k] = t1[k]; } }
            else {
#pragma unroll
                for (int k = 0; k < 8; ++k) a2[q][k] = 0.f; } }
#pragma unroll
        for (int q = 0; q < 4; ++q) { const int row = row0 + q * NGR; if (row < NROWS) {
            float vc[8], gg[8], o[8];
#pragma unroll
            for (int k = 0; k < 4; ++k) { vc[2 * k] = bflo(v0[q][k]); vc[2 * k + 1] = bfhi(v0[q][k]); gg[2 * k] = bflo(gz[q][k]); gg[2 * k + 1] = bfhi(gz[q][k]); }
#pragma unroll
            for (int k = 0; k < 8; ++k) o[k] = gg[k] * (w0[k] * a2[q][k] + w1[k] * a1[q][k] + w2[k] * vc[k]);
            u32x4 w; w.x = cvtpk(o[0], o[1]); w.y = cvtpk(o[2], o[3]); w.z = cvtpk(o[4], o[5]); w.w = cvtpk(o[6], o[7]);
            *(u32x4*)(G + (size_t)row * 1024 + c0) = w;
            float* dst = nullptr;
            if (row < NMAIN) { const int i = row & (SEQ - 1), b = row >> 12; if (i >= SEQ - 2) dst = A.out + O_CVP + (((size_t)layer * NB + b) * 2 + (i - (SEQ - 2))) * 1024; }
            else if (row < META0) { const int s = row - SAMP0, b = s >> 2, l = s & 3; if (l >= 2) dst = A.out + O_CVS + (((size_t)layer * DECB + b) * 2 + (l - 2)) * 1024; }
            if (dst) { *(f32x4*)(dst + c0) = (f32x4){vc[0], vc[1], vc[2], vc[3]}; *(f32x4*)(dst + c0 + 4) = (f32x4){vc[4], vc[5], vc[6], vc[7]}; }
        } }
    }
}

__device__ __forceinline__ void norm_row_finish(const Args& A, int layer, int row, const f32x4 (&m)[4], const u32x2 (&xw)[4], const f32x4 (&g)[4], int lane) {
    unsigned char* ws = A.ws; float s = 0.f;
#pragma unroll
    for (int j = 0; j < 4; ++j) s += (m[j].x * m[j].x + m[j].y * m[j].y) + (m[j].z * m[j].z + m[j].w * m[j].w);
    const float r = 1.0f / sqrtf(wave_sum(s, lane) * (1.0f / 1024.0f) + RMS_EPS);
    f32x4 xn[4];
#pragma unroll
    for (int j = 0; j < 4; ++j) xn[j] = (f32x4){bflo(xw[j].x), bfhi(xw[j].x), bflo(xw[j].y), bfhi(xw[j].y)} + m[j] * r * g[j];
    if (layer == 3) { if (row < META0) {
#pragma unroll
            for (int j = 0; j < 4; ++j) ((f32x4*)(A.out + (size_t)row * 1024))[lane + 64 * j] = xn[j]; } }
    else x_row_store(xn, (bf16*)(ws + WS_X) + (size_t)row * 1024, (float*)(ws + WS_RS) + row, lane);
}
__device__ __forceinline__ void norm_phase(const Args& A, int layer, int gw, int NGW, int lane) {
    unsigned char* ws = A.ws; const bf16* MB = (const bf16*)(ws + WS_MB); const bf16* X = (const bf16*)(ws + WS_X); const float* pg = A.post_g + (size_t)layer * 1024;
    f32x4 g[4];
#pragma unroll
    for (int j = 0; j < 4; ++j) g[j] = ((const f32x4*)pg)[lane + 64 * j];
    for (int row0 = gw; row0 < NMAIN; row0 += 4 * NGW) {
        u32x2 mw[4][4], xw[4][4];
#pragma unroll
        for (int k = 0; k < 4; ++k) { const int row = row0 + k * NGW < NMAIN ? row0 + k * NGW : row0;
#pragma unroll
            for (int j = 0; j < 4; ++j) { mw[k][j] = ((const u32x2*)(MB + (size_t)row * 1024))[lane + 64 * j]; xw[k][j] = ((const u32x2*)(X + (size_t)row * 1024))[lane + 64 * j]; } }
#pragma unroll
        for (int k = 0; k < 4; ++k) { const int row = row0 + k * NGW; if (row < NMAIN) {
            f32x4 m[4];
#pragma unroll
            for (int j = 0; j < 4; ++j) m[j] = (f32x4){bflo(mw[k][j].x), bfhi(mw[k][j].x), bflo(mw[k][j].y), bfhi(mw[k][j].y)};
            norm_row_finish(A, layer, row, m, xw[k], g, lane); } }
    }
    const float* PG = (const float*)(ws + WS_PARTG);
    for (int row = NMAIN + gw; row < NROWS; row += NGW) {
        u32x2 xw[4]; f32x4 m[4];
#pragma unroll
        for (int j = 0; j < 4; ++j) xw[j] = ((const u32x2*)(X + (size_t)row * 1024))[lane + 64 * j];
#pragma unroll
        for (int s2 = 0; s2 < GOUT_SPLITK; s2 += 2) { f32x4 t0[4], t1[4];
#pragma unroll
            for (int j = 0; j < 4; ++j) { t0[j] = ((const f32x4*)(PG + ((size_t)s2 * 768 + (row - NMAIN)) * 1024))[lane + 64 * j]; t1[j] = ((const f32x4*)(PG + ((size_t)(s2 + 1) * 768 + (row - NMAIN)) * 1024))[lane + 64 * j]; }
#pragma unroll
            for (int j = 0; j < 4; ++j) m[j] = s2 == 0 ? t0[j] + t1[j] : m[j] + (t0[j] + t1[j]); }
        norm_row_finish(A, layer, row, m, xw, g, lane);
    }
}

__device__ __forceinline__ void latent_phase(const Args& A, int gw, int NGW, int lane) {
    unsigned char* ws = A.ws; const float* CKR = (const float*)(ws + WS_CKR); bf16* CB = (bf16*)(ws + WS_CB); bf16* KRB = (bf16*)(ws + WS_KRB);
    const float* COS = (const float*)(ws + WS_COS); const float* SIN = (const float*)(ws + WS_SIN);
    const f32x4 g = ((const f32x4*)A.kv_lat_g)[lane];
    for (int row0 = gw; row0 < NROWS; row0 += 4 * NGW) {
        f32x4 cc[4]; float x1[4], x2[4], cs[4], sn[4];
#pragma unroll
        for (int k = 0; k < 4; ++k) { const int row = row0 + k * NGW < NROWS ? row0 + k * NGW : row0; const int pi = pg8::posidx_of_row(row); const int l16 = lane & 15;
            cc[k] = ((const f32x4*)(CKR + (size_t)row * 512))[lane]; x1[k] = CKR[(size_t)row * 512 + 256 + l16]; x2[k] = CKR[(size_t)row * 512 + 272 + l16]; cs[k] = COS[pi * 16 + l16]; sn[k] = SIN[pi * 16 + l16]; }
#pragma unroll
        for (int k = 0; k < 4; ++k) { const int row = row0 + k * NGW; if (row < NROWS) {
            const f32x4 c = cc[k];
            const float r = 1.0f / sqrtf(wave_sum((c.x * c.x + c.y * c.y) + (c.z * c.z + c.w * c.w), lane) * (1.0f / 256.0f) + RMS_EPS);
            const f32x4 cn = c * r * g;
            u32x2 w; w.x = cvtpk(cn.x, cn.y); w.y = cvtpk(cn.z, cn.w); ((u32x2*)(CB + (size_t)row * 256))[lane] = w;
            const float o1 = x1[k] * cs[k] - x2[k] * sn[k], o2 = x1[k] * sn[k] + x2[k] * cs[k];
            if (lane < 16) { KRB[(size_t)row * 32 + lane] = (bf16)(cvtpk(o1, o1) & 0xffffu); KRB[(size_t)row * 32 + 16 + lane] = (bf16)(cvtpk(o2, o2) & 0xffffu); }
            if (row < NMAIN) { const int b = row >> 12, i = row & (SEQ - 1); const size_t t = (size_t)b * TTOT + NMETA + i;
                ((f32x4*)(A.out + O_CKP + t * KVL))[lane] = cn; if (lane < 16) { A.out[O_KRP + t * QKR + lane] = o1; A.out[O_KRP + t * QKR + 16 + lane] = o2; } }
            else if (row < META0) { const size_t t = row - SAMP0; ((f32x4*)(A.out + O_CKS + t * KVL))[lane] = cn; if (lane < 16) { A.out[O_KRS + t * QKR + lane] = o1; A.out[O_KRS + t * QKR + 16 + lane] = o2; } }
            else if (row < META0 + NMETA) { const int j = row - META0;
#pragma unroll
                for (int b = 0; b < NB; ++b) { const size_t t = (size_t)b * TTOT + j; ((f32x4*)(A.out + O_CKP + t * KVL))[lane] = cn; if (lane < 16) { A.out[O_KRP + t * QKR + lane] = o1; A.out[O_KRP + t * QKR + 16 + lane] = o2; } } }
        } }
    }
}

namespace ap {
constexpr int NW = 8, QBLK = 32, KVBLK = 64;
constexpr int SLOTB = 8192;
constexpr int LDS_K = 0, LDS_V = 3 * SLOTB, LDS_R = 6 * SLOTB, OFF_WS = LDS_R + 3 * (SLOTB / 2), LDS_BYTES_AP = OFF_WS + NW * 64 * 4;
constexpr float THR = 8.0f;
typedef __attribute__((address_space(3))) const char* lds_cptr;
typedef short v4i16_t __attribute__((ext_vector_type(4)));
__device__ __forceinline__ int crow(int r, int hi) { return (r & 3) + 8 * (r >> 2) + 4 * hi; }
#define PK4(P, BASE, OUT) do { unsigned a0 = cvtpk(P[BASE + 0], P[BASE + 1]), a1 = cvtpk(P[BASE + 2], P[BASE + 3]);   \
    unsigned b0 = cvtpk(P[BASE + 4], P[BASE + 5]), b1 = cvtpk(P[BASE + 6], P[BASE + 7]);                              \
    auto r0 = __builtin_amdgcn_permlane32_swap(a0, b0, false, false); auto r1 = __builtin_amdgcn_permlane32_swap(a1, b1, false, false); \
    u32x4 w = {r0[0], r1[0], r0[1], r1[1]}; OUT = *reinterpret_cast<bf16x8*>(&w); } while (0)
__device__ __forceinline__ void glds16(const void* sbase, unsigned voff, unsigned lds_base) {
    unsigned sv; asm volatile("s_mov_b32 %0, m0\n\ts_mov_b32 m0, %3\n\ts_nop 0\n\tglobal_load_lds_dwordx4 %1, %2\n\ts_mov_b32 m0, %0" : "=&s"(sv) : "v"(voff), "s"(sbase), "s"(lds_base) : "memory"); }
__device__ __forceinline__ void kload2(bf16x8* kf, lds_cptr kp, int j) { kf[2 * j] = *(const __attribute__((address_space(3))) bf16x8*)(kp + j * 2048); kf[2 * j + 1] = *(const __attribute__((address_space(3))) bf16x8*)(kp + j * 2048 + 512); }
__device__ __forceinline__ s16x4 vtr(lds_cptr p) { return __builtin_bit_cast(s16x4, __builtin_amdgcn_ds_read_tr16_b64_v4i16((__attribute__((address_space(3))) v4i16_t*)p)); }
__device__ __forceinline__ void mask_tile(f32x16& p0, f32x16& p1, int lim, int hi) {
    const int d = lim - 4 * hi;
#pragma unroll
    for (int r = 0; r < 16; ++r) { const int c = (r & 3) + 8 * (r >> 2); if (c > d) p0[r] = -INFINITY; if (c + 32 > d) p1[r] = -INFINITY; }
}
#define MFMA32(a, b, c) __builtin_amdgcn_mfma_f32_32x32x16_bf16(a, b, c, 0, 0, 0)
#define WAIT_BAR(N) asm volatile("s_waitcnt vmcnt(" #N ") lgkmcnt(0)\n\ts_barrier" ::: "memory")
#define PIN(x) asm volatile("" : "+v"(x))
#define MX3(a, b, c) __builtin_fmaxf(__builtin_fmaxf((a), (b)), (c))
__device__ __forceinline__ float rowmax(const f32x16& p0, const f32x16& p1) {
    float a = MX3(p0[0], p0[1], p1[0]), b = MX3(p0[2], p0[3], p1[1]); a = MX3(a, p1[2], p1[3]);
#pragma unroll
    for (int r = 4; r < 16; r += 4) { a = MX3(a, p0[r], p0[r + 1]); b = MX3(b, p0[r + 2], p0[r + 3]); a = MX3(a, p1[r], p1[r + 1]); b = MX3(b, p1[r + 2], p1[r + 3]); }
    float m = __builtin_fmaxf(a, b); auto rr = __builtin_amdgcn_permlane32_swap(__float_as_uint(m), __float_as_uint(m), false, false);
    return __builtin_fmaxf(__uint_as_float(rr[0]), __uint_as_float(rr[1])); }

__device__ __forceinline__ void attn_unit(unsigned char* ws_, int b_, int h_, int qb_, bool meta_, char* lds, const int wave) {
    unsigned char* ws = opaque_global(ws_); int wid = wave; asm volatile("" : "+s"(wid));
    const bf16* __restrict__ QN = (const bf16*)(ws + WS_QN); const bf16* __restrict__ QR = (const bf16*)(ws + WS_QR); const bf16* __restrict__ KN = (const bf16*)(ws + WS_KN);
    const bf16* __restrict__ KRB = (const bf16*)(ws + WS_KRB); const bf16* __restrict__ VV = (const bf16*)(ws + WS_VV);
    const int b = __builtin_amdgcn_readfirstlane(b_), h = __builtin_amdgcn_readfirstlane(h_), qb = __builtin_amdgcn_readfirstlane(qb_); const bool meta = __builtin_amdgcn_readfirstlane((int)meta_) != 0;
    const int lane = lane_fresh(), r32 = lane & 31, hi = lane >> 5;
    const unsigned lds0 = (unsigned)(uintptr_t)lds; const lds_cptr lds3 = (lds_cptr)lds;
    float* wsf = (float*)(lds + OFF_WS) + wid * 64;
    const int qrow0 = meta ? META0 : b * SEQ + qb * 256;
    const int NT = meta ? 1 : 4 * qb + 5;
    const int qrel = wid * QBLK + r32;
    const size_t krow1 = (size_t)b * SEQ;
    const bf16* ksrc = KN + krow1 * 1024 + h * 64 + wid * 8;
    const bf16* rsrc = KRB + krow1 * 32 + (wid & 3) * 8;
    const bf16* vsrc = VV + (krow1 + 16 * (wid & 3)) * 1024 + h * 64 + (wid >> 2) * 32;
    const unsigned kdst = lds0 + LDS_K + wid * 1024, vdst = lds0 + LDS_V + wid * 1024, rdst = lds0 + LDS_R + (wid & 3) * 1024;
#define KOFF ((unsigned)lane * 2048u)
#define ROFF ((unsigned)lane * 64u)
#define VOFF ((unsigned)(lane >> 2) * 2048u + (unsigned)(lane & 3) * 16u)
#define RFL(x) ((unsigned)__builtin_amdgcn_readfirstlane((int)(x)))
#define DMA_K(t, slot) glds16(ksrc + (long)((t) - 1) * (KVBLK * 1024), KOFF, RFL(kdst + (slot)))
#define DMA_V(t, slot) glds16(vsrc + (long)((t) - 1) * (KVBLK * 1024), VOFF, RFL(vdst + (slot)))
#define DMA_R(t, slot) do { if (wid < 4) glds16(rsrc + (long)((t) - 1) * (KVBLK * 32), ROFF, RFL(rdst + ((slot) >> 1))); } while (0)
#define WAITB(a, b) do { if (wid < 4) { WAIT_BAR(a); } else { WAIT_BAR(b); } } while (0)
    const lds_cptr kp0 = lds3 + LDS_K + hi * 1024 + r32 * 16, rp0 = lds3 + LDS_R + hi * 1024 + r32 * 16;
    const lds_cptr vp0 = lds3 + LDS_V + ((lane >> 4) & 1) * 32 + (lane & 3) * 8 + (4 * hi + ((lane & 15) >> 2)) * 64;
    glds16(KN + (size_t)META0 * 1024 + h * 64 + wid * 8, KOFF, RFL(kdst));
    if (wid < 4) glds16(KRB + (size_t)META0 * 32 + (wid & 3) * 8, ROFF, RFL(rdst));
    glds16(VV + ((size_t)META0 + 16 * (wid & 3)) * 1024 + h * 64 + (wid >> 2) * 32, VOFF, RFL(vdst));
    if (NT > 1) { DMA_K(1, SLOTB); DMA_R(1, SLOTB); }
    bf16x8 qr[6];
    { const size_t qrow = (size_t)(qrow0 + wid * QBLK + r32);
#pragma unroll
      for (int d0 = 0; d0 < 4; ++d0) qr[d0] = *reinterpret_cast<const bf16x8*>(QN + qrow * 1024 + h * 64 + d0 * 16 + hi * 8);
#pragma unroll
      for (int d0 = 0; d0 < 2; ++d0) qr[4 + d0] = *reinterpret_cast<const bf16x8*>(QR + qrow * 512 + h * 32 + d0 * 16 + hi * 8); }
    float mhat = 0.f, l_reg = 0.f; f32x16 o[2]; o[0] = f32x16{}; o[1] = f32x16{}; f32x16 negm = f32x16{}; PIN(negm);
    bool resc = false;
    f32x16 pA0, pA1, pB0, pB1; bf16x8 kf[8], kr[4]; s16x4 vlo[8], vhi[8]; u32x4 pw0, pw1, pw2, pw3;
    int sl_prev = 0, sl_cur = 0, sl_next = SLOTB;
#define ROT() do { sl_prev = sl_cur; sl_cur = sl_next; sl_next = (sl_next == 2 * SLOTB) ? 0 : sl_next + SLOTB; } while (0)
#define RESC() do { if (resc) { asm volatile("s_waitcnt lgkmcnt(0)" ::: "memory"); _Pragma("unroll") for (int d_ = 0; d_ < 2; ++d_) _Pragma("unroll") for (int r = 0; r < 16; ++r) o[d_][r] *= wsf[crow(r, hi)]; } } while (0)
    if (NT > 1) { DMA_K(2, 2 * SLOTB); WAITB(4, 3); } else { WAIT_BAR(0); }
    _Pragma("unroll") for (int j = 0; j < 4; ++j) kload2(kf, kp0, j);
    _Pragma("unroll") for (int j = 0; j < 2; ++j) kload2(kr, rp0, j);
    pA0 = MFMA32(kf[0], qr[0], negm); pA1 = MFMA32(kf[1], qr[0], negm); pA0 = MFMA32(kf[2], qr[1], pA0); pA1 = MFMA32(kf[3], qr[1], pA1);
    pA0 = MFMA32(kf[4], qr[2], pA0); pA1 = MFMA32(kf[5], qr[2], pA1); pA0 = MFMA32(kf[6], qr[3], pA0); pA1 = MFMA32(kf[7], qr[3], pA1);
    pA0 = MFMA32(kr[0], qr[4], pA0); pA1 = MFMA32(kr[1], qr[4], pA1); pA0 = MFMA32(kr[2], qr[5], pA0); pA1 = MFMA32(kr[3], qr[5], pA1);
    mask_tile(pA0, pA1, meta ? (qrel < 15 ? qrel : 15) : 15, hi);
    { const float rm = rowmax(pA0, pA1); mhat = rm;
#pragma unroll
      for (int r = 0; r < 16; ++r) { pA0[r] -= rm; pA1[r] -= rm; }
#pragma unroll
      for (int r = 0; r < 16; ++r) negm[r] = -mhat;
      PIN(negm);
#pragma unroll
      for (int r = 0; r < 16; ++r) { pA0[r] = __builtin_amdgcn_exp2f(pA0[r]); pA1[r] = __builtin_amdgcn_exp2f(pA1[r]); } }
    WAIT_BAR(0);
    if (NT > 1) {
        DMA_K(3, 0); DMA_R(2, 2 * SLOTB); DMA_V(1, SLOTB); ROT();
        _Pragma("unroll") for (int j = 0; j < 4; ++j) kload2(kf, kp0 + sl_cur, j);
        WAITB(3, 2);
    }
#define PKW(P, i) cvtpk(P[i], P[i + 1])
#define PAF(k) __builtin_bit_cast(bf16x8, pw##k)
#define VFR(i) (bf16x8){vlo[i][0], vlo[i][1], vlo[i][2], vlo[i][3], vhi[i][0], vhi[i][1], vhi[i][2], vhi[i][3]}
#define VRD(i) do { vlo[i] = vtr(vp_ + (((i) >> 2) * 4096 + ((i) & 3) * 1024)); vhi[i] = vtr(vp_ + (((i) >> 2) * 4096 + ((i) & 3) * 1024 + 512)); } while (0)
#define KRD(G, j) do { if (G) { kload2(kf, kp0 + sl_next, j); SBAR(); } } while (0)
#define GAPA(MF, a0, a1, a2, a3, W0, W1, PW) do { MF; sacc += a0; sacc += a1; sacc += a2; sacc += a3; PIN(sacc); W0; W1; PIN(PW); SBAR(); } while (0)
#define GAPR(MF) do { MF; SBAR(); } while (0)
#define EX(v) __builtin_amdgcn_exp2f(v)
#define GAPB(MF, X, i) do { MF; X[i] = EX(X[i]); X[i + 1] = EX(X[i + 1]); X[i + 2] = EX(X[i + 2]); X[i + 3] = EX(X[i + 3]); PIN(X); SBAR(); } while (0)
#define STEP(C0, C1, P0, P1, t, MSK, GK, GR, GV, GL) do { SBAR(); \
    const lds_cptr vp_ = vp0 + sl_prev; const lds_cptr rp_ = rp0 + (sl_cur >> 1); \
    VRD(0); SBAR(); float sacc = P0[0] + P0[1]; \
                    GAPA(C0 = MFMA32(kf[0], qr[0], negm), P0[2], P0[3], P0[4], P0[5],     pw0[0] = PKW(P0, 0),  pw0[1] = PKW(P0, 2),  pw0); \
    VRD(4); SBAR(); GAPA(C1 = MFMA32(kf[1], qr[0], negm), P0[6], P0[7], P0[8], P0[9],     pw0[2] = PKW(P0, 4),  pw0[3] = PKW(P0, 6),  pw0); \
    VRD(1); SBAR(); GAPA(C0 = MFMA32(kf[2], qr[1], C0),   P0[10], P0[11], P0[12], P0[13], pw1[0] = PKW(P0, 8),  pw1[1] = PKW(P0, 10), pw1); \
    VRD(5); SBAR(); GAPA(C1 = MFMA32(kf[3], qr[1], C1),   P0[14], P0[15], P1[0], P1[1],   pw1[2] = PKW(P0, 12), pw1[3] = PKW(P0, 14), pw1); \
    kload2(kf, rp_, 0); VRD(2); SBAR(); GAPA(C0 = MFMA32(kf[4], qr[2], C0),   P1[2], P1[3], P1[4], P1[5],     pw2[0] = PKW(P1, 0),  pw2[1] = PKW(P1, 2),  pw2); \
    kload2(kf, rp_, 1); VRD(6); SBAR(); GAPA(C1 = MFMA32(kf[5], qr[2], C1),   P1[6], P1[7], P1[8], P1[9],     pw2[2] = PKW(P1, 4),  pw2[3] = PKW(P1, 6),  pw2); \
    VRD(3); SBAR(); GAPA(C0 = MFMA32(kf[6], qr[3], C0),   P1[10], P1[11], P1[12], P1[13], pw3[0] = PKW(P1, 8),  pw3[1] = PKW(P1, 10), pw3); \
    VRD(7); SBAR(); GAPA(C1 = MFMA32(kf[7], qr[3], C1),   P1[14], P1[15], 0.f, 0.f,       pw3[2] = PKW(P1, 12), pw3[3] = PKW(P1, 14), pw3); \
    GAPR(C0 = MFMA32(kf[0], qr[4], C0)); GAPR(C1 = MFMA32(kf[1], qr[4], C1)); GAPR(C0 = MFMA32(kf[2], qr[5], C0)); GAPR(C1 = MFMA32(kf[3], qr[5], C1)); \
    l_reg += sacc; \
    if (GK) DMA_K((t) + 3, sl_cur); if (GR) DMA_R((t) + 2, sl_prev); if (GV) DMA_V((t) + 1, sl_next);            \
    if (MSK) mask_tile(C0, C1, qrel - 64 * ((t) - (NT - 4)), hi); \
    { const float rm = rowmax(C0, C1); resc = false;                                                              \
      if (__builtin_expect(__any(rm > THR), 0)) { const float dl = __builtin_fmaxf(rm, 0.f); mhat += dl;          \
          _Pragma("unroll") for (int r = 0; r < 16; ++r) { C0[r] -= dl; C1[r] -= dl; } \
          _Pragma("unroll") for (int r = 0; r < 16; ++r) negm[r] = -mhat; \
          PIN(negm); \
          const float f = __builtin_amdgcn_exp2f(-dl); l_reg *= f; if (hi == 0) wsf[r32] = f; resc = true; } } \
    SBAR(); \
    GAPB(o[0] = MFMA32(PAF(0), VFR(0), o[0]), C0, 0);              GAPB(o[1] = MFMA32(PAF(0), VFR(4), o[1]), C0, 4); \
    KRD(GL, 0); GAPB(o[0] = MFMA32(PAF(1), VFR(1), o[0]), C0, 8);  KRD(GL, 1); GAPB(o[1] = MFMA32(PAF(1), VFR(5), o[1]), C0, 12); \
    KRD(GL, 2); GAPB(o[0] = MFMA32(PAF(2), VFR(2), o[0]), C1, 0);  KRD(GL, 3); GAPB(o[1] = MFMA32(PAF(2), VFR(6), o[1]), C1, 4); \
    GAPB(o[0] = MFMA32(PAF(3), VFR(3), o[0]), C1, 8);              GAPB(o[1] = MFMA32(PAF(3), VFR(7), o[1]), C1, 12); \
    } while (0)
    int t = 1;
    for (; t + 5 < NT; t += 2) {
        STEP(pB0, pB1, pA0, pA1, t, false, true, true, true, true);     WAITB(3, 2); RESC(); ROT();
        STEP(pA0, pA1, pB0, pB1, t + 1, false, true, true, true, true); WAITB(3, 2); RESC(); ROT();
    }
#define ENDW(tt) do { if ((tt) + 3 < NT) { WAITB(3, 2); } else if ((tt) + 2 < NT) { WAITB(2, 1); } else if ((tt) + 1 < NT) { WAIT_BAR(1); } else { WAIT_BAR(0); } } while (0)
    for (; t + 1 < NT; t += 2) {
        STEP(pB0, pB1, pA0, pA1, t, true, (t + 3 < NT), (t + 2 < NT), (t + 1 < NT), (t + 1 < NT));         ENDW(t);     RESC(); ROT();
        STEP(pA0, pA1, pB0, pB1, t + 1, true, (t + 4 < NT), (t + 3 < NT), (t + 2 < NT), (t + 2 < NT));     ENDW(t + 1); RESC(); ROT();
    }
    { float sacc = pA0[0] + pA0[1];
#pragma unroll
      for (int r = 2; r < 16; ++r) sacc += pA0[r];
#pragma unroll
      for (int r = 0; r < 16; ++r) sacc += pA1[r];
      l_reg += sacc;
      pw0 = (u32x4){PKW(pA0, 0), PKW(pA0, 2), PKW(pA0, 4), PKW(pA0, 6)}; pw1 = (u32x4){PKW(pA0, 8), PKW(pA0, 10), PKW(pA0, 12), PKW(pA0, 14)};
      pw2 = (u32x4){PKW(pA1, 0), PKW(pA1, 2), PKW(pA1, 4), PKW(pA1, 6)}; pw3 = (u32x4){PKW(pA1, 8), PKW(pA1, 10), PKW(pA1, 12), PKW(pA1, 14)};
      const lds_cptr vp_ = vp0 + sl_prev; _Pragma("unroll") for (int i = 0; i < 8; ++i) VRD(i);
      o[0] = MFMA32(PAF(0), VFR(0), o[0]); o[1] = MFMA32(PAF(0), VFR(4), o[1]); o[0] = MFMA32(PAF(1), VFR(1), o[0]); o[1] = MFMA32(PAF(1), VFR(5), o[1]);
      o[0] = MFMA32(PAF(2), VFR(2), o[0]); o[1] = MFMA32(PAF(2), VFR(6), o[1]); o[0] = MFMA32(PAF(3), VFR(3), o[0]); o[1] = MFMA32(PAF(3), VFR(7), o[1]); }
    { auto rr = __builtin_amdgcn_permlane32_swap(__float_as_uint(l_reg), __float_as_uint(l_reg), false, false); l_reg = __uint_as_float(rr[0]) + __uint_as_float(rr[1]); }
    if (hi == 0) wsf[32 + r32] = l_reg; asm volatile("s_waitcnt lgkmcnt(0)" ::: "memory");
    { float* stg = (float*)(lds + 65536) + wid * 2048;
#pragma unroll
      for (int r = 0; r < 16; ++r) { const int orow = crow(r, hi); const float rl = __builtin_amdgcn_rcpf(wsf[32 + orow]);
#pragma unroll
          for (int d0 = 0; d0 < 2; ++d0) stg[orow * 64 + d0 * 32 + r32] = o[d0][r] * rl; }
      asm volatile("s_waitcnt lgkmcnt(0)" ::: "memory");
      const bf16* __restrict__ SZ = (const bf16*)(ws + WS_SZ); bf16* __restrict__ OG = (bf16*)(ws + WS_OG);
      u32x4 zz[4];
#pragma unroll
      for (int i = 0; i < 4; ++i) { const int row = i * 8 + (lane >> 3), ch = lane & 7; zz[i] = *(const u32x4*)(SZ + (size_t)(qrow0 + wid * QBLK + row) * 1024 + h * 64 + ch * 8); }
#pragma unroll
      for (int i = 0; i < 4; ++i) { const int row = i * 8 + (lane >> 3), ch = lane & 7; const f32x4 a = *(const f32x4*)(stg + row * 64 + ch * 8), c = *(const f32x4*)(stg + row * 64 + ch * 8 + 4);
          u32x4 w; w.x = cvtpk(a[0] * bflo(zz[i].x), a[1] * bfhi(zz[i].x)); w.y = cvtpk(a[2] * bflo(zz[i].y), a[3] * bfhi(zz[i].y)); w.z = cvtpk(c[0] * bflo(zz[i].z), c[1] * bfhi(zz[i].z)); w.w = cvtpk(c[2] * bflo(zz[i].w), c[3] * bfhi(zz[i].w));
          *(u32x4*)(OG + (size_t)(qrow0 + wid * QBLK + row) * 1024 + h * 64 + ch * 8) = w; } }
    asm volatile("s_waitcnt lgkmcnt(0)\n\ts_barrier" ::: "memory");
#undef RFL
#undef KOFF
#undef ROFF
#undef VOFF
#undef DMA_K
#undef DMA_V
#undef DMA_R
#undef WAITB
#undef ROT
#undef RESC
#undef PKW
#undef PAF
#undef VFR
#undef VRD
#undef KRD
#undef GAPA
#undef GAPR
#undef EX
#undef GAPB
#undef STEP
#undef ENDW
}
#undef MFMA32
#undef WAIT_BAR
#undef PIN
#undef MX3
}

namespace as {
constexpr int IMG_HALF = 16384, IMG_ROPE = 32768, IMG_BYTES = 36864;
constexpr int OFF_Q = 0, OFF_K0 = IMG_BYTES, OFF_WS = OFF_K0 + 3 * IMG_BYTES, LDS_BYTES_AS = OFF_WS + 8 * 64 * 4 + 8 * 64 * 4;
constexpr float THR = 8.0f;
constexpr int NTILE = 2 * AS_PAGES;
__device__ __forceinline__ unsigned off_a(unsigned row, unsigned ch) { return 2048u * (row >> 3) + 512u * (ch >> 2) + 64u * (row & 7) + 16u * ((ch & 3) ^ ((row >> 2) & 3)); }
__device__ __forceinline__ unsigned off_rope(unsigned row, unsigned ch) { return IMG_ROPE + 64u * row + 16u * (ch ^ ((row >> 2) & 3)); }
__device__ __forceinline__ unsigned img_off(unsigned row, unsigned c8) { return c8 < 32 ? (c8 >> 4) * IMG_HALF + off_a(row, c8 & 15) : off_rope(row, c8 - 32); }
__device__ __forceinline__ s16x4 tr_read_dyn(unsigned addr) { s16x4 r; asm volatile("ds_read_b64_tr_b16 %0, %1" : "=&v"(r) : "v"(addr) : "memory"); return r; }

__device__ __forceinline__ void attn_s_unit(const Args& A, int b, int s, char* lds, const int wave) {
    unsigned char* ws = opaque_global(A.ws);
    const int lane = lane_fresh(), wid = wave, tid = wave * 64 + lane, r32 = lane & 31, hi = lane >> 5;
    const int qg = wid & 1, kh = (wid >> 1) & 1, chh = wid >> 2;
    const int* pt = A.page_table + (size_t)b * NPAGES + s * AS_PAGES;
    float* wsf = (float*)(lds + OFF_WS) + wid * 64;
    struct Stage { f32x4 c[8]; f32x4 r; } sA, sB;
#define TLOAD(S, t) do { const int t_ = (t) < NTILE ? (t) : NTILE - 1; const int pg_ = __builtin_amdgcn_readfirstlane(pgl[t_ >> 1]); const size_t k0_ = (size_t)pg_ * PAGE + (t_ & 1) * 64; \
    const int live_ = (t) < NTILE ? 1 : 0;        \
    const float* cb_ = A.cache_ckv + (k0_ + wid) * KVL + live_ * lane * 4; const float* rb_ = A.cache_krope + k0_ * QKR + live_ * tid * 4; \
    _Pragma("unroll") for (int i_ = 0; i_ < 8; ++i_) S.c[i_] = __builtin_nontemporal_load((const f32x4*)(cb_ + (size_t)(live_ * 8 * i_) * KVL)); S.r = __builtin_nontemporal_load((const f32x4*)rb_); } while (0)
#define TWRITE(bufoff, S) do { _Pragma("unroll") for (int i_ = 0; i_ < 8; ++i_) { u32x2 w_; w_.x = cvtpk(S.c[i_][0], S.c[i_][1]); w_.y = cvtpk(S.c[i_][2], S.c[i_][3]); \
        *(u32x2*)(lds + (bufoff) + img_off(8 * i_ + wid, lane >> 1) + (lane & 1) * 8) = w_; } \
    { const int rrow_ = tid >> 3, rc4 = tid & 7; u32x2 w_; w_.x = cvtpk(S.r[0], S.r[1]); w_.y = cvtpk(S.r[2], S.r[3]); *(u32x2*)(lds + (bufoff) + off_rope(rrow_, rc4 >> 1) + (rc4 & 1) * 8) = w_; } } while (0)
    __attribute__((address_space(3))) int* pgl = (__attribute__((address_space(3))) int*)(lds + OFF_WS + 2048) + wid * 64;
    if (lane < AS_PAGES) pgl[lane] = pt[lane];
    asm volatile("s_waitcnt vmcnt(0) lgkmcnt(0)" ::: "memory");
    TLOAD(sA, 0); TLOAD(sB, 1);
    {
        const bf16* QN = (const bf16*)(ws + WS_QN); const bf16* QR = (const bf16*)(ws + WS_QR); const bf16* WUKB = (const bf16*)(ws + WS_WUKB);
        bf16* QABS = (bf16*)(ws + WS_QABS) + (size_t)b * 64 * 288;
        const size_t qrow0 = (size_t)(SAMP0 + b * 4);
        const int l15 = lane & 15, l4 = lane >> 4, tok = l15 & 3;
#pragma unroll 1
        for (int hh = 0; hh < 2; ++hh) { const int h = 2 * wid + hh;
            const bf16x8 bq0 = *(const bf16x8*)(QN + (qrow0 + tok) * 1024 + h * 64 + 8 * l4), bq1 = *(const bf16x8*)(QN + (qrow0 + tok) * 1024 + h * 64 + 32 + 8 * l4);
#pragma unroll 4
            for (int nt = 0; nt < 16; ++nt) { const bf16* wp = WUKB + (size_t)(nt * 16 + l15) * 1024 + h * 64 + 8 * l4;
                const bf16x8 a0 = *(const bf16x8*)wp, a1 = *(const bf16x8*)(wp + 32);
                f32x4 acc = (f32x4){0.f, 0.f, 0.f, 0.f};
                acc = __builtin_amdgcn_mfma_f32_16x16x32_bf16(a0, bq0, acc, 0, 0, 0);
                acc = __builtin_amdgcn_mfma_f32_16x16x32_bf16(a1, bq1, acc, 0, 0, 0);
                if (l15 < 4) { const int q = l15 * 16 + h, c0 = nt * 16 + l4 * 4; u32x2 w; w.x = cvtpk(acc[0], acc[1]); w.y = cvtpk(acc[2], acc[3]);
                    *(u32x2*)(lds + OFF_Q + img_off(q, c0 >> 3) + (c0 & 7) * 2) = w; if (s == 0) *(u32x2*)(QABS + (size_t)q * 288 + c0) = w; } }
        }
        if (tid < 256) { const int q = tid >> 2, c = tid & 3; const u32x4 w = *(const u32x4*)(QR + (qrow0 + (q >> 4)) * 512 + (q & 15) * 32 + c * 8);
            *(u32x4*)(lds + OFF_Q + off_rope(q, c)) = w; if (s == 0) *(u32x4*)(QABS + (size_t)q * 288 + 256 + c * 8) = w; }
    }
    unsigned kaddr[2], qaddr[2], kraddr, qraddr;
    { const unsigned krow = kh * 32 + r32, qrow = qg * 32 + r32;
#pragma unroll
      for (int od = 0; od < 2; ++od) { kaddr[od] = off_a(krow, 2 * od + hi); qaddr[od] = OFF_Q + off_a(qrow, 2 * od + hi); }
      kraddr = off_rope(krow, hi); qraddr = OFF_Q + off_rope(qrow, hi); }
    const unsigned kr2 = IMG_ROPE + 64u * (kh * 32 + r32) + 16u * ((2 + hi) ^ (((kh * 32 + r32) >> 2) & 3)), qr2 = OFF_Q + IMG_ROPE + 64u * (qg * 32 + r32) + 16u * ((2 + hi) ^ (((qg * 32 + r32) >> 2) & 3));
    unsigned vaddr[2];
    { const unsigned blk = (lane >> 4) & 1, q = (lane & 15) >> 2, p = lane & 3;
#pragma unroll
      for (int t = 0; t < 2; ++t) vaddr[t] = chh * IMG_HALF + off_a(32 * kh + 8 * hi + 4 * t + q, 2 * blk + (p >> 1)) + 8 * (p & 1); }
    float m_reg = -1e30f, l_reg = 0.f; f32x16 o[4] = {};
    const unsigned ldsb = (unsigned)(uintptr_t)lds;
#define KQ_LD(X, pp) do { constexpr unsigned so_ = 512u * ((pp) & 3) + (unsigned)IMG_HALF * ((pp) >> 2); \
        k##X##0 = *(const bf16x8*)(lds + bo_ + kaddr[0] + so_); q##X##0 = *(const bf16x8*)(lds + qaddr[0] + so_); k##X##1 = *(const bf16x8*)(lds + bo_ + kaddr[1] + so_); q##X##1 = *(const bf16x8*)(lds + qaddr[1] + so_); } while (0)
#define KQ_LDR(X) do { k##X##0 = *(const bf16x8*)(lds + bo_ + kraddr); q##X##0 = *(const bf16x8*)(lds + qraddr); k##X##1 = *(const bf16x8*)(lds + bo_ + kr2); q##X##1 = *(const bf16x8*)(lds + qr2); } while (0)
#define KQ_MM(X) do { p = __builtin_amdgcn_mfma_f32_32x32x16_bf16(k##X##0, q##X##0, p, 0, 0, 0); p = __builtin_amdgcn_mfma_f32_32x32x16_bf16(k##X##1, q##X##1, p, 0, 0, 0); } while (0)
#define PV_RD(X, nt) do { v##X##0 = tr_read_dyn(ldsb + bo_ + vaddr[0] + 512 * (nt)); v##X##1 = tr_read_dyn(ldsb + bo_ + vaddr[1] + 512 * (nt)); \
        v##X##2 = tr_read_dyn(ldsb + bo_ + vaddr[0] + 512 * (nt) + 4096); v##X##3 = tr_read_dyn(ldsb + bo_ + vaddr[1] + 512 * (nt) + 4096); } while (0)
#define PV_MM(X, nt) do { o[nt] = __builtin_amdgcn_mfma_f32_32x32x16_bf16(pa0, ((bf16x8){v##X##0[0], v##X##0[1], v##X##0[2], v##X##0[3], v##X##1[0], v##X##1[1], v##X##1[2], v##X##1[3]}), o[nt], 0, 0, 0); \
        o[nt] = __builtin_amdgcn_mfma_f32_32x32x16_bf16(pa1, ((bf16x8){v##X##2[0], v##X##2[1], v##X##2[2], v##X##2[3], v##X##3[0], v##X##3[1], v##X##3[2], v##X##3[3]}), o[nt], 0, 0, 0); } while (0)
#define LGKM_WAIT(N) do { asm volatile("s_waitcnt lgkmcnt(" #N ")" ::: "memory"); SBAR(); } while (0)
#define COMPUTE(bufoff) do { f32x16 p = f32x16{}; const unsigned bo_ = (bufoff); bf16x8 kA0, qA0, kA1, qA1, kB0, qB0, kB1, qB1; \
    KQ_LD(A, 0); KQ_LD(B, 1); SBAR(); KQ_MM(A); KQ_LD(A, 2); SBAR(); KQ_MM(B); KQ_LD(B, 3); SBAR(); KQ_MM(A); KQ_LD(A, 4); SBAR(); KQ_MM(B); KQ_LD(B, 5); SBAR(); \
    KQ_MM(A); KQ_LD(A, 6); SBAR(); KQ_MM(B); KQ_LD(B, 7); SBAR(); KQ_MM(A); KQ_LDR(A); SBAR(); KQ_MM(B); SBAR(); KQ_MM(A); SBAR(); \
    float pmax = p[0]; _Pragma("unroll") for (int r = 1; r < 16; ++r) pmax = fmaxf(pmax, p[r]); \
    { auto rr = __builtin_amdgcn_permlane32_swap(__float_as_uint(pmax), __float_as_uint(pmax), false, false); pmax = fmaxf(__uint_as_float(rr[0]), __uint_as_float(rr[1])); } \
    float alpha = 1.f; \
    if (!__all(pmax - m_reg <= THR)) { const float mn = fmaxf(m_reg, pmax); alpha = __builtin_amdgcn_exp2f(m_reg - mn); m_reg = mn; \
        if (hi == 0) wsf[r32] = alpha; asm volatile("s_waitcnt lgkmcnt(0)" ::: "memory"); \
        _Pragma("unroll") for (int n = 0; n < 4; ++n) _Pragma("unroll") for (int r = 0; r < 16; ++r) o[n][r] *= wsf[ap::crow(r, hi)]; } \
    s16x4 vA0, vA1, vA2, vA3, vB0, vB1, vB2, vB3; asm volatile("s_waitcnt lgkmcnt(0)" ::: "memory"); SBAR(); PV_RD(A, 0); SBAR();        \
    float ps = 0.f; _Pragma("unroll") for (int r = 0; r < 16; ++r) { p[r] = __builtin_amdgcn_exp2f(p[r] - m_reg); ps += p[r]; } \
    { auto rr = __builtin_amdgcn_permlane32_swap(__float_as_uint(ps), __float_as_uint(ps), false, false); ps = __uint_as_float(rr[0]) + __uint_as_float(rr[1]); } \
    l_reg = l_reg * alpha + ps; \
    bf16x8 pa0, pa1; PK4(p, 0, pa0); PK4(p, 8, pa1); SBAR(); \
    PV_RD(B, 1); LGKM_WAIT(4); PV_MM(A, 0); SBAR(); PV_RD(A, 2); LGKM_WAIT(4); PV_MM(B, 1); SBAR(); PV_RD(B, 3); LGKM_WAIT(4); PV_MM(A, 2); SBAR(); LGKM_WAIT(0); PV_MM(B, 3); SBAR(); } while (0)
    TWRITE(OFF_K0, sA); TLOAD(sA, 2); TWRITE(OFF_K0 + IMG_BYTES, sB); TLOAD(sB, 3); __syncthreads();
    { unsigned bc = OFF_K0, bn = OFF_K0 + IMG_BYTES, bw = OFF_K0 + 2 * IMG_BYTES;
#pragma unroll 1
      for (int t = 0; t < NTILE; t += 2) {
        SBAR(); COMPUTE(bc); SBAR();
        TWRITE(bw, sA); TLOAD(sA, t + 4);
        __syncthreads();
        { const unsigned x_ = bc; bc = bn; bn = bw; bw = x_; }
        SBAR(); COMPUTE(bc); SBAR();
        TWRITE(bw, sB); TLOAD(sB, t + 5);
        __syncthreads();
        { const unsigned x_ = bc; bc = bn; bn = bw; bw = x_; }
      } }
    { float* xo = (float*)lds + (size_t)(chh * 2 + qg) * 4096;
      float* xml = (float*)(lds + 65536) + (chh * 2 + qg) * 128;
      if (kh == 1) {
#pragma unroll
          for (int nt = 0; nt < 4; ++nt)
#pragma unroll
              for (int r = 0; r < 16; ++r) xo[(nt * 16 + r) * 64 + lane] = o[nt][r];
          xml[lane] = m_reg; xml[64 + lane] = l_reg; }
      __syncthreads();
      if (kh == 0) {
          const float m2 = xml[lane], l2 = xml[64 + lane]; const float mn = fmaxf(m_reg, m2); const float a1 = __builtin_amdgcn_exp2f(m_reg - mn), a2 = __builtin_amdgcn_exp2f(m2 - mn);
          l_reg = l_reg * a1 + l2 * a2; m_reg = mn;
          if (hi == 0) { wsf[r32] = a1; wsf[32 + r32] = a2; } asm volatile("s_waitcnt lgkmcnt(0)" ::: "memory");
          float* PO = (float*)(ws + WS_PART) + ((size_t)(b * 4 + s) * 64) * 256; float* PML = (float*)(ws + WS_PML) + (size_t)(b * 4 + s) * 128;
#pragma unroll
          for (int nt = 0; nt < 4; ++nt)
#pragma unroll
              for (int r = 0; r < 16; ++r) { const int qr_ = ap::crow(r, hi); PO[(size_t)(qg * 32 + qr_) * 256 + chh * 128 + nt * 32 + r32] = o[nt][r] * wsf[qr_] + xo[(nt * 16 + r) * 64 + lane] * wsf[32 + qr_]; }
          if (chh == 0 && hi == 0) { PML[qg * 32 + r32] = m_reg; PML[64 + qg * 32 + r32] = l_reg; } }
    }
    __syncthreads();
#undef TLOAD
#undef TWRITE
#undef COMPUTE
#undef KQ_LD
#undef KQ_LDR
#undef KQ_MM
#undef PV_RD
#undef PV_MM
#undef LGKM_WAIT
}
#undef PK4
#undef PKV
#undef KSWZ
}

__device__ __forceinline__ void comb_unit(const Args& A, int b, int hq, char* lds, const int wave) {
    unsigned char* ws = A.ws; const int tid = wave * 64 + lane_fresh(), lq = tid >> 5, l = lq >> 2, h = hq * 4 + (lq & 3), j = tid & 31, q = l * 16 + h;
    const bf16* QABS = (const bf16*)(ws + WS_QABS) + ((size_t)b * 64 + q) * 288; const bf16* CB = (const bf16*)(ws + WS_CB); const bf16* KRB = (const bf16*)(ws + WS_KRB);
    const float* PO = (const float*)(ws + WS_PART) + ((size_t)b * 4 * 64 + q) * 256; const float* PML = (const float*)(ws + WS_PML) + (size_t)b * 4 * 128;
    float* olds = (float*)lds;
    float qv[8], qrv[8];
    { const u32x4 w = *(const u32x4*)(QABS + j * 8);
#pragma unroll
      for (int k = 0; k < 4; ++k) { qv[2 * k] = bflo(w[k]); qv[2 * k + 1] = bfhi(w[k]); }
      u32x4 wr = (u32x4){0u, 0u, 0u, 0u}; if (j < 4) wr = *(const u32x4*)(QABS + 256 + j * 8);
#pragma unroll
      for (int k = 0; k < 4; ++k) { qrv[2 * k] = bflo(wr[k]); qrv[2 * k + 1] = bfhi(wr[k]); } }
    float sc[4], cn[4][8];
#pragma unroll
    for (int jn = 0; jn < 4; ++jn) { const size_t row = (size_t)(SAMP0 + b * 4 + jn); const u32x4 w = *(const u32x4*)(CB + row * 256 + j * 8); float d = 0.f;
#pragma unroll
        for (int k = 0; k < 4; ++k) { cn[jn][2 * k] = bflo(w[k]); cn[jn][2 * k + 1] = bfhi(w[k]); d += qv[2 * k] * cn[jn][2 * k] + qv[2 * k + 1] * cn[jn][2 * k + 1]; }
        if (j < 4) { const u32x4 wr = *(const u32x4*)(KRB + row * 32 + j * 8);
#pragma unroll
            for (int k = 0; k < 4; ++k) d += qrv[2 * k] * bflo(wr[k]) + qrv[2 * k + 1] * bfhi(wr[k]); }
#pragma unroll
        for (int o = 1; o < 32; o <<= 1) d = d + shfl_xor_f(d, o, tid & 63);
        sc[jn] = jn <= l ? d : -INFINITY; }
    float mp[4], lp[4], M = -INFINITY;
#pragma unroll
    for (int p = 0; p < AS_SPLITS; ++p) { mp[p] = PML[p * 128 + q]; lp[p] = PML[p * 128 + 64 + q]; M = fmaxf(M, mp[p]); }
#pragma unroll
    for (int jn = 0; jn < 4; ++jn) M = fmaxf(M, sc[jn]);
    float L = 0.f, acc[8];
#pragma unroll
    for (int k = 0; k < 8; ++k) acc[k] = 0.f;
#pragma unroll
    for (int p = 0; p < AS_SPLITS; ++p) { const float w = __builtin_amdgcn_exp2f(mp[p] - M); L += w * lp[p]; const f32x4 a = *(const f32x4*)(PO + (size_t)p * 64 * 256 + j * 8), c = *(const f32x4*)(PO + (size_t)p * 64 * 256 + j * 8 + 4);
#pragma unroll
        for (int k = 0; k < 4; ++k) { acc[k] += w * a[k]; acc[4 + k] += w * c[k]; } }
#pragma unroll
    for (int jn = 0; jn < 4; ++jn) { const float w = __builtin_amdgcn_exp2f(sc[jn] - M); L += w;
#pragma unroll
        for (int k = 0; k < 8; ++k) acc[k] += w * cn[jn][k]; }
    const float rl = 1.0f / L;
    *(f32x4*)(olds + lq * 256 + j * 8) = (f32x4){acc[0] * rl, acc[1] * rl, acc[2] * rl, acc[3] * rl}; *(f32x4*)(olds + lq * 256 + j * 8 + 4) = (f32x4){acc[4] * rl, acc[5] * rl, acc[6] * rl, acc[7] * rl};
    __syncthreads();
    const bf16* WUV = (const bf16*)(ws + WS_WUKV) + (size_t)(1024 + h * 64 + 2 * j) * 256;
    float o0 = 0.f, o1 = 0.f;
    for (int c = 0; c < 256; c += 8) { const u32x4 w0 = *(const u32x4*)(WUV + c), w1 = *(const u32x4*)(WUV + 256 + c); const f32x4 x0 = *(const f32x4*)(olds + lq * 256 + c), x1 = *(const f32x4*)(olds + lq * 256 + c + 4);
        o0 += x0[0] * bflo(w0[0]) + x0[1] * bfhi(w0[0]) + x0[2] * bflo(w0[1]) + x0[3] * bfhi(w0[1]) + x1[0] * bflo(w0[2]) + x1[1] * bfhi(w0[2]) + x1[2] * bflo(w0[3]) + x1[3] * bfhi(w0[3]);
        o1 += x0[0] * bflo(w1[0]) + x0[1] * bfhi(w1[0]) + x0[2] * bflo(w1[1]) + x0[3] * bfhi(w1[1]) + x1[0] * bflo(w1[2]) + x1[1] * bfhi(w1[2]) + x1[2] * bflo(w1[3]) + x1[3] * bfhi(w1[3]); }
    const size_t orow = (size_t)(SAMP0 + b * 4 + l) * 1024 + h * 64 + 2 * j;
    const unsigned z = *(const unsigned*)((const bf16*)(ws + WS_SZ) + orow);
    *(unsigned*)((bf16*)(ws + WS_OG) + orow) = cvtpk(o0 * bflo(z), o1 * bfhi(z));
    __syncthreads();
}
constexpr int N_AS_ITEMS = DECB * AS_SPLITS;
#ifndef PREF_DIV
#define PREF_DIV 4
#endif
#ifndef PREF_NUM
#define PREF_NUM 0
#endif
#ifndef ARGS_RELOAD
#define ARGS_RELOAD 1
#endif
#ifndef REP_BAR
#define REP_BAR 1
#endif
#ifndef REP_ELT
#define REP_ELT 1
#endif
#ifndef TAIL_CONV
#define TAIL_CONV 1
#endif
#ifndef STATIC_SCHED
#define STATIC_SCHED 0
#endif
#ifndef REP_AS
#define REP_AS 1
#endif
#ifndef REP_AP
#define REP_AP 1
#endif
#ifndef REP_GEMM
#define REP_GEMM 1
#endif
#ifndef EN_P0
#define EN_P0 1
#endif
#ifndef EN_G1
#define EN_G1 1
#endif
#ifndef EN_CONV
#define EN_CONV 1
#endif
#ifndef EN_G4
#define EN_G4 1
#endif
#ifndef EN_LAT
#define EN_LAT 1
#endif
#ifndef EN_G5
#define EN_G5 1
#endif
#ifndef EN_G6
#define EN_G6 1
#endif
#ifndef EN_AP
#define EN_AP 1
#endif
#ifndef EN_AS
#define EN_AS 1
#endif
#ifndef EN_COMB
#define EN_COMB 1
#endif
#ifndef EN_GOUT
#define EN_GOUT 1
#endif
#ifndef EN_NORM
#define EN_NORM 1
#endif

__device__ __forceinline__ Args fresh_args() {
    const __attribute__((address_space(4))) unsigned long long* p = (const __attribute__((address_space(4))) unsigned long long*)__builtin_amdgcn_kernarg_segment_ptr();
    asm volatile("" : "+s"(p));
#define GP(T, i) ((T*)(__attribute__((address_space(1))) T*)p[i])
    Args a;
    a.x_prompt = GP(const float, 0); a.x_sample = GP(const float, 1); a.cache_ckv = GP(const float, 2); a.cache_krope = GP(const float, 3); a.state_conv = GP(const float, 4); a.page_table = GP(const int, 5);
    a.meta = GP(const float, 6); a.pre_g = GP(const float, 7); a.post_g = GP(const float, 8); a.w_in_conv = GP(const float, 9); a.conv_w = GP(const float, 10); a.w_out_conv = GP(const float, 11);
    a.kv_norm_g = GP(const float, 12); a.w_dkv = GP(const float, 13); a.kv_lat_g = GP(const float, 14); a.w_uk = GP(const float, 15); a.w_uv = GP(const float, 16); a.w_in_mla = GP(const float, 17);
    a.q_norm_g = GP(const float, 18); a.w_uq = GP(const float, 19); a.w_out_mla = GP(const float, 20); a.out = GP(float, 21); a.ws = GP(unsigned char, 22);
#undef GP
    return a;
}
static_assert(sizeof(Args) == 23 * 8, "Args = 23 pointers, no padding: fresh_args() reads them by index");
__global__ void __launch_bounds__(NWAVES * 64, 2) yoco_fwd(Args args_unused_directly) {
    extern __shared__ __attribute__((aligned(16))) unsigned char lds[];
    LAS unsigned char* ldsl = (LAS unsigned char*)lds;
    const int wave = __builtin_amdgcn_readfirstlane(threadIdx.x >> 6) & 7;
#define LANE_OPAQUE() const int lane = lane_fresh()
#define IS_T0() (wave == 0 && lane_fresh() == 0)
#if ARGS_RELOAD
#define PHASE_ARGS() const Args args = fresh_args(); unsigned char* const ws = args.ws; (void)ws; PHASE_IDS()
#else
#define PHASE_ARGS() Args args = args_unused_directly; asm volatile("" : "+s"(args.ws), "+s"(args.out)); unsigned char* const ws = args.ws; (void)ws; PHASE_IDS()
#endif
    const int G0 = gridDim.x, bx0 = blockIdx.x;
#define PHASE_IDS() int G = G0, bx = bx0; asm volatile("" : "+s"(G), "+s"(bx)); const int vcu = (G % 8 == 0) ? (bx % 8) * (G / 8) + bx / 8 : bx; const int gw = vcu * NWAVES + wave, NGW = G * NWAVES; (void)vcu; (void)gw; (void)NGW
    { const int t_ = wave * 64 + lane_fresh(); if (t_ < 8) ((LAS unsigned*)(ldsl + LDSCTL_OFF))[t_] = 0u; }
    __syncthreads();
    { PHASE_ARGS(); (void)xcd_barrier_post((unsigned*)(ws + WS_CTL) + CW_BAR, (volatile LAS unsigned*)(ldsl + LDSCTL_OFF), IS_T0()); }
#define GRID_BAR() do { PHASE_ARGS(); XcdBarrier b_; b_.bar = (unsigned*)(ws + WS_CTL) + CW_BAR; b_.x = xb_xcc_id(); b_.st = (volatile LAS unsigned*)(ldsl + LDSCTL_OFF); for (int rb_ = 0; rb_ < REP_BAR; ++rb_) xcd_barrier(b_, IS_T0()); } while (0)
#if EN_P0
    { PHASE_ARGS(); LANE_OPAQUE(); for (int re_ = 0; re_ < REP_ELT; ++re_) p0_prologue(args, ldsl, gw, NGW, wave, lane); }
#endif
    GRID_BAR();

#pragma unroll 1
    for (int l = 0; l < 4; ++l) {
        if (l < 2) {
            { PHASE_ARGS(); pg8::Gemm g{(const bf16*)(ws + WS_X), (const bf16*)(ws + WS_WIN) + (size_t)l * 4096 * 1024, NROWS, 4096, 1024}; pg8::RepOrder<REP_GEMM> S; S.init(NROWS, 4096, G, bx);
              pg8::EpiConvSplit E{(bf16*)(ws + WS_V1), (bf16*)(ws + WS_GZ), (const float*)(ws + WS_RS)};
#if EN_G1
              pg8::gemm_phase<pg8::EpiConvSplit, pg8::RepOrder<REP_GEMM>, true, true>(ldsl, g, S, E, wave);
#endif
              { constexpr int r_ = (67 * 16) % 256; if (TAIL_CONV && G == 256 && bx >= r_) { LANE_OPAQUE(); convert_set(args, l == 0 ? 1 : 3, ldsl, (bx - r_) * NWAVES + wave, (256 - r_) * NWAVES, wave, lane); }
                else if (TAIL_CONV && G != 256 && l == 0) { LANE_OPAQUE(); convert_set(args, 1, ldsl, gw, NGW, wave, lane); convert_set(args, 3, ldsl, gw, NGW, wave, lane); } }
 }
            GRID_BAR();
#if EN_CONV
            { PHASE_ARGS(); LANE_OPAQUE(); for (int re_ = 0; re_ < REP_ELT; ++re_) conv_phase(args, l, gw, NGW, lane); }
#endif
            GRID_BAR();
        } else {
            const int j = l - 2;
            { PHASE_ARGS(); pg8::Gemm g{(const bf16*)(ws + WS_X), (const bf16*)(ws + (j ? WS_WA1 : WS_WA0)), NROWS, j ? 1536 : 2048, 1024}; pg8::RepOrder<REP_GEMM> S; S.init(NROWS, j ? 1536 : 2048, G, bx);
              pg8::EpiMlaIn E{(float*)(ws + WS_CKR), (bf16*)(ws + WS_QL), (float*)(ws + WS_SSQ), (bf16*)(ws + WS_SZ), j ? 0 : 2, (const float*)(ws + WS_RS)};
#if EN_G4
              pg8::gemm_phase<pg8::EpiMlaIn, pg8::RepOrder<REP_GEMM>, true, true>(ldsl, g, S, E, wave);
#endif
 }
            GRID_BAR();
            if (j == 0) {
#if EN_LAT
                { PHASE_ARGS(); LANE_OPAQUE(); for (int re_ = 0; re_ < REP_ELT; ++re_) latent_phase(args, gw, NGW, lane); }
#endif
                GRID_BAR();
                { PHASE_ARGS(); pg8::Gemm g{(const bf16*)(ws + WS_CB), (const bf16*)(ws + WS_WUKV), NROWS, 2048, 256}; pg8::RepOrder<REP_GEMM> S; S.init(NROWS, 2048, G, bx);
                  pg8::EpiBf16 E{(bf16*)(ws + WS_KN), 1024, 1024, (size_t)(WS_VV - WS_KN) / 2};
#if EN_G5
                  pg8::gemm_phase<pg8::EpiBf16, pg8::RepOrder<REP_GEMM>, true, true>(ldsl, g, S, E, wave);
#endif
 }
            }
            { PHASE_ARGS(); pg8::Gemm g{(const bf16*)(ws + WS_QL), (const bf16*)(ws + WS_WUQ) + (size_t)j * 1536 * 512, NROWS, 1536, 512}; pg8::RepOrder<REP_GEMM> S; S.init(NROWS, 1536, G, bx);
              pg8::EpiQUp E{(bf16*)(ws + WS_QN), (bf16*)(ws + WS_QR), (const float*)(ws + WS_SSQ), (const float*)(ws + WS_COS), (const float*)(ws + WS_SIN)};
#if EN_G6
              pg8::gemm_phase<pg8::EpiQUp, pg8::RepOrder<REP_GEMM>, true, true>(ldsl, g, S, E, wave);
#endif
 }
            GRID_BAR();
            {
                PHASE_ARGS();
                unsigned* qh = (unsigned*)(ws + WS_CTL) + CW_Q + j * 16 * 64;
                volatile LAS int* slot = (volatile LAS int*)(ldsl + LDSCTL_OFF + 16);
                const int myq = bx & 7; const bool prefS = ((bx >> 3) % PREF_DIV) < PREF_NUM;
                bool s_open = true, own_open = true; unsigned steal = 0xffffffffu;
#define DEQUEUE(dst, word) do { if (IS_T0()) *slot = (int)__hip_atomic_fetch_add(qh + (word) * 64, 1u, __ATOMIC_RELAXED, __HIP_MEMORY_SCOPE_AGENT); __syncthreads(); dst = *slot; __syncthreads(); } while (0)
#pragma unroll 1
                for (;;) {
                    int type = -1, id = 0, q = 0;
                    if (prefS && s_open) { DEQUEUE(id, 8); if (id < N_AS_ITEMS * REP_AS) type = 0; else s_open = false; }
                    if (type < 0 && own_open) { q = myq; DEQUEUE(id, q); if (id < 130 * REP_AP) { id = id % 130; type = id < 128 ? 1 : 2; } else own_open = false; }
                    if (type < 0 && s_open) { DEQUEUE(id, 8); if (id < N_AS_ITEMS * REP_AS) type = 0; else s_open = false; }
                    if (type < 0) {
                        if (steal == 0xffffffffu) { if (IS_T0()) { unsigned m_ = 0u;
#pragma unroll
                                for (int k_ = 0; k_ < 8; ++k_) if (__hip_atomic_load(qh + k_ * 64, __ATOMIC_RELAXED, __HIP_MEMORY_SCOPE_AGENT) < 130u * REP_AP) m_ |= 1u << k_;
                                *slot = (int)m_; } __syncthreads(); steal = (unsigned)*slot & ~(1u << myq); __syncthreads(); }
                        while (steal) { q = __builtin_ctz(steal); DEQUEUE(id, q); if (id < 130 * REP_AP) { id = id % 130; type = id < 128 ? 1 : 2; break; } steal &= ~(1u << q); }
                    }
                    if (type < 0) break;
#if EN_AS
                    if (type == 0) { id = id % N_AS_ITEMS; as::attn_s_unit(args, id / AS_SPLITS, id % AS_SPLITS, (char*)lds, wave); }
#endif
#if EN_AP
                    if (type >= 1) { const bool mt = type == 2; const int bh = q * 8 + (id & 7);
                        ap::attn_unit(ws, mt ? 0 : bh >> 4, mt ? q * 2 + (id - 128) : bh & 15, mt ? 0 : 15 - (id >> 3), mt, (char*)lds, wave); }
#endif
                }
#undef DEQUEUE
            }
            GRID_BAR();
#if EN_COMB
            { PHASE_ARGS(); for (int u = vcu; u < NSAMP * REP_ELT; u += G) comb_unit(args, (u % NSAMP) >> 2, u & 3, (char*)lds, wave); }
#endif
            GRID_BAR();
        }
        { PHASE_ARGS(); const bf16* Ag = (const bf16*)(ws + (l < 2 ? WS_G : WS_OG)); const bf16* Wl = (const bf16*)(ws + (l < 2 ? WS_WOC : WS_WOM)) + (size_t)(l & 1) * 1024 * 1024;
#if EN_GOUT
          { pg8::Gemm g{Ag, Wl, NMAIN, 1024, 1024}; pg8::StaticOrder S; S.init(NMAIN, 1024, G, bx); pg8::EpiBf16 E{(bf16*)(ws + WS_MB), 1024, 0, 0};
            pg8::gemm_phase<pg8::EpiBf16, pg8::StaticOrder, true, true>(ldsl, g, S, E, wave); }
          { pg8::Gemm g{Ag, Wl, NROWS, 1024, 1024 / GOUT_SPLITK, 1024}; pg8::SplitKSmallOrder<GOUT_SPLITK> S; S.init(1024, 1024, G, bx); pg8::EpiPartF32 E{(float*)(ws + WS_PARTG), 1024 / GOUT_SPLITK};
            pg8::gemm_phase<pg8::EpiPartF32, pg8::SplitKSmallOrder<GOUT_SPLITK>, true, true>(ldsl, g, S, E, wave); }
#endif
          if (l < 2) { constexpr int r_ = 96; if (TAIL_CONV && G == 256 && bx >= r_) { LANE_OPAQUE(); convert_set(args, l == 0 ? 2 : 4, ldsl, (bx - r_) * NWAVES + wave, (256 - r_) * NWAVES, wave, lane); }
                       else if (TAIL_CONV && G != 256 && l == 0) { LANE_OPAQUE(); convert_set(args, 2, ldsl, gw, NGW, wave, lane); convert_set(args, 4, ldsl, gw, NGW, wave, lane); } }
 }
        GRID_BAR();
#if EN_NORM
        { PHASE_ARGS(); LANE_OPAQUE(); norm_phase(args, l, gw, NGW, lane); }
#endif
        if (l < 3) GRID_BAR();
    }
}

extern "C" void kernel_launch(void* const* d_in, const int* in_sizes, int n_in, void* d_out, int out_size, void* d_ws, size_t ws_size, hipStream_t stream) {
    static int grid = 0;
    if (grid == 0) {
        if (n_in != 21 || out_size != (int)O_END || ws_size < WS_END) { fprintf(stderr, "kernel_launch: unexpected shapes: n_in %d out %d (want %zu) ws %zu (want >= %zu)\n", n_in, out_size, (size_t)O_END, ws_size, (size_t)WS_END); grid = -1; return; }
        int dev = 0, cus = 0, per_cu = 0;
        if (hipGetDevice(&dev) != hipSuccess || hipDeviceGetAttribute(&cus, hipDeviceAttributeMultiprocessorCount, dev) != hipSuccess) { grid = -1; return; }
        if (hipFuncSetAttribute((const void*)yoco_fwd, hipFuncAttributeMaxDynamicSharedMemorySize, LDS_BYTES) != hipSuccess) { fprintf(stderr, "kernel_launch: hipFuncSetAttribute failed\n"); grid = -1; return; }
        if (hipOccupancyMaxActiveBlocksPerMultiprocessor(&per_cu, (const void*)yoco_fwd, NWAVES * 64, LDS_BYTES) != hipSuccess || per_cu < 1) { fprintf(stderr, "kernel_launch: occupancy query says %d blocks per CU\n", per_cu); }
        (void)hipGetLastError();
        grid = cus;
    }
    if (grid < 0) return;
    if (hipMemsetAsync((char*)d_ws + WS_CTL, 0, CTL_ZERO_BYTES, stream) != hipSuccess) return;
    Args a{};
    a.x_prompt = (const float*)d_in[0]; a.x_sample = (const float*)d_in[1]; a.cache_ckv = (const float*)d_in[2]; a.cache_krope = (const float*)d_in[3]; a.state_conv = (const float*)d_in[4];
    a.page_table = (const int*)d_in[5]; a.meta = (const float*)d_in[6]; a.pre_g = (const float*)d_in[7]; a.post_g = (const float*)d_in[8]; a.w_in_conv = (const float*)d_in[9];
    a.conv_w = (const float*)d_in[10]; a.w_out_conv = (const float*)d_in[11]; a.kv_norm_g = (const float*)d_in[12]; a.w_dkv = (const float*)d_in[13]; a.kv_lat_g = (const float*)d_in[14];
    a.w_uk = (const float*)d_in[15]; a.w_uv = (const float*)d_in[16]; a.w_in_mla = (const float*)d_in[17]; a.q_norm_g = (const float*)d_in[18]; a.w_uq = (const float*)d_in[19]; a.w_out_mla = (const float*)d_in[20];
    a.out = (float*)d_out; a.ws = (unsigned char*)d_ws;
    hipLaunchKernelGGL(yoco_fwd, dim3(grid), dim3(NWAVES * 64), LDS_BYTES, stream, a);
    const hipError_t le = hipPeekAtLastError();
    if (le != hipSuccess) fprintf(stderr, "kernel_launch: launch failed: %s\n", hipGetErrorName(le));
}
```

```cpp
#include <hip/hip_runtime.h>
#include <hip/hip_bf16.h>
#include <cstdio>
#include <cstdint>
#include <cmath>

constexpr int DM = 1024, NB = 4, SEQ = 4096, NMETA = 16, TTOT = SEQ + NMETA;
constexpr int DECB = 128, DECS = 4, PAST = 8192, PAGE = 128, NPAGES = PAST / PAGE;
constexpr int NH = 16, QKN = 64, QKR = 32, VH = 64, QLORA = 512, KVL = 256;
constexpr int NMAIN = NB * SEQ;
constexpr int SAMP0 = NMAIN, NSAMP = DECB * DECS;
constexpr int META0 = SAMP0 + NSAMP;
constexpr int NROWS = META0 + 256;
constexpr int NPOS = TTOT + DECS;
constexpr float RMS_EPS = 1e-6f;
#ifndef AS_SPLITS_N
#define AS_SPLITS_N 1
#endif
constexpr int AS_SPLITS = AS_SPLITS_N, AS_PAGES = NPAGES / AS_SPLITS;
constexpr float QSCALE = 0.10206207261596575f * 1.4426950408889634f;

__device__ __forceinline__ float shfl_xor_f(float v, int mask, int lane) { return __int_as_float(__builtin_amdgcn_ds_bpermute((lane ^ mask) << 2, __float_as_int(v))); }

__device__ __forceinline__ int lane_fresh() { int l; asm volatile("v_mbcnt_lo_u32_b32 %0, -1, 0\n\tv_mbcnt_hi_u32_b32 %0, -1, %0" : "=v"(l)); return l & 63; }

template <class T> __device__ __forceinline__ T* opaque_global(T* p) { unsigned long long v = (unsigned long long)p; asm volatile("" : "+s"(v)); return (T*)(__attribute__((address_space(1))) T*)v; }

namespace pg8 {
#define PG8_LAS __attribute__((address_space(3)))
typedef unsigned short bf16_t;
typedef short bf16x8 __attribute__((ext_vector_type(8)));
typedef float f32x4 __attribute__((ext_vector_type(4)));
typedef unsigned u32x4 __attribute__((ext_vector_type(4)));
constexpr int BM = 256, BK = 64, HALF = 128, HTB = HALF * BK * 2  , STAGE_BYTES = 8 * HTB, NXCD = 8, WGM = 8;

__host__ __device__ __forceinline__ int lds_byte(int r, int c) { const int st = (r >> 4) * 2 + (c >> 5), rr = r & 15, cc = c & 31, ob = rr * 64 + cc * 2; return st * 1024 + (ob ^ (((ob >> 9) & 1) << 5)); }
__host__ __device__ __forceinline__ void stage_rc(int b, int& R, int& C) { const int st = b / 1024, sb = b % 1024, swz = sb ^ (((sb >> 9) & 1) << 5); R = (st >> 1) * 16 + swz / 64; C = (st & 1) * 32 + (swz % 64) / 2; }
__host__ __device__ __forceinline__ int perm32(int rho) { const int n = rho >> 4, i = rho & 15; return 8 * (i >> 2) + 4 * n + (i & 3); }

struct Unit { int pm, pn; int koff = 0; };
struct Gemm { const bf16_t* A; const bf16_t* Bt; int M, N, K; int ld = 0; };

struct StaticOrder {
    int nM, nN, nwg, G, c;
    __host__ __device__ void init(int M, int N, int G_, int c_) { nM = M / BM; nN = N / BM; nwg = nM * nN; G = G_; c = c_; }
    __host__ __device__ bool next(int i, Unit& u) const {
        const long L = (long)i * G + c; if (L >= nwg) return false;
        int wgid = (int)L; { const int q = nwg / NXCD, r = nwg % NXCD, xcd = wgid % NXCD, off = wgid / NXCD; wgid = (xcd < r ? xcd * (q + 1) : r * (q + 1) + (xcd - r) * q) + off; }
        const int nig = WGM * nN, gid = wgid / nig, fm = gid * WGM, gsz = (nM - fm) < WGM ? (nM - fm) : WGM;
        u.pm = fm + ((wgid % nig) % gsz); u.pn = (wgid % nig) / gsz; return true;
    }
    __device__ __forceinline__ void a_ready(const Unit&) const {}
    __device__ __forceinline__ void done(const Unit&) const {}
};


template <int R> struct RepOrder {
    StaticOrder base; int cnt;
    __host__ __device__ void init(int M, int N, int G_, int c_) { base.init(M, N, G_, c_); cnt = (base.nwg - c_ + G_ - 1) / G_; if (cnt < 0) cnt = 0; }
    __host__ __device__ bool next(int i, Unit& u) const { if (i >= R * cnt) return false; return base.next(i % cnt, u); }
    __device__ __forceinline__ void a_ready(const Unit&) const {}
    __device__ __forceinline__ void done(const Unit&) const {}
};

template <int S> struct SplitKSmallOrder {
    int nN, G, c, ksub;
    __host__ __device__ void init(int N, int K, int G_, int c_) { nN = N / BM; G = G_; c = c_; ksub = K / S; }
    __host__ __device__ bool next(int i, Unit& u) const { const long L = (long)i * G + c; if (L >= 3L * nN * S) return false; const int r = (int)(L / S); u.koff = (int)(L % S) * ksub; u.pm = 64 + r % 3; u.pn = r / 3; return true; }
    __device__ __forceinline__ void a_ready(const Unit&) const {}
    __device__ __forceinline__ void done(const Unit&) const {}
};

typedef float f32x2_t __attribute__((ext_vector_type(2))); typedef __bf16 bf16x2_t __attribute__((ext_vector_type(2)));
__device__ __forceinline__ unsigned cvt_pk_bf16(float lo, float hi) { f32x2_t v = {lo, hi}; bf16x2_t b = __builtin_convertvector(v, bf16x2_t); return __builtin_bit_cast(unsigned, b); }
typedef unsigned u32x2 __attribute__((ext_vector_type(2)));
__device__ __forceinline__ float sigmoidf_fast(float z) { return __builtin_amdgcn_rcpf(1.0f + __builtin_amdgcn_exp2f(-1.4426950408889634f * z)); }

struct EpiBf16 {
    static constexpr bool PERM = true, AFTER_DRAIN = false;
    bf16_t* O; int ldc; int split_cols; size_t split_stride;
    __device__ __forceinline__ void operator()(const f32x4 (&acc)[2][2][4][2], const Unit& u, int wr, int wc, int fr, int fq) const {
        const int row0 = u.pm * BM + wr * 64 + fr; int colt = u.pn * BM; bf16_t* base = O;
        if (split_cols && colt >= split_cols) { base += split_stride; colt -= split_cols; }
        const int col0 = colt + wc * 32 + 8 * fq;
#pragma unroll
        for (int ai = 0; ai < 2; ++ai)
#pragma unroll
            for (int m = 0; m < 4; ++m) { bf16_t* rowp = base + (size_t)(row0 + ai * HALF + m * 16) * ldc + col0;
#pragma unroll
                for (int bj = 0; bj < 2; ++bj) { const f32x4 v0 = acc[ai][bj][m][0], v1 = acc[ai][bj][m][1];
                    u32x4 w; w.x = cvt_pk_bf16(v0[0], v0[1]); w.y = cvt_pk_bf16(v0[2], v0[3]); w.z = cvt_pk_bf16(v1[0], v1[1]); w.w = cvt_pk_bf16(v1[2], v1[3]);
                    *(u32x4*)(rowp + bj * HALF) = w; } }
    }
};

struct EpiConvSplit {
    static constexpr bool PERM = true, AFTER_DRAIN = false;
    bf16_t* V; bf16_t* GZ; const float* RS;
    __device__ __forceinline__ void operator()(const f32x4 (&acc)[2][2][4][2], const Unit& u, int wr, int wc, int fr, int fq) const {
        const int row0 = u.pm * BM + wr * 64 + fr, ch0 = u.pn * 64 + wc * 16 + fq * 4;
#pragma unroll
        for (int ai = 0; ai < 2; ++ai)
#pragma unroll
            for (int m = 0; m < 4; ++m) { const size_t off = (size_t)(row0 + ai * HALF + m * 16) * 1024 + ch0;
                const float rs = RS[row0 + ai * HALF + m * 16];
                const f32x4 bg = acc[ai][0][m][0] * rs, cg = acc[ai][0][m][1] * rs, uu = acc[ai][1][m][0] * rs, zz = acc[ai][1][m][1] * rs;
                const f32x4 v = cg * uu; f32x4 g;
#pragma unroll
                for (int e = 0; e < 4; ++e) g[e] = bg[e] * zz[e] * sigmoidf_fast(zz[e]);
                u32x2 wv, wg; wv.x = cvt_pk_bf16(v[0], v[1]); wv.y = cvt_pk_bf16(v[2], v[3]); wg.x = cvt_pk_bf16(g[0], g[1]); wg.y = cvt_pk_bf16(g[2], g[3]);
                *(u32x2*)(V + off) = wv; *(u32x2*)(GZ + off) = wg; }
    }
};

struct EpiMlaIn {
    static constexpr bool PERM = true, AFTER_DRAIN = false;
    float* CKR; bf16_t* QL; float* SSQ; bf16_t* SZ; int nck; const float* RS;
    __device__ __forceinline__ void operator()(const f32x4 (&acc)[2][2][4][2], const Unit& u, int wr, int wc, int fr, int fq) const {
        const int row0 = u.pm * BM + wr * 64 + fr; const int t = u.pn - nck;
        if (t < 0) {
            const int col0 = u.pn * BM + wc * 32 + 8 * fq;
#pragma unroll
            for (int ai = 0; ai < 2; ++ai)
#pragma unroll
                for (int m = 0; m < 4; ++m) { float* rowp = CKR + (size_t)(row0 + ai * HALF + m * 16) * 512 + col0; const float rs = RS[row0 + ai * HALF + m * 16];
#pragma unroll
                    for (int bj = 0; bj < 2; ++bj) { *(f32x4*)(rowp + bj * HALF) = acc[ai][bj][m][0] * rs; *(f32x4*)(rowp + bj * HALF + 4) = acc[ai][bj][m][1] * rs; } }
        } else if (t < 2) {
            const int col0 = t * BM + wc * 32 + 8 * fq;
#pragma unroll
            for (int ai = 0; ai < 2; ++ai)
#pragma unroll
                for (int m = 0; m < 4; ++m) { const int row = row0 + ai * HALF + m * 16; bf16_t* rowp = QL + (size_t)row * 512 + col0; float s = 0.f; const float rs = RS[row];
#pragma unroll
                    for (int bj = 0; bj < 2; ++bj) { const f32x4 v0 = acc[ai][bj][m][0] * rs, v1 = acc[ai][bj][m][1] * rs;
                        s += (v0[0] * v0[0] + v0[1] * v0[1]) + (v0[2] * v0[2] + v0[3] * v0[3]) + (v1[0] * v1[0] + v1[1] * v1[1]) + (v1[2] * v1[2] + v1[3] * v1[3]);
                        u32x4 w; w.x = cvt_pk_bf16(v0[0], v0[1]); w.y = cvt_pk_bf16(v0[2], v0[3]); w.z = cvt_pk_bf16(v1[0], v1[1]); w.w = cvt_pk_bf16(v1[2], v1[3]);
                        *(u32x4*)(rowp + bj * HALF) = w; }
                    { const int ln = fq * 16 + fr; s += shfl_xor_f(s, 16, ln); s += shfl_xor_f(s, 32, ln); }
                    if (fq == 0) SSQ[(size_t)row * 8 + t * 4 + wc] = s; }
        } else {
            const int col0 = (t - 2) * BM + wc * 32 + 8 * fq;
#pragma unroll
            for (int ai = 0; ai < 2; ++ai)
#pragma unroll
                for (int m = 0; m < 4; ++m) { bf16_t* rowp = SZ + (size_t)(row0 + ai * HALF + m * 16) * 1024 + col0; const float rs = RS[row0 + ai * HALF + m * 16];
#pragma unroll
                    for (int bj = 0; bj < 2; ++bj) { f32x4 v0 = acc[ai][bj][m][0] * rs, v1 = acc[ai][bj][m][1] * rs;
#pragma unroll
                        for (int e = 0; e < 4; ++e) { v0[e] = v0[e] * sigmoidf_fast(v0[e]); v1[e] = v1[e] * sigmoidf_fast(v1[e]); }
                        u32x4 w; w.x = cvt_pk_bf16(v0[0], v0[1]); w.y = cvt_pk_bf16(v0[2], v0[3]); w.z = cvt_pk_bf16(v1[0], v1[1]); w.w = cvt_pk_bf16(v1[2], v1[3]);
                        *(u32x4*)(rowp + bj * HALF) = w; } }
        }
    }
};

__device__ __forceinline__ int posidx_of_row(int row) {
    return row < NMAIN ? (row & (SEQ - 1)) + NMETA : (row < META0 ? TTOT + ((row - SAMP0) & 3) : (row < META0 + NMETA ? row - META0 : 0));
}
struct EpiQUp {
    static constexpr bool PERM = true, AFTER_DRAIN = false;
    bf16_t* QN; bf16_t* QR; const float* SSQ; const float* COS; const float* SIN;
    __device__ __forceinline__ void operator()(const f32x4 (&acc)[2][2][4][2], const Unit& u, int wr, int wc, int fr, int fq) const {
        const int row0 = u.pm * BM + wr * 64 + fr;
#pragma unroll
        for (int ai = 0; ai < 2; ++ai)
#pragma unroll
            for (int m = 0; m < 4; ++m) { const int row = row0 + ai * HALF + m * 16;
                const f32x4 s0 = *(const f32x4*)(SSQ + (size_t)row * 8), s1 = *(const f32x4*)(SSQ + (size_t)row * 8 + 4);
                const float ss = ((s0[0] + s0[1]) + (s0[2] + s0[3])) + ((s1[0] + s1[1]) + (s1[2] + s1[3]));
                const float sc = QSCALE / sqrtf(ss * (1.0f / 512.0f) + RMS_EPS);
                if (u.pn < 4) { bf16_t* rowp = QN + (size_t)row * 1024 + u.pn * BM + wc * 32 + 8 * fq;
#pragma unroll
                    for (int bj = 0; bj < 2; ++bj) { const f32x4 v0 = acc[ai][bj][m][0] * sc, v1 = acc[ai][bj][m][1] * sc;
                        u32x4 w; w.x = cvt_pk_bf16(v0[0], v0[1]); w.y = cvt_pk_bf16(v0[2], v0[3]); w.z = cvt_pk_bf16(v1[0], v1[1]); w.w = cvt_pk_bf16(v1[2], v1[3]);
                        *(u32x4*)(rowp + bj * HALF) = w; }
                } else { const int pi = posidx_of_row(row);
                    const f32x4 cs = *(const f32x4*)(COS + pi * 16 + 4 * fq), sn = *(const f32x4*)(SIN + pi * 16 + 4 * fq);
#pragma unroll
                    for (int bj = 0; bj < 2; ++bj) { const f32x4 x1 = acc[ai][bj][m][0] * sc, x2 = acc[ai][bj][m][1] * sc;
                        const f32x4 o1 = x1 * cs - x2 * sn, o2 = x1 * sn + x2 * cs;
                        bf16_t* hp = QR + (size_t)row * 512 + ((u.pn - 4) * 8 + 4 * bj + wc) * 32 + 4 * fq;
                        u32x2 w1, w2; w1.x = cvt_pk_bf16(o1[0], o1[1]); w1.y = cvt_pk_bf16(o1[2], o1[3]); w2.x = cvt_pk_bf16(o2[0], o2[1]); w2.y = cvt_pk_bf16(o2[2], o2[3]);
                        *(u32x2*)hp = w1; *(u32x2*)(hp + 16) = w2; } }
            }
    }
};


struct EpiPartF32 {
    static constexpr bool PERM = true, AFTER_DRAIN = false;
    float* P; int ksub;
    __device__ __forceinline__ void operator()(const f32x4 (&acc)[2][2][4][2], const Unit& u, int wr, int wc, int fr, int fq) const {
        float* base = P + ((size_t)(u.koff / ksub) * 768 + (size_t)(u.pm - 64) * BM + wr * 64 + fr) * 1024 + u.pn * BM + wc * 32 + 8 * fq;
#pragma unroll
        for (int ai = 0; ai < 2; ++ai)
#pragma unroll
            for (int m = 0; m < 4; ++m) { float* rowp = base + (size_t)(ai * HALF + m * 16) * 1024;
#pragma unroll
                for (int bj = 0; bj < 2; ++bj) { *(f32x4*)(rowp + bj * HALF) = acc[ai][bj][m][0]; *(f32x4*)(rowp + bj * HALF + 4) = acc[ai][bj][m][1]; } }
    }
};
template <class Epi, class Sched, bool ALIGN_EPI = false, bool SP2 = false>
__device__ __forceinline__ void gemm_phase(PG8_LAS unsigned char* lds, const Gemm g, const Sched& S, const Epi& E, const int wave) {
    int wave_ = wave; asm volatile("" : "+s"(wave_)); wave_ &= 7;
    const int lane = lane_fresh(), tid = wave_ * 64 + lane, wid = wave_, wr = wid >> 2, wc = wid & 3, fr = lane & 15, fq = lane >> 4;
    const int K = g.K, nt = K / BK, ld = g.ld ? g.ld : g.K;
    unsigned voffA[2], voffB[2];
#pragma unroll
    for (int i = 0; i < 2; ++i) { int R, C; stage_rc(tid * 16 + i * 8192, R, C); const int Rb = Epi::PERM ? ((R & ~31) + perm32(R & 31)) : R;
        voffA[i] = (unsigned)(R * ld + C) * 2u; voffB[i] = (unsigned)(Rb * ld + C) * 2u; }
    const size_t kstep = (size_t)(BK * 2);
    const size_t hstep = (size_t)HALF * ld * 2;
    const size_t tstep = 2 * hstep;
    const unsigned ldsw = (unsigned)wid * 1024u;
    const int aoff = lds_byte(wr * 64 + fr, fq * 8), boff = lds_byte(wc * 32 + fr, fq * 8);
#define PG8_SA(b, h) (((b) * 2 + (h)) * HTB)
#define PG8_SB(b, h) ((4 + (b) * 2 + (h)) * HTB)
#define PG8_STAGE(bufoff, gbase, voff) do { _Pragma("unroll") for (int _i = 0; _i < 2; ++_i) \
        __builtin_amdgcn_global_load_lds((const unsigned*)((const char*)(gbase) + (voff)[_i]), (PG8_LAS unsigned*)(lds + (bufoff) + ldsw + _i * 8192), 16, 0, 0); } while (0)
#define PG8_LDA(dst, b, h) do { _Pragma("unroll") for (int m = 0; m < 4; ++m) _Pragma("unroll") for (int k = 0; k < 2; ++k) dst[m][k] = *(const PG8_LAS bf16x8*)(lds + PG8_SA(b, h) + aoff + m * 2048 + k * 1024); } while (0)
#define PG8_LDB(dst, b, h) do { _Pragma("unroll") for (int n = 0; n < 2; ++n) _Pragma("unroll") for (int k = 0; k < 2; ++k) dst[n][k] = *(const PG8_LAS bf16x8*)(lds + PG8_SB(b, h) + boff + n * 2048 + k * 1024); } while (0)
#define PG8_MMA(ai, bj, At, Bt) do { __builtin_amdgcn_s_setprio(1); _Pragma("unroll") for (int m = 0; m < 4; ++m) _Pragma("unroll") for (int n = 0; n < 2; ++n) _Pragma("unroll") for (int k = 0; k < 2; ++k) \
        acc[ai][bj][m][n] = __builtin_amdgcn_mfma_f32_16x16x32_bf16(Bt[n][k], At[m][k], acc[ai][bj][m][n], 0, 0, 0); __builtin_amdgcn_s_setprio(0); } while (0)
#define PG8_WAIT_V(n) asm volatile("s_waitcnt vmcnt(" #n ")" ::: "memory")
#define PG8_WAIT_L(n) asm volatile("s_waitcnt lgkmcnt(" #n ")" ::: "memory")
#define PG8_BAR __builtin_amdgcn_s_barrier()
#define PG8_SCHED __builtin_amdgcn_sched_barrier(0)
    Unit cur, nxt; int ui = 0;
    if (!S.next(0, cur)) return;
    f32x4 acc[2][2][4][2];
    float zf_ = 0.f; asm volatile("" : "+v"(zf_));
#pragma unroll
    for (int a = 0; a < 2; ++a)
#pragma unroll
        for (int b = 0; b < 2; ++b)
#pragma unroll
            for (int m = 0; m < 4; ++m)
#pragma unroll
                for (int n = 0; n < 2; ++n) acc[a][b][m][n] = (f32x4){zf_, zf_, zf_, zf_};
    bf16x8 At[4][2], B0[2][2], B1[2][2];
    const char* cA = (const char*)g.A + (size_t)cur.pm * tstep + (size_t)cur.koff * 2; const char* cB = (const char*)g.Bt + (size_t)cur.pn * tstep + (size_t)cur.koff * 2;
    S.a_ready(cur);
    if constexpr (SP2) {
        PG8_STAGE(PG8_SB(0, 0), cB, voffB); PG8_STAGE(PG8_SB(0, 1), cB + hstep, voffB); PG8_STAGE(PG8_SA(0, 0), cA, voffA); PG8_STAGE(PG8_SA(0, 1), cA + hstep, voffA);
        if (wr == 1) PG8_BAR;
        PG8_WAIT_V(2); PG8_BAR;
        PG8_STAGE(PG8_SB(1, 0), cB + kstep, voffB); PG8_STAGE(PG8_SA(1, 0), cA + kstep, voffA); PG8_STAGE(PG8_SB(1, 1), cB + hstep + kstep, voffB);
        PG8_WAIT_V(6); PG8_BAR;
    } else {
        PG8_STAGE(PG8_SB(0, 0), cB, voffB); PG8_STAGE(PG8_SA(0, 0), cA, voffA); PG8_STAGE(PG8_SB(0, 1), cB + hstep, voffB); PG8_STAGE(PG8_SA(0, 1), cA + hstep, voffA);
        if (wr == 1) PG8_BAR;
        PG8_WAIT_V(4); PG8_BAR;
        PG8_STAGE(PG8_SB(1, 0), cB + kstep, voffB); PG8_STAGE(PG8_SA(1, 0), cA + kstep, voffA); PG8_STAGE(PG8_SB(1, 1), cB + hstep + kstep, voffB);
        PG8_WAIT_V(6); PG8_BAR;
    }
    for (;;) {
        const bool has_next = S.next(ui + 1, nxt);
        const char* nA = has_next ? (const char*)g.A + (size_t)nxt.pm * tstep + (size_t)nxt.koff * 2 : cA; const char* nB = has_next ? (const char*)g.Bt + (size_t)nxt.pn * tstep + (size_t)nxt.koff * 2 : cB;
        for (int t = 0; t < nt; t += 2) {
            const bool last = (t == nt - 2);
            const char* a1 = cA + (size_t)(t + 1) * kstep;
            const char* a2 = last ? nA : cA + (size_t)(t + 2) * kstep; const char* b2 = last ? nB : cB + (size_t)(t + 2) * kstep;
            const char* a3 = a2 + kstep; const char* b3 = b2 + kstep;
            if (last && has_next) S.a_ready(nxt);
            if constexpr (SP2) {
            PG8_LDB(B0, 0, 0); PG8_LDB(B1, 0, 1); PG8_SCHED; PG8_LDA(At, 0, 0); PG8_STAGE(PG8_SA(1, 1), a1 + hstep, voffA);
            PG8_WAIT_V(8); PG8_WAIT_L(0); PG8_BAR; PG8_MMA(0, 0, At, B0); PG8_MMA(0, 1, At, B1); PG8_BAR; PG8_SCHED;
            PG8_LDA(At, 0, 1); PG8_STAGE(PG8_SB(0, 0), b2, voffB); PG8_STAGE(PG8_SB(0, 1), b2 + hstep, voffB); PG8_STAGE(PG8_SA(0, 0), a2, voffA);
            PG8_WAIT_V(8); PG8_WAIT_L(0); PG8_BAR; PG8_MMA(1, 0, At, B0); PG8_MMA(1, 1, At, B1); PG8_BAR; PG8_SCHED;
            PG8_LDB(B0, 1, 0); PG8_LDB(B1, 1, 1); PG8_SCHED; PG8_LDA(At, 1, 0); PG8_STAGE(PG8_SA(0, 1), a2 + hstep, voffA);
            PG8_WAIT_V(8); PG8_WAIT_L(0); PG8_BAR; PG8_MMA(0, 0, At, B0); PG8_MMA(0, 1, At, B1); PG8_BAR; PG8_SCHED;
            PG8_LDA(At, 1, 1); PG8_STAGE(PG8_SB(1, 0), b3, voffB); PG8_STAGE(PG8_SB(1, 1), b3 + hstep, voffB); PG8_STAGE(PG8_SA(1, 0), a3, voffA);
            PG8_WAIT_V(8); PG8_WAIT_L(0); PG8_BAR; PG8_MMA(1, 0, At, B0); PG8_MMA(1, 1, At, B1); PG8_BAR; PG8_SCHED;
            } else {
            PG8_LDB(B0, 0, 0); PG8_SCHED; PG8_LDA(At, 0, 0); PG8_STAGE(PG8_SA(1, 1), a1 + hstep, voffA);
            PG8_WAIT_L(8); PG8_BAR; PG8_WAIT_L(0); PG8_MMA(0, 0, At, B0); PG8_BAR; PG8_SCHED;
            PG8_LDB(B1, 0, 1); PG8_STAGE(PG8_SB(0, 0), b2, voffB);
            PG8_BAR; PG8_WAIT_L(0); PG8_MMA(0, 1, At, B1); PG8_BAR;
            PG8_LDA(At, 0, 1); PG8_STAGE(PG8_SA(0, 0), a2, voffA);
            PG8_BAR; PG8_WAIT_L(0); PG8_MMA(1, 0, At, B0); PG8_BAR; PG8_SCHED;
            PG8_STAGE(PG8_SB(0, 1), b2 + hstep, voffB);
            PG8_WAIT_V(6); PG8_BAR; PG8_MMA(1, 1, At, B1); PG8_BAR;
            PG8_LDB(B0, 1, 0); PG8_SCHED; PG8_LDA(At, 1, 0); PG8_STAGE(PG8_SA(0, 1), a2 + hstep, voffA);
            PG8_WAIT_L(8); PG8_BAR; PG8_WAIT_L(0); PG8_MMA(0, 0, At, B0); PG8_BAR; PG8_SCHED;
            PG8_LDB(B1, 1, 1); PG8_STAGE(PG8_SB(1, 0), b3, voffB);
            PG8_BAR; PG8_WAIT_L(0); PG8_MMA(0, 1, At, B1); PG8_BAR;
            PG8_LDA(At, 1, 1); PG8_STAGE(PG8_SA(1, 0), a3, voffA);
            PG8_BAR; PG8_WAIT_L(0); PG8_MMA(1, 0, At, B0); PG8_BAR; PG8_SCHED;
            PG8_STAGE(PG8_SB(1, 1), b3 + hstep, voffB);
            PG8_WAIT_V(6); PG8_BAR; PG8_MMA(1, 1, At, B1); PG8_BAR;
            }
        }
        if constexpr (ALIGN_EPI) { if (wr == 0) PG8_BAR; }
        if constexpr (!Epi::AFTER_DRAIN) { const int ln_ = lane_fresh(); const int fr_ = ln_ & 15, fq_ = ln_ >> 4;
            E(acc, cur, wr, wc, fr_, fq_); S.done(cur); }
        if (!has_next) break;
        float zg_ = 0.f; asm volatile("" : "+v"(zg_));
#pragma unroll
        for (int a = 0; a < 2; ++a)
#pragma unroll
            for (int b = 0; b < 2; ++b)
#pragma unroll
                for (int m = 0; m < 4; ++m)
#pragma unroll
                    for (int n = 0; n < 2; ++n) acc[a][b][m][n] = (f32x4){zg_, zg_, zg_, zg_};
        cur = nxt; cA = nA; cB = nB; ++ui;
        if constexpr (ALIGN_EPI) { if (wr == 1) PG8_BAR; }
    }
    PG8_WAIT_V(0);
    if constexpr (!ALIGN_EPI) { if (wr == 0) PG8_BAR; }
    PG8_BAR;
    if constexpr (Epi::AFTER_DRAIN) { E.fused(acc, cur, wr, wc, fr, fq, lds, wid, lane); S.done(cur); }
#undef PG8_SA
#undef PG8_SB
#undef PG8_STAGE
#undef PG8_LDA
#undef PG8_LDB
#undef PG8_MMA
#undef PG8_WAIT_V
#undef PG8_WAIT_L
#undef PG8_BAR
#undef PG8_SCHED
}
}
#define GAS __attribute__((address_space(1)))
#define LAS __attribute__((address_space(3)))
typedef unsigned short bf16;
typedef unsigned v4u __attribute__((ext_vector_type(4)));
typedef float f32x4 __attribute__((ext_vector_type(4)));
typedef short bf16x8 __attribute__((ext_vector_type(8)));
typedef GAS unsigned gu32;
typedef GAS unsigned long long gu64;
#define RLX_AGENT __ATOMIC_RELAXED, __HIP_MEMORY_SCOPE_AGENT
#define LDS_WAIT() asm volatile("s_waitcnt lgkmcnt(0)" ::: "memory")
#define VM_WAIT() asm volatile("s_waitcnt vmcnt(0)" ::: "memory")
__device__ __forceinline__ unsigned long long rt() { return __builtin_amdgcn_s_memrealtime(); }
__device__ __forceinline__ unsigned f2bf(float f) { unsigned u = __builtin_bit_cast(unsigned, f); return (u + 0x7fffu + ((u >> 16) & 1u)) >> 16; }
__device__ __forceinline__ unsigned pk2(float lo, float hi) { return f2bf(lo) | (f2bf(hi) << 16); }

#define XB_TMO      128
#define XB_XCNT(j)  (256  + 64 * (j))
#define XB_XSUB(j)  (1280 + 64 * (j))
#define XB_XGEN(j)  (2304 + 64 * (j))
#define XB_TOP      3328
#define XB_TOPGEN   3392
#define XCD_BAR_WORDS 3456
#define XB_SPIN_CAP (1u << 18)

__device__ __forceinline__ unsigned xb_ld(unsigned* p)              { return __hip_atomic_load(p, __ATOMIC_RELAXED, __HIP_MEMORY_SCOPE_AGENT); }
__device__ __forceinline__ unsigned xb_add(unsigned* p, unsigned v) { return __hip_atomic_fetch_add(p, v, __ATOMIC_RELAXED, __HIP_MEMORY_SCOPE_AGENT); }
__device__ __forceinline__ unsigned xb_xcc_id() { return (unsigned)__builtin_amdgcn_s_getreg((3 << 11) | 20) & 0xFu; }
#define XB_SPIN(cond, bar) do { unsigned _sp = 0; while (cond) { __builtin_amdgcn_s_sleep(1); \
    if ((++_sp & 255u) == 0u) { if (xb_ld(&(bar)[XB_TMO])) break; if (_sp > XB_SPIN_CAP) { atomicAdd(&(bar)[XB_TMO], 1u); break; } } } } while (0)

struct XcdBarrier {
    unsigned* bar; unsigned x;
    volatile LAS unsigned* st;
};

__device__ __forceinline__ XcdBarrier xcd_barrier_post(unsigned* bar, volatile LAS unsigned* st, const bool is_t0) {
    XcdBarrier b; b.bar = bar; b.x = xb_xcc_id(); b.st = st;
    if (is_t0) (void)xb_add(&bar[XB_XCNT(b.x)], 1u);
    return b;
}
__device__ __forceinline__ void xcd_barrier_complete(unsigned* bar, unsigned x, unsigned& nloc, unsigned& nx) {
    const unsigned G = gridDim.x * gridDim.y * gridDim.z;
    unsigned sum, cnt, mine, sp = 0u;
    for (;;) {
        sum = 0u; cnt = 0u; mine = 0u;
#pragma unroll
        for (unsigned j = 0; j < 16; ++j) { const unsigned c = xb_ld(&bar[XB_XCNT(j)]); sum += c; cnt += (c > 0u) ? 1u : 0u; mine = (j == x) ? c : mine; }
        if (sum == G) break;
        __builtin_amdgcn_s_sleep(1);
        if ((++sp & 255u) == 0u) { if (xb_ld(&bar[XB_TMO])) break; if (sp > XB_SPIN_CAP) { atomicAdd(&bar[XB_TMO], 1u); break; } }
    }
    nloc = mine > 0u ? mine : 1u; nx = cnt > 0u ? cnt : 1u;
}

__device__ __forceinline__ void xcd_barrier(const XcdBarrier& b, const bool is_t0) {
    asm volatile("s_waitcnt vmcnt(0)" ::: "memory");
    __syncthreads();
    if (is_t0) {
        unsigned* bar = b.bar;
        __builtin_amdgcn_s_waitcnt(0);
        unsigned nloc = b.st[0], nx = b.st[1];
        if (nloc == 0u) { xcd_barrier_complete(bar, b.x, nloc, nx); b.st[0] = nloc; b.st[1] = nx; }
        const unsigned old = xb_add(&bar[XB_XSUB(b.x)], 1u);
        const unsigned gen = old / nloc;
        if (old + 1u == (gen + 1u) * nloc) {
            __builtin_amdgcn_fence(__ATOMIC_RELEASE, "agent");
            asm volatile("s_waitcnt vmcnt(0)" ::: "memory");
            const unsigned og = xb_add(&bar[XB_TOP], 1u);
            const unsigned tg = og / nx;
            if (og + 1u == (tg + 1u) * nx) xb_add(&bar[XB_TOPGEN], 1u);
            else XB_SPIN(xb_ld(&bar[XB_TOPGEN]) == tg, bar);
            __builtin_amdgcn_fence(__ATOMIC_ACQUIRE, "agent");
            xb_add(&bar[XB_XGEN(b.x)], 1u);
            asm volatile("s_waitcnt vmcnt(0)" ::: "memory");
        } else {
            XB_SPIN(xb_ld(&bar[XB_XGEN(b.x)]) == gen, bar);
            __builtin_amdgcn_fence(__ATOMIC_ACQUIRE, "agent");
            asm volatile("s_waitcnt vmcnt(0)" ::: "memory");
        }
    }
    __syncthreads();
}

constexpr size_t MiB = 1u << 20;
constexpr size_t WS_CTL = 0, CTL_ZERO_BYTES = 64 * 1024;
constexpr int CW_BAR = 1024;
constexpr int CW_Q = 8192;
constexpr size_t WS_COS = 1 * MiB;
constexpr size_t WS_SIN = WS_COS + 512 * 1024;
constexpr size_t WS_WIN  = 2 * MiB;
constexpr size_t WS_WOC  = WS_WIN + 16 * MiB;
constexpr size_t WS_WA0  = WS_WOC + 4 * MiB;
constexpr size_t WS_WA1  = WS_WA0 + 4 * MiB;
constexpr size_t WS_WUKV = WS_WA1 + 3 * MiB;
constexpr size_t WS_WUQ  = WS_WUKV + 1 * MiB;
constexpr size_t WS_WOM  = WS_WUQ + 3 * MiB;
constexpr size_t WS_WUKB = WS_WOM + 4 * MiB;
constexpr size_t WS_ACT  = 40 * MiB;
constexpr size_t SZ_F32R = (size_t)NROWS * 1024 * 4, SZ_BFR = (size_t)NROWS * 1024 * 2;
constexpr size_t WS_X    = WS_ACT;
constexpr size_t WS_XH   = WS_X + SZ_F32R;
constexpr size_t WS_V1   = WS_XH + SZ_BFR;
constexpr size_t WS_GZ   = WS_V1 + SZ_BFR;
constexpr size_t WS_G    = WS_GZ + SZ_BFR;
constexpr size_t WS_MB   = WS_G + SZ_BFR;
constexpr size_t WS_CKR  = WS_MB + SZ_BFR;
constexpr size_t WS_CB   = WS_CKR + (size_t)NROWS * 512 * 4;
constexpr size_t WS_KRB  = WS_CB + (size_t)NROWS * 256 * 2;
constexpr size_t WS_KN   = WS_KRB + (size_t)NROWS * 32 * 2;
constexpr size_t WS_VV   = WS_KN + SZ_BFR;
constexpr size_t WS_QL   = WS_VV + SZ_BFR;
constexpr size_t WS_SSQ  = WS_QL + (size_t)NROWS * 512 * 2;
constexpr size_t WS_SZ   = WS_SSQ + (size_t)NROWS * 8 * 4;
constexpr size_t WS_QN   = WS_SZ + SZ_BFR;
constexpr size_t WS_QR   = WS_QN + SZ_BFR;
constexpr size_t WS_OG   = WS_QR + (size_t)NROWS * 512 * 2;
constexpr size_t WS_PART = WS_OG + SZ_BFR;
constexpr size_t WS_PML  = WS_PART + (size_t)DECB * 4 * 64 * 256 * 4;
constexpr size_t WS_QABS = WS_PML + (size_t)DECB * 4 * 2 * 64 * 4;
constexpr int GOUT_SPLITK = 8;
constexpr size_t WS_PARTG = WS_QABS + (size_t)DECB * 64 * 288 * 2;
constexpr size_t WS_END  = WS_PARTG + (size_t)GOUT_SPLITK * 768 * 1024 * 4;
static_assert(WS_WUKB + 1 * MiB <= WS_ACT && WS_END < 1024 * MiB, "d_ws map");

constexpr size_t O_YP = 0, O_YS = O_YP + (size_t)NB * SEQ * DM, O_CKP = O_YS + (size_t)NSAMP * DM, O_KRP = O_CKP + (size_t)NB * TTOT * KVL,
                 O_CVP = O_KRP + (size_t)NB * TTOT * QKR, O_CKS = O_CVP + (size_t)2 * NB * 2 * DM, O_KRS = O_CKS + (size_t)NSAMP * KVL,
                 O_CVS = O_KRS + (size_t)NSAMP * QKR, O_END = O_CVS + (size_t)2 * DECB * 2 * DM;

#ifndef TAIL_CONV
#define TAIL_CONV 1
#endif
constexpr size_t WS_RS = WS_XH;
constexpr int RING_BYTES = 131072;
constexpr int LDS_BYTES = 163840;
constexpr int LDSCTL_OFF = LDS_BYTES - 64;
constexpr int NWAVES = 8;

struct Args {
    const float* x_prompt; const float* x_sample; const float* cache_ckv; const float* cache_krope; const float* state_conv; const int* page_table;
    const float* meta; const float* pre_g; const float* post_g; const float* w_in_conv; const float* conv_w; const float* w_out_conv;
    const float* kv_norm_g; const float* w_dkv; const float* kv_lat_g; const float* w_uk; const float* w_uv; const float* w_in_mla;
    const float* q_norm_g; const float* w_uq; const float* w_out_mla;
    float* out; unsigned char* ws;
};

typedef unsigned short bf16;
typedef short bf16x8 __attribute__((ext_vector_type(8)));
typedef float f32x4 __attribute__((ext_vector_type(4)));
typedef float f32x8 __attribute__((ext_vector_type(8)));
typedef float f32x16 __attribute__((ext_vector_type(16)));
typedef unsigned u32x4 __attribute__((ext_vector_type(4)));
typedef unsigned u32x2 __attribute__((ext_vector_type(2)));
typedef short s16x4 __attribute__((ext_vector_type(4)));
#define LDS_WAIT() asm volatile("s_waitcnt lgkmcnt(0)" ::: "memory")
#define VM_WAIT() asm volatile("s_waitcnt vmcnt(0)" ::: "memory")
#define SBAR() __builtin_amdgcn_sched_barrier(0)
typedef float f32x2_t __attribute__((ext_vector_type(2))); typedef __bf16 bf16x2_t __attribute__((ext_vector_type(2)));
__device__ __forceinline__ unsigned cvtpk(float lo, float hi) { f32x2_t v = {lo, hi}; bf16x2_t b = __builtin_convertvector(v, bf16x2_t); return __builtin_bit_cast(unsigned, b); }
__device__ __forceinline__ float bf2f(unsigned short b) { return __uint_as_float((unsigned)b << 16); }
__device__ __forceinline__ float bflo(unsigned w) { return __uint_as_float(w << 16); }
__device__ __forceinline__ float bfhi(unsigned w) { return __uint_as_float(w & 0xffff0000u); }
__device__ __forceinline__ float wave_sum(float v, int lane) {
#pragma unroll
    for (int o = 1; o < 64; o <<= 1) v += shfl_xor_f(v, o, lane);
    return v;
}

template <class DestRow>
__device__ __forceinline__ void transpose_item(const float* __restrict__ W, int K, int N, const float* __restrict__ gain, bf16* WT, const DestRow& dest, LAS float* scr, int item, int lane) {
    const int nblk = N / 32, kb = item / nblk, nb = item % nblk, k0 = 64 * kb, n0 = 32 * nb;
#pragma unroll 8
    for (int i = 0; i < 32; ++i) { const int kk = 2 * i + (lane >> 5); float w = W[(size_t)(k0 + kk) * N + n0 + (lane & 31)]; if (gain) w *= gain[k0 + kk]; scr[kk * 33 + (lane & 31)] = w; }
    LDS_WAIT(); asm volatile("" ::: "memory");
    const int c = lane & 7;
#pragma unroll
    for (int j = 0; j < 4; ++j) { const int n = (lane >> 3) + 8 * j; const LAS float* s = scr + (8 * c) * 33 + n;
        u32x4 o; o.x = cvtpk(s[0 * 33], s[1 * 33]); o.y = cvtpk(s[2 * 33], s[3 * 33]); o.z = cvtpk(s[4 * 33], s[5 * 33]); o.w = cvtpk(s[6 * 33], s[7 * 33]);
        *(u32x4*)(WT + (size_t)dest(n0 + n) * K + k0 + 8 * c) = o; }
    LDS_WAIT(); asm volatile("" ::: "memory");
}
struct DestIdent { int off; __device__ __forceinline__ int operator()(int n) const { return off + n; } };
struct DestConvIn {
    __device__ __forceinline__ int operator()(int n) const { const int p = n >> 10, ch = n & 1023, cl = ch & 63; return (ch >> 6) * 256 + (p >> 1) * 128 + (cl >> 4) * 32 + ((cl >> 2) & 3) * 8 + (p & 1) * 4 + (cl & 3); } };
struct DestUq {
    __device__ __forceinline__ int operator()(int n) const { const int h = n / 96, t = n - h * 96; if (t < 64) return h * 64 + t; const int el = t - 64, i = el & 15;
        return 1024 + (h >> 3) * 256 + ((h & 7) >> 2) * 128 + (h & 3) * 32 + (i >> 2) * 8 + (el >> 4) * 4 + (i & 3); } };

__device__ __forceinline__ void x_row_store(const f32x4 (&v)[4], bf16* xrow, float* rs, int lane) {
    float s = 0.f;
#pragma unroll
    for (int j = 0; j < 4; ++j) s += (v[j].x * v[j].x + v[j].y * v[j].y) + (v[j].z * v[j].z + v[j].w * v[j].w);
    const float r = 1.0f / sqrtf(wave_sum(s, lane) * (1.0f / 1024.0f) + RMS_EPS);
    u32x2* o8 = (u32x2*)xrow + lane;
#pragma unroll
    for (int j = 0; j < 4; ++j) { u32x2 w; w.x = cvtpk(v[j].x, v[j].y); w.y = cvtpk(v[j].z, v[j].w); o8[64 * j] = w; }
    if (lane == 0) *rs = r;
}

template <class DestRow>
__device__ __forceinline__ void transpose_item64(const float* __restrict__ W, int K, int N, const float* __restrict__ gain, bf16* WT, const DestRow& dest, LAS float* scr, int item, int lane) {
    const int nblk = N / 64, kb = item / nblk, nb = item % nblk, k0 = 64 * kb, n0 = 64 * nb;
    float wv[64];
#pragma unroll
    for (int i = 0; i < 64; ++i) wv[i] = W[(size_t)(k0 + i) * N + n0 + lane];
#pragma unroll
    for (int i = 0; i < 64; ++i) { float w = wv[i]; if (gain) w *= gain[k0 + i]; scr[i * 65 + lane] = w; }
    LDS_WAIT(); asm volatile("" ::: "memory");
#pragma unroll
    for (int jj = 0; jj < 8; ++jj) { const int p = lane + 64 * jj, n = p >> 3, c = p & 7; const LAS float* s = scr + (8 * c) * 65 + n;
        u32x4 o; o.x = cvtpk(s[0 * 65], s[1 * 65]); o.y = cvtpk(s[2 * 65], s[3 * 65]); o.z = cvtpk(s[4 * 65], s[5 * 65]); o.w = cvtpk(s[6 * 65], s[7 * 65]);
        *(u32x4*)(WT + (size_t)dest(n0 + n) * K + k0 + 8 * c) = o; }
    LDS_WAIT(); asm volatile("" ::: "memory");
}
__device__ __forceinline__ void convert_set(const Args& A, const int set, LAS unsigned char* lds, int iw, int nw, int wave, int lane) {
    unsigned char* ws = A.ws;
    LAS float* scr = (LAS float*)(lds + wave * 16640);
    constexpr int I_WIN = 16 * 64, I_SQ = 16 * 16, I_DKV = (1024 / 64) * (288 / 32), I_INM = 16 * 24, I_UKV = 4 * 16, I_UQ = 8 * 24;
    if (set == 0 || set == 1) { const int l = set;
        for (int it = iw; it < I_WIN + I_SQ; it += nw) {
            if (it < I_WIN) transpose_item64(A.w_in_conv + (size_t)l * 1024 * 4096, 1024, 4096, A.pre_g + l * 1024, (bf16*)(ws + WS_WIN) + (size_t)l * 4096 * 1024, DestConvIn{}, scr, it, lane);
            else transpose_item64(A.w_out_conv + (size_t)l * 1024 * 1024, 1024, 1024, nullptr, (bf16*)(ws + WS_WOC) + (size_t)l * 1024 * 1024, DestIdent{0}, scr, it - I_WIN, lane); }
    } else if (set == 2) {
        for (int it = iw; it < I_DKV + 2 * I_INM; it += nw) {
            if (it < I_DKV) transpose_item(A.w_dkv, 1024, 288, A.kv_norm_g, (bf16*)(ws + WS_WA0), DestIdent{0}, scr, it, lane);
            else { const int r = it - I_DKV, j = r / I_INM; transpose_item64(A.w_in_mla + (size_t)j * 1024 * 1536, 1024, 1536, A.pre_g + (2 + j) * 1024, (bf16*)(ws + (j ? WS_WA1 : WS_WA0)), DestIdent{j ? 0 : 512}, scr, r % I_INM, lane); } }
        { unsigned z_ = 0u; asm volatile("" : "+v"(z_));
          for (int i = iw * 64 + lane; i < 224 * 128; i += nw * 64) ((u32x4*)((bf16*)(ws + WS_WA0) + 288 * 1024))[i] = (u32x4){z_, z_, z_, z_}; }
    } else if (set == 3) {
        for (int it = iw; it < 2 * I_UKV + 2 * I_UQ; it += nw) {
            if (it < 2 * I_UKV) { const int j = it / I_UKV; transpose_item64(j ? A.w_uv : A.w_uk, 256, 1024, nullptr, (bf16*)(ws + WS_WUKV), DestIdent{j * 1024}, scr, it % I_UKV, lane); }
            else { const int r = it - 2 * I_UKV, j = r / I_UQ; transpose_item64(A.w_uq + (size_t)j * 512 * 1536, 512, 1536, A.q_norm_g + j * 512, (bf16*)(ws + WS_WUQ) + (size_t)j * 1536 * 512, DestUq{}, scr, r % I_UQ, lane); } }
        for (int i = iw * 64 + lane; i < 256 * 1024 / 8; i += nw * 64) { const f32x4 a = ((const f32x4*)A.w_uk)[2 * i], b = ((const f32x4*)A.w_uk)[2 * i + 1];
            u32x4 w; w.x = cvtpk(a.x, a.y); w.y = cvtpk(a.z, a.w); w.z = cvtpk(b.x, b.y); w.w = cvtpk(b.z, b.w); ((u32x4*)(ws + WS_WUKB))[i] = w; }
    } else {
        for (int it = iw; it < 2 * I_SQ; it += nw) { const int j = it / I_SQ; transpose_item64(A.w_out_mla + (size_t)j * 1024 * 1024, 1024, 1024, nullptr, (bf16*)(ws + WS_WOM) + (size_t)j * 1024 * 1024, DestIdent{0}, scr, it % I_SQ, lane); }
    }
}

__device__ __forceinline__ void p0_prologue(const Args& A, LAS unsigned char* lds, int gw, int NGW, int wave, int lane) {
    unsigned char* ws = A.ws;
    convert_set(A, 0, lds, gw, NGW, wave, lane);
#if !TAIL_CONV
    convert_set(A, 1, lds, gw, NGW, wave, lane); convert_set(A, 2, lds, gw, NGW, wave, lane); convert_set(A, 3, lds, gw, NGW, wave, lane); convert_set(A, 4, lds, gw, NGW, wave, lane);
#endif
    for (int i = gw * 64 + lane; i < NPOS * 16; i += NGW * 64) { const int p = i >> 4, e = i & 15; const float pos = (float)(p < TTOT ? p : PAST + (p - TTOT));
        const float inv = powf(10000.0f, -(float)e / 16.0f); const float ang = pos * inv; ((float*)(ws + WS_COS))[i] = cosf(ang); ((float*)(ws + WS_SIN))[i] = sinf(ang); }
    for (int row0 = gw; row0 < NROWS; row0 += 4 * NGW) {
        f32x4 v[4][4];
#pragma unroll
        for (int k = 0; k < 4; ++k) { const int row = row0 + k * NGW < NROWS ? row0 + k * NGW : row0;
            const float* src = row < NMAIN ? A.x_prompt + (size_t)row * 1024 : (row < META0 ? A.x_sample + (size_t)(row - SAMP0) * 1024 : (row < META0 + NMETA ? A.meta + (size_t)(row - META0) * 1024 : nullptr));
#pragma unroll
            for (int j = 0; j < 4; ++j) v[k][j] = src ? ((const f32x4*)src)[lane + 64 * j] : (f32x4){0.f, 0.f, 0.f, 0.f}; }
#pragma unroll
        for (int k = 0; k < 4; ++k) { const int row = row0 + k * NGW; if (row < NROWS) {
            x_row_store(v[k], (bf16*)(ws + WS_X) + (size_t)row * 1024, (float*)(ws + WS_RS) + row, lane); } }
    }
}

__device__ __forceinline__ void conv_phase(const Args& A, int layer, int gw, int NGW, int lane) {
    unsigned char* ws = A.ws; const bf16* V = (const bf16*)(ws + WS_V1); const bf16* GZ = (const bf16*)(ws + WS_GZ); bf16* G = (bf16*)(ws + WS_G);
    const float* cw = A.conv_w + (size_t)layer * 3 * 1024;
    const int c0 = (gw & 1) * 512 + lane * 8, gr = gw >> 1, NGR = NGW >> 1;
    float w0[8], w1[8], w2[8];
#pragma unroll
    for (int k = 0; k < 2; ++k) { const f32x4 t0 = *(const f32x4*)(cw + c0 + 4 * k), t1 = *(const f32x4*)(cw + 1024 + c0 + 4 * k), t2 = *(const f32x4*)(cw + 2048 + c0 + 4 * k);
#pragma unroll
        for (int e = 0; e < 4; ++e) { w0[4 * k + e] = t0[e]; w1[4 * k + e] = t1[e]; w2[4 * k + e] = t2[e]; } }
    for (int row0 = gr; row0 < NROWS; row0 += 4 * NGR) {
        u32x4 v0[4], gz[4]; float a1[4][8], a2[4][8];
#pragma unroll
        for (int q = 0; q < 4; ++q) { const int row = row0 + q * NGR < NROWS ? row0 + q * NGR : row0;
            int r1, r2; const float* s1 = nullptr; const float* s2 = nullptr;
            if (row < NMAIN) { const int i = row & (SEQ - 1); r1 = i >= 1 ? row - 1 : META0 + 15; r2 = i >= 2 ? row - 2 : META0 + 14 + i; }
            else if (row < META0) { const int s = row - SAMP0, b = s >> 2, l = s & 3; const float* st = A.state_conv + ((size_t)layer * DECB + b) * 2 * 1024;
                if (l >= 1) r1 = row - 1; else { r1 = -2; s1 = st + 1024; }
                if (l >= 2) r2 = row - 2; else { r2 = -2; s2 = st + l * 1024; } }
            else if (row < META0 + NMETA) { const int j = row - META0; r1 = j >= 1 ? row - 1 : -1; r2 = j >= 2 ? row - 2 : -1; }
            else { r1 = -1; r2 = -1; }
            v0[q] = *(const u32x4*)(V + (size_t)row * 1024 + c0); gz[q] = *(const u32x4*)(GZ + (size_t)row * 1024 + c0);
            if (r1 >= 0) { const u32x4 t = *(const u32x4*)(V + (size_t)r1 * 1024 + c0);
#pragma unroll
                for (int k = 0; k < 4; ++k) { a1[q][2 * k] = bflo(t[k]); a1[q][2 * k + 1] = bfhi(t[k]); } }
            else if (r1 == -2) { const f32x4 t0 = *(const f32x4*)(s1 + c0), t1 = *(const f32x4*)(s1 + c0 + 4);
#pragma unroll
                for (int k = 0; k < 4; ++k) { a1[q][k] = t0[k]; a1[q][4 + k] = t1[k]; } }
            else {
#pragma unroll
                for (int k = 0; k < 8; ++k) a1[q][k] = 0.f; }
            if (r2 >= 0) { const u32x4 t = *(const u32x4*)(V + (size_t)r2 * 1024 + c0);
#pragma unroll
                for (int k = 0; k < 4; ++k) { a2[q][2 * k] = bflo(t[k]); a2[q][2 * k + 1] = bfhi(t[k]); } }
            else if (r2 == -2) { const f32x4 t0 = *(const f32x4*)(s2 + c0), t1 = *(const f32x4*)(s2 + c0 + 4);
#pragma unroll
                for (int k = 0; k < 4; ++k) { a2[q][k] = t0[k]; a2[q][4 + k] = t1[k]; } }
            else {
#pragma unroll
                for (int k = 0; k < 8; ++k) a2[q][k] = 0.f; } }
#pragma unroll
        for (int q = 0; q < 4; ++q) { const int row = row0 + q * NGR; if (row < NROWS) {
            float vc[8], gg[8], o[8];
#pragma unroll
            for (int k = 0; k < 4; ++k) { vc[2 * k] = bflo(v0[q][k]); vc[2 * k + 1] = bfhi(v0[q][k]); gg[2 * k] = bflo(gz[q][k]); gg[2 * k + 1] = bfhi(gz[q][k]); }
#pragma unroll
            for (int k = 0; k < 8; ++k) o[k] = gg[k] * (w0[k] * a2[q][k] + w1[k] * a1[q][k] + w2[k] * vc[k]);
            u32x4 w; w.x = cvtpk(o[0], o[1]); w.y = cvtpk(o[2], o[3]); w.z = cvtpk(o[4], o[5]); w.w = cvtpk(o[6], o[7]);
            *(u32x4*)(G + (size_t)row * 1024 + c0) = w;
            float* dst = nullptr;
            if (row < NMAIN) { const int i = row & (SEQ - 1), b = row >> 12; if (i >= SEQ - 2) dst = A.out + O_CVP + (((size_t)layer * NB + b) * 2 + (i - (SEQ - 2))) * 1024; }
            else if (row < META0) { const int s = row - SAMP0, b = s >> 2, l = s & 3; if (l >= 2) dst = A.out + O_CVS + (((size_t)layer * DECB + b) * 2 + (l - 2)) * 1024; }
            if (dst) { *(f32x4*)(dst + c0) = (f32x4){vc[0], vc[1], vc[2], vc[3]}; *(f32x4*)(dst + c0 + 4) = (f32x4){vc[4], vc[5], vc[6], vc[7]}; }
        } }
    }
}

__device__ __forceinline__ void norm_row_finish(const Args& A, int layer, int row, const f32x4 (&m)[4], const u32x2 (&xw)[4], const f32x4 (&g)[4], int lane) {
    unsigned char* ws = A.ws; float s = 0.f;
#pragma unroll
    for (int j = 0; j < 4; ++j) s += (m[j].x * m[j].x + m[j].y * m[j].y) + (m[j].z * m[j].z + m[j].w * m[j].w);
    const float r = 1.0f / sqrtf(wave_sum(s, lane) * (1.0f / 1024.0f) + RMS_EPS);
    f32x4 xn[4];
#pragma unroll
    for (int j = 0; j < 4; ++j) xn[j] = (f32x4){bflo(xw[j].x), bfhi(xw[j].x), bflo(xw[j].y), bfhi(xw[j].y)} + m[j] * r * g[j];
    if (layer == 3) { if (row < META0) {
#pragma unroll
            for (int j = 0; j < 4; ++j) ((f32x4*)(A.out + (size_t)row * 1024))[lane + 64 * j] = xn[j]; } }
    else x_row_store(xn, (bf16*)(ws + WS_X) + (size_t)row * 1024, (float*)(ws + WS_RS) + row, lane);
}
__device__ __forceinline__ void norm_phase(const Args& A, int layer, int gw, int NGW, int lane) {
    unsigned char* ws = A.ws; const bf16* MB = (const bf16*)(ws + WS_MB); const bf16* X = (const bf16*)(ws + WS_X); const float* pg = A.post_g + (size_t)layer * 1024;
    f32x4 g[4];
#pragma unroll
    for (int j = 0; j < 4; ++j) g[j] = ((const f32x4*)pg)[lane + 64 * j];
    for (int row0 = gw; row0 < NMAIN; row0 += 4 * NGW) {
        u32x2 mw[4][4], xw[4][4];
#pragma unroll
        for (int k = 0; k < 4; ++k) { const int row = row0 + k * NGW < NMAIN ? row0 + k * NGW : row0;
#pragma unroll
            for (int j = 0; j < 4; ++j) { mw[k][j] = ((const u32x2*)(MB + (size_t)row * 1024))[lane + 64 * j]; xw[k][j] = ((const u32x2*)(X + (size_t)row * 1024))[lane + 64 * j]; } }
#pragma unroll
        for (int k = 0; k < 4; ++k) { const int row = row0 + k * NGW; if (row < NMAIN) {
            f32x4 m[4];
#pragma unroll
            for (int j = 0; j < 4; ++j) m[j] = (f32x4){bflo(mw[k][j].x), bfhi(mw[k][j].x), bflo(mw[k][j].y), bfhi(mw[k][j].y)};
            norm_row_finish(A, layer, row, m, xw[k], g, lane); } }
    }
    const float* PG = (const float*)(ws + WS_PARTG);
    for (int row = NMAIN + gw; row < NROWS; row += NGW) {
        u32x2 xw[4]; f32x4 m[4];
#pragma unroll
        for (int j = 0; j < 4; ++j) xw[j] = ((const u32x2*)(X + (size_t)row * 1024))[lane + 64 * j];
#pragma unroll
        for (int s2 = 0; s2 < GOUT_SPLITK; s2 += 2) { f32x4 t0[4], t1[4];
#pragma unroll
            for (int j = 0; j < 4; ++j) { t0[j] = ((const f32x4*)(PG + ((size_t)s2 * 768 + (row - NMAIN)) * 1024))[lane + 64 * j]; t1[j] = ((const f32x4*)(PG + ((size_t)(s2 + 1) * 768 + (row - NMAIN)) * 1024))[lane + 64 * j]; }
#pragma unroll
            for (int j = 0; j < 4; ++j) m[j] = s2 == 0 ? t0[j] + t1[j] : m[j] + (t0[j] + t1[j]); }
        norm_row_finish(A, layer, row, m, xw, g, lane);
    }
}

__device__ __forceinline__ void latent_phase(const Args& A, int gw, int NGW, int lane) {
    unsigned char* ws = A.ws; const float* CKR = (const float*)(ws + WS_CKR); bf16* CB = (bf16*)(ws + WS_CB); bf16* KRB = (bf16*)(ws + WS_KRB);
    const float* COS = (const float*)(ws + WS_COS); const float* SIN = (const float*)(ws + WS_SIN);
    const f32x4 g = ((const f32x4*)A.kv_lat_g)[lane];
    for (int row0 = gw; row0 < NROWS; row0 += 4 * NGW) {
        f32x4 cc[4]; float x1[4], x2[4], cs[4], sn[4];
#pragma unroll
        for (int k = 0; k < 4; ++k) { const int row = row0 + k * NGW < NROWS ? row0 + k * NGW : row0; const int pi = pg8::posidx_of_row(row); const int l16 = lane & 15;
            cc[k] = ((const f32x4*)(CKR + (size_t)row * 512))[lane]; x1[k] = CKR[(size_t)row * 512 + 256 + l16]; x2[k] = CKR[(size_t)row * 512 + 272 + l16]; cs[k] = COS[pi * 16 + l16]; sn[k] = SIN[pi * 16 + l16]; }
#pragma unroll
        for (int k = 0; k < 4; ++k) { const int row = row0 + k * NGW; if (row < NROWS) {
            const f32x4 c = cc[k];
            const float r = 1.0f / sqrtf(wave_sum((c.x * c.x + c.y * c.y) + (c.z * c.z + c.w * c.w), lane) * (1.0f / 256.0f) + RMS_EPS);
            const f32x4 cn = c * r * g;
            u32x2 w; w.x = cvtpk(cn.x, cn.y); w.y = cvtpk(cn.z, cn.w); ((u32x2*)(CB + (size_t)row * 256))[lane] = w;
            const float o1 = x1[k] * cs[k] - x2[k] * sn[k], o2 = x1[k] * sn[k] + x2[k] * cs[k];
            if (lane < 16) { KRB[(size_t)row * 32 + lane] = (bf16)(cvtpk(o1, o1) & 0xffffu); KRB[(size_t)row * 32 + 16 + lane] = (bf16)(cvtpk(o2, o2) & 0xffffu); }
            if (row < NMAIN) { const int b = row >> 12, i = row & (SEQ - 1); const size_t t = (size_t)b * TTOT + NMETA + i;
                ((f32x4*)(A.out + O_CKP + t * KVL))[lane] = cn; if (lane < 16) { A.out[O_KRP + t * QKR + lane] = o1; A.out[O_KRP + t * QKR + 16 + lane] = o2; } }
            else if (row < META0) { const size_t t = row - SAMP0; ((f32x4*)(A.out + O_CKS + t * KVL))[lane] = cn; if (lane < 16) { A.out[O_KRS + t * QKR + lane] = o1; A.out[O_KRS + t * QKR + 16 + lane] = o2; } }
            else if (row < META0 + NMETA) { const int j = row - META0;
#pragma unroll
                for (int b = 0; b < NB; ++b) { const size_t t = (size_t)b * TTOT + j; ((f32x4*)(A.out + O_CKP + t * KVL))[lane] = cn; if (lane < 16) { A.out[O_KRP + t * QKR + lane] = o1; A.out[O_KRP + t * QKR + 16 + lane] = o2; } } }
        } }
    }
}

namespace ap {
constexpr int NW = 8, QBLK = 32, KVBLK = 64;
constexpr int SLOTB = 8192;
constexpr int NSLOT = 4;
constexpr int LDS_K = 0, LDS_V = NSLOT * SLOTB, LDS_R = 2 * NSLOT * SLOTB, OFF_WS = LDS_R + NSLOT * (SLOTB / 2), OFF_STG = OFF_WS + NW * 64 * 4, LDS_BYTES_AP = OFF_STG + NW * 8192;
constexpr float THR = 8.0f;
typedef __attribute__((address_space(3))) const char* lds_cptr;
typedef short v4i16_t __attribute__((ext_vector_type(4)));
__device__ __forceinline__ int crow(int r, int hi) { return (r & 3) + 8 * (r >> 2) + 4 * hi; }
#define PK4(P, BASE, OUT) do { unsigned a0 = cvtpk(P[BASE + 0], P[BASE + 1]), a1 = cvtpk(P[BASE + 2], P[BASE + 3]);   \
    unsigned b0 = cvtpk(P[BASE + 4], P[BASE + 5]), b1 = cvtpk(P[BASE + 6], P[BASE + 7]);                              \
    auto r0 = __builtin_amdgcn_permlane32_swap(a0, b0, false, false); auto r1 = __builtin_amdgcn_permlane32_swap(a1, b1, false, false); \
    u32x4 w = {r0[0], r1[0], r0[1], r1[1]}; OUT = *reinterpret_cast<bf16x8*>(&w); } while (0)
__device__ __forceinline__ void glds16(const void* sbase, unsigned voff, unsigned lds_base) {
    unsigned sv; asm volatile("s_mov_b32 %0, m0\n\ts_mov_b32 m0, %3\n\ts_nop 0\n\tglobal_load_lds_dwordx4 %1, %2\n\ts_mov_b32 m0, %0" : "=&s"(sv) : "v"(voff), "s"(sbase), "s"(lds_base) : "memory"); }
__device__ __forceinline__ void kload2(bf16x8* kf, lds_cptr kp, int j) { kf[2 * j] = *(const __attribute__((address_space(3))) bf16x8*)(kp + j * 2048); kf[2 * j + 1] = *(const __attribute__((address_space(3))) bf16x8*)(kp + j * 2048 + 512); }
__device__ __forceinline__ s16x4 vtr(lds_cptr p) { return __builtin_bit_cast(s16x4, __builtin_amdgcn_ds_read_tr16_b64_v4i16((__attribute__((address_space(3))) v4i16_t*)p)); }
__device__ __forceinline__ void mask_tile(f32x16& p0, f32x16& p1, int lim, int hi) {
    const int d = lim - 4 * hi;
#pragma unroll
    for (int r = 0; r < 16; ++r) { const int c = (r & 3) + 8 * (r >> 2); if (c > d) p0[r] = -INFINITY; if (c + 32 > d) p1[r] = -INFINITY; }
}
#define MFMA32(a, b, c) __builtin_amdgcn_mfma_f32_32x32x16_bf16(a, b, c, 0, 0, 0)
#define WAIT_BAR(N) asm volatile("s_waitcnt vmcnt(" #N ") lgkmcnt(0)\n\ts_barrier" ::: "memory")
#define PIN(x) asm volatile("" : "+v"(x))
#define MX3(a, b, c) __builtin_fmaxf(__builtin_fmaxf((a), (b)), (c))
__device__ __forceinline__ float rowmax(const f32x16& p0, const f32x16& p1) {
    float a = MX3(p0[0], p0[1], p1[0]), b = MX3(p0[2], p0[3], p1[1]); a = MX3(a, p1[2], p1[3]);
#pragma unroll
    for (int r = 4; r < 16; r += 4) { a = MX3(a, p0[r], p0[r + 1]); b = MX3(b, p0[r + 2], p0[r + 3]); a = MX3(a, p1[r], p1[r + 1]); b = MX3(b, p1[r + 2], p1[r + 3]); }
    float m = __builtin_fmaxf(a, b); auto rr = __builtin_amdgcn_permlane32_swap(__float_as_uint(m), __float_as_uint(m), false, false);
    return __builtin_fmaxf(__uint_as_float(rr[0]), __uint_as_float(rr[1])); }

__device__ __forceinline__ void attn_unit(unsigned char* ws_, int b_, int h_, int qb_, bool meta_, char* lds, const int wave) {
    unsigned char* ws = opaque_global(ws_); int wid = wave; asm volatile("" : "+s"(wid));
    const bf16* __restrict__ QN = (const bf16*)(ws + WS_QN); const bf16* __restrict__ QR = (const bf16*)(ws + WS_QR); const bf16* __restrict__ KN = (const bf16*)(ws + WS_KN);
    const bf16* __restrict__ KRB = (const bf16*)(ws + WS_KRB); const bf16* __restrict__ VV = (const bf16*)(ws + WS_VV);
    const int b = __builtin_amdgcn_readfirstlane(b_), h = __builtin_amdgcn_readfirstlane(h_), qb = __builtin_amdgcn_readfirstlane(qb_); const bool meta = __builtin_amdgcn_readfirstlane((int)meta_) != 0;
    const int lane = lane_fresh(), r32 = lane & 31, hi = lane >> 5;
    const unsigned lds0 = (unsigned)(uintptr_t)lds; const lds_cptr lds3 = (lds_cptr)lds;
    float* wsf = (float*)(lds + OFF_WS) + wid * 64;
    const int qrow0 = meta ? META0 : b * SEQ + qb * 256;
    const int NT = meta ? 1 : 4 * qb + 5;
    const int qrel = wid * QBLK + r32;
    const size_t krow1 = (size_t)b * SEQ;
    const bf16* ksrc = KN + krow1 * 1024 + h * 64 + wid * 8;
    const bf16* rsrc = KRB + krow1 * 32 + (wid & 3) * 8;
    const bf16* vsrc = VV + (krow1 + 16 * (wid & 3)) * 1024 + h * 64 + (wid >> 2) * 32;
    const unsigned kdst = lds0 + LDS_K + wid * 1024, vdst = lds0 + LDS_V + wid * 1024, rdst = lds0 + LDS_R + (wid & 3) * 1024;
#define KOFF ((unsigned)lane * 2048u)
#define ROFF ((unsigned)lane * 64u)
#define VOFF ((unsigned)(lane >> 2) * 2048u + (unsigned)(lane & 3) * 16u)
#define RFL(x) ((unsigned)__builtin_amdgcn_readfirstlane((int)(x)))
#define SLOT(t) (((t) & (NSLOT - 1)) * SLOTB)
#define DMA_K(t) glds16(ksrc + (long)((t) - 1) * (KVBLK * 1024), KOFF, RFL(kdst + SLOT(t)))
#define DMA_V(t) glds16(vsrc + (long)((t) - 1) * (KVBLK * 1024), VOFF, RFL(vdst + SLOT(t)))
#define DMA_R(t) do { if (wid < 4) glds16(rsrc + (long)((t) - 1) * (KVBLK * 32), ROFF, RFL(rdst + (SLOT(t) >> 1))); } while (0)
#define WAITB(a, b) do { if (wid < 4) { WAIT_BAR(a); } else { WAIT_BAR(b); } } while (0)
    const lds_cptr kp0 = lds3 + LDS_K + hi * 1024 + r32 * 16, rp0 = lds3 + LDS_R + hi * 1024 + r32 * 16;
    const lds_cptr vp0 = lds3 + LDS_V + ((lane >> 4) & 1) * 32 + (lane & 3) * 8 + (4 * hi + ((lane & 15) >> 2)) * 64;
    glds16(KN + (size_t)META0 * 1024 + h * 64 + wid * 8, KOFF, RFL(kdst));
    if (wid < 4) glds16(KRB + (size_t)META0 * 32 + (wid & 3) * 8, ROFF, RFL(rdst));
    glds16(VV + ((size_t)META0 + 16 * (wid & 3)) * 1024 + h * 64 + (wid >> 2) * 32, VOFF, RFL(vdst));
    if (NT > 1) { DMA_K(1); DMA_R(1); DMA_V(1); DMA_K(2); DMA_R(2); DMA_K(3); }
    bf16x8 qr[6];
    { const size_t qrow = (size_t)(qrow0 + wid * QBLK + r32);
#pragma unroll
      for (int d0 = 0; d0 < 4; ++d0) qr[d0] = *reinterpret_cast<const bf16x8*>(QN + qrow * 1024 + h * 64 + d0 * 16 + hi * 8);
#pragma unroll
      for (int d0 = 0; d0 < 2; ++d0) qr[4 + d0] = *reinterpret_cast<const bf16x8*>(QR + qrow * 512 + h * 32 + d0 * 16 + hi * 8); }
    float mhat = 0.f, l_reg = 0.f; f32x16 o[2]; o[0] = f32x16{}; o[1] = f32x16{}; f32x16 negm = f32x16{}; PIN(negm);
    bool resc = false;
    f32x16 pA0, pA1, pB0, pB1; bf16x8 kf[8], kr[4]; s16x4 vlo[8], vhi[8]; u32x4 pw0, pw1, pw2, pw3;
#define RESC() do { if (resc) { asm volatile("s_waitcnt lgkmcnt(0)" ::: "memory"); _Pragma("unroll") for (int d_ = 0; d_ < 2; ++d_) _Pragma("unroll") for (int r = 0; r < 16; ++r) o[d_][r] *= wsf[crow(r, hi)]; } } while (0)
    if (NT > 1) { WAITB(7, 5); } else { WAIT_BAR(0); }
    _Pragma("unroll") for (int j = 0; j < 4; ++j) kload2(kf, kp0, j);
    _Pragma("unroll") for (int j = 0; j < 2; ++j) kload2(kr, rp0, j);
    pA0 = MFMA32(kf[0], qr[0], negm); pA1 = MFMA32(kf[1], qr[0], negm); pA0 = MFMA32(kf[2], qr[1], pA0); pA1 = MFMA32(kf[3], qr[1], pA1);
    pA0 = MFMA32(kf[4], qr[2], pA0); pA1 = MFMA32(kf[5], qr[2], pA1); pA0 = MFMA32(kf[6], qr[3], pA0); pA1 = MFMA32(kf[7], qr[3], pA1);
    pA0 = MFMA32(kr[0], qr[4], pA0); pA1 = MFMA32(kr[1], qr[4], pA1); pA0 = MFMA32(kr[2], qr[5], pA0); pA1 = MFMA32(kr[3], qr[5], pA1);
    mask_tile(pA0, pA1, meta ? (qrel < 15 ? qrel : 15) : 15, hi);
    { const float rm = rowmax(pA0, pA1); mhat = rm;
#pragma unroll
      for (int r = 0; r < 16; ++r) { pA0[r] -= rm; pA1[r] -= rm; }
#pragma unroll
      for (int r = 0; r < 16; ++r) negm[r] = -mhat;
      PIN(negm);
#pragma unroll
      for (int r = 0; r < 16; ++r) { pA0[r] = __builtin_amdgcn_exp2f(pA0[r]); pA1[r] = __builtin_amdgcn_exp2f(pA1[r]); } }
    WAIT_BAR(0);
    if (NT > 1) {
        DMA_K(4); DMA_R(3); DMA_V(2);
        _Pragma("unroll") for (int j = 0; j < 4; ++j) kload2(kf, kp0 + SLOT(1), j);
        WAITB(3, 2);
    }
#define PKW(P, i) cvtpk(P[i], P[i + 1])
#define PAF(k) __builtin_bit_cast(bf16x8, pw##k)
#define VFR(i) (bf16x8){vlo[i][0], vlo[i][1], vlo[i][2], vlo[i][3], vhi[i][0], vhi[i][1], vhi[i][2], vhi[i][3]}
#define VRD(i) do { vlo[i] = vtr(vp_ + (((i) >> 2) * 4096 + ((i) & 3) * 1024)); vhi[i] = vtr(vp_ + (((i) >> 2) * 4096 + ((i) & 3) * 1024 + 512)); } while (0)
#define KRD(G, j) do { if (G) { kload2(kf, kp_, j); SBAR(); } } while (0)
#define GAPA(MF, a0, a1, a2, a3, W0, W1, PW) do { MF; sacc += a0; sacc += a1; sacc += a2; sacc += a3; PIN(sacc); W0; W1; PIN(PW); SBAR(); } while (0)
#define GAPR(MF) do { MF; SBAR(); } while (0)
#define EX(v) __builtin_amdgcn_exp2f(v)
#define GAPB(MF, X, i) do { MF; X[i] = EX(X[i]); X[i + 1] = EX(X[i + 1]); X[i + 2] = EX(X[i + 2]); X[i + 3] = EX(X[i + 3]); PIN(X); SBAR(); } while (0)
#define STEP(C0, C1, P0, P1, t, MSK, GK, GR, GV, GL) do { SBAR(); \
    const lds_cptr vp_ = vp0 + SLOT((t) - 1); const lds_cptr rp_ = rp0 + (SLOT(t) >> 1); const lds_cptr kp_ = kp0 + SLOT((t) + 1); \
    VRD(0); SBAR(); float sacc = P0[0] + P0[1]; \
                    GAPA(C0 = MFMA32(kf[0], qr[0], negm), P0[2], P0[3], P0[4], P0[5],     pw0[0] = PKW(P0, 0),  pw0[1] = PKW(P0, 2),  pw0); \
    VRD(4); SBAR(); GAPA(C1 = MFMA32(kf[1], qr[0], negm), P0[6], P0[7], P0[8], P0[9],     pw0[2] = PKW(P0, 4),  pw0[3] = PKW(P0, 6),  pw0); \
    VRD(1); SBAR(); GAPA(C0 = MFMA32(kf[2], qr[1], C0),   P0[10], P0[11], P0[12], P0[13], pw1[0] = PKW(P0, 8),  pw1[1] = PKW(P0, 10), pw1); \
    VRD(5); SBAR(); GAPA(C1 = MFMA32(kf[3], qr[1], C1),   P0[14], P0[15], P1[0], P1[1],   pw1[2] = PKW(P0, 12), pw1[3] = PKW(P0, 14), pw1); \
    kload2(kf, rp_, 0); VRD(2); SBAR(); GAPA(C0 = MFMA32(kf[4], qr[2], C0),   P1[2], P1[3], P1[4], P1[5],     pw2[0] = PKW(P1, 0),  pw2[1] = PKW(P1, 2),  pw2); \
    kload2(kf, rp_, 1); VRD(6); SBAR(); GAPA(C1 = MFMA32(kf[5], qr[2], C1),   P1[6], P1[7], P1[8], P1[9],     pw2[2] = PKW(P1, 4),  pw2[3] = PKW(P1, 6),  pw2); \
    VRD(3); SBAR(); GAPA(C0 = MFMA32(kf[6], qr[3], C0),   P1[10], P1[11], P1[12], P1[13], pw3[0] = PKW(P1, 8),  pw3[1] = PKW(P1, 10), pw3); \
    VRD(7); SBAR(); GAPA(C1 = MFMA32(kf[7], qr[3], C1),   P1[14], P1[15], 0.f, 0.f,       pw3[2] = PKW(P1, 12), pw3[3] = PKW(P1, 14), pw3); \
    GAPR(C0 = MFMA32(kf[0], qr[4], C0)); GAPR(C1 = MFMA32(kf[1], qr[4], C1)); GAPR(C0 = MFMA32(kf[2], qr[5], C0)); GAPR(C1 = MFMA32(kf[3], qr[5], C1)); \
    l_reg += sacc; \
    if (GK) DMA_K((t) + 4); if (GR) DMA_R((t) + 3); if (GV) DMA_V((t) + 2);            \
    if (MSK) mask_tile(C0, C1, qrel - 64 * ((t) - (NT - 4)), hi); \
    { const float rm = rowmax(C0, C1); resc = false;                                                              \
      if (__builtin_expect(__any(rm > THR), 0)) { const float dl = __builtin_fmaxf(rm, 0.f); mhat += dl;          \
          _Pragma("unroll") for (int r = 0; r < 16; ++r) { C0[r] -= dl; C1[r] -= dl; } \
          _Pragma("unroll") for (int r = 0; r < 16; ++r) negm[r] = -mhat; \
          PIN(negm); \
          const float f = __builtin_amdgcn_exp2f(-dl); l_reg *= f; if (hi == 0) wsf[r32] = f; resc = true; } } \
    SBAR(); \
    GAPB(o[0] = MFMA32(PAF(0), VFR(0), o[0]), C0, 0);              GAPB(o[1] = MFMA32(PAF(0), VFR(4), o[1]), C0, 4); \
    KRD(GL, 0); GAPB(o[0] = MFMA32(PAF(1), VFR(1), o[0]), C0, 8);  KRD(GL, 1); GAPB(o[1] = MFMA32(PAF(1), VFR(5), o[1]), C0, 12); \
    KRD(GL, 2); GAPB(o[0] = MFMA32(PAF(2), VFR(2), o[0]), C1, 0);  KRD(GL, 3); GAPB(o[1] = MFMA32(PAF(2), VFR(6), o[1]), C1, 4); \
    GAPB(o[0] = MFMA32(PAF(3), VFR(3), o[0]), C1, 8);              GAPB(o[1] = MFMA32(PAF(3), VFR(7), o[1]), C1, 12); \
    } while (0)
    int t = 1;
    for (; t + 5 < NT; t += 2) {
        STEP(pB0, pB1, pA0, pA1, t, false, true, true, true, true);     WAITB(6, 4); RESC();
        STEP(pA0, pA1, pB0, pB1, t + 1, false, true, true, true, true); WAITB(6, 4); RESC();
    }
    if (NT > 1) {
        STEP(pB0, pB1, pA0, pA1, t, true, false, true, true, true);       WAITB(5, 3); RESC();
        STEP(pA0, pA1, pB0, pB1, t + 1, true, false, false, true, true);  WAITB(3, 2); RESC();
        STEP(pB0, pB1, pA0, pA1, t + 2, true, false, false, false, true); WAIT_BAR(1); RESC();
        STEP(pA0, pA1, pB0, pB1, t + 3, true, false, false, false, false); WAIT_BAR(0); RESC();
    }
    { float sacc = pA0[0] + pA0[1];
#pragma unroll
      for (int r = 2; r < 16; ++r) sacc += pA0[r];
#pragma unroll
      for (int r = 0; r < 16; ++r) sacc += pA1[r];
      l_reg += sacc;
      pw0 = (u32x4){PKW(pA0, 0), PKW(pA0, 2), PKW(pA0, 4), PKW(pA0, 6)}; pw1 = (u32x4){PKW(pA0, 8), PKW(pA0, 10), PKW(pA0, 12), PKW(pA0, 14)};
      pw2 = (u32x4){PKW(pA1, 0), PKW(pA1, 2), PKW(pA1, 4), PKW(pA1, 6)}; pw3 = (u32x4){PKW(pA1, 8), PKW(pA1, 10), PKW(pA1, 12), PKW(pA1, 14)};
      const lds_cptr vp_ = vp0 + SLOT(NT - 1); _Pragma("unroll") for (int i = 0; i < 8; ++i) VRD(i);
      o[0] = MFMA32(PAF(0), VFR(0), o[0]); o[1] = MFMA32(PAF(0), VFR(4), o[1]); o[0] = MFMA32(PAF(1), VFR(1), o[0]); o[1] = MFMA32(PAF(1), VFR(5), o[1]);
      o[0] = MFMA32(PAF(2), VFR(2), o[0]); o[1] = MFMA32(PAF(2), VFR(6), o[1]); o[0] = MFMA32(PAF(3), VFR(3), o[0]); o[1] = MFMA32(PAF(3), VFR(7), o[1]); }
    { auto rr = __builtin_amdgcn_permlane32_swap(__float_as_uint(l_reg), __float_as_uint(l_reg), false, false); l_reg = __uint_as_float(rr[0]) + __uint_as_float(rr[1]); }
    if (hi == 0) wsf[32 + r32] = l_reg; asm volatile("s_waitcnt lgkmcnt(0)" ::: "memory");
    { float* stg = (float*)(lds + OFF_STG) + wid * 2048;
#pragma unroll
      for (int r = 0; r < 16; ++r) { const int orow = crow(r, hi); const float rl = __builtin_amdgcn_rcpf(wsf[32 + orow]);
#pragma unroll
          for (int d0 = 0; d0 < 2; ++d0) stg[orow * 64 + d0 * 32 + r32] = o[d0][r] * rl; }
      asm volatile("s_waitcnt lgkmcnt(0)" ::: "memory");
      const bf16* __restrict__ SZ = (const bf16*)(ws + WS_SZ); bf16* __restrict__ OG = (bf16*)(ws + WS_OG);
      u32x4 zz[4];
#pragma unroll
      for (int i = 0; i < 4; ++i) { const int row = i * 8 + (lane >> 3), ch = lane & 7; zz[i] = *(const u32x4*)(SZ + (size_t)(qrow0 + wid * QBLK + row) * 1024 + h * 64 + ch * 8); }
#pragma unroll
      for (int i = 0; i < 4; ++i) { const int row = i * 8 + (lane >> 3), ch = lane & 7; const f32x4 a = *(const f32x4*)(stg + row * 64 + ch * 8), c = *(const f32x4*)(stg + row * 64 + ch * 8 + 4);
          u32x4 w; w.x = cvtpk(a[0] * bflo(zz[i].x), a[1] * bfhi(zz[i].x)); w.y = cvtpk(a[2] * bflo(zz[i].y), a[3] * bfhi(zz[i].y)); w.z = cvtpk(c[0] * bflo(zz[i].z), c[1] * bfhi(zz[i].z)); w.w = cvtpk(c[2] * bflo(zz[i].w), c[3] * bfhi(zz[i].w));
          *(u32x4*)(OG + (size_t)(qrow0 + wid * QBLK + row) * 1024 + h * 64 + ch * 8) = w; } }
    asm volatile("s_waitcnt lgkmcnt(0)\n\ts_barrier" ::: "memory");
#undef RFL
#undef KOFF
#undef ROFF
#undef VOFF
#undef DMA_K
#undef DMA_V
#undef DMA_R
#undef WAITB
#undef SLOT
#undef RESC
#undef PKW
#undef PAF
#undef VFR
#undef VRD
#undef KRD
#undef GAPA
#undef GAPR
#undef EX
#undef GAPB
#undef STEP
}
#undef MFMA32
#undef WAIT_BAR
#undef PIN
#undef MX3
}

namespace as {
constexpr int IMG_HALF = 16384, IMG_ROPE = 32768, IMG_BYTES = 36864;
constexpr int OFF_Q = 0, OFF_K0 = IMG_BYTES, OFF_WS = OFF_K0 + 3 * IMG_BYTES, LDS_BYTES_AS = OFF_WS + 8 * 64 * 4 + 8 * 64 * 4;
constexpr float THR = 8.0f;
constexpr int NTILE = 2 * AS_PAGES;
__device__ __forceinline__ unsigned off_a(unsigned row, unsigned ch) { return 2048u * (row >> 3) + 512u * (ch >> 2) + 64u * (row & 7) + 16u * ((ch & 3) ^ ((row >> 2) & 3)); }
__device__ __forceinline__ unsigned off_rope(unsigned row, unsigned ch) { return IMG_ROPE + 64u * row + 16u * (ch ^ ((row >> 2) & 3)); }
__device__ __forceinline__ unsigned img_off(unsigned row, unsigned c8) { return c8 < 32 ? (c8 >> 4) * IMG_HALF + off_a(row, c8 & 15) : off_rope(row, c8 - 32); }
__device__ __forceinline__ s16x4 tr_read_dyn(unsigned addr) { s16x4 r; asm volatile("ds_read_b64_tr_b16 %0, %1" : "=&v"(r) : "v"(addr) : "memory"); return r; }

__device__ __forceinline__ void attn_s_unit(const Args& A, int b, int s, char* lds, const int wave) {
    unsigned char* ws = opaque_global(A.ws);
    const int lane = lane_fresh(), wid = wave, tid = wave * 64 + lane, r32 = lane & 31, hi = lane >> 5;
    const int qg = wid & 1, kh = (wid >> 1) & 1, chh = wid >> 2;
    const int* pt = A.page_table + (size_t)b * NPAGES + s * AS_PAGES;
    float* wsf = (float*)(lds + OFF_WS) + wid * 64;
    struct Stage { f32x4 c[8]; f32x4 r; } sA, sB;
#define TLOAD(S, t) do { const int t_ = (t) < NTILE ? (t) : NTILE - 1; const int pg_ = __builtin_amdgcn_readfirstlane(pgl[t_ >> 1]); const size_t k0_ = (size_t)pg_ * PAGE + (t_ & 1) * 64; \
    const int live_ = (t) < NTILE ? 1 : 0;        \
    const float* cb_ = A.cache_ckv + (k0_ + wid) * KVL + live_ * lane * 4; const float* rb_ = A.cache_krope + k0_ * QKR + live_ * tid * 4; \
    _Pragma("unroll") for (int i_ = 0; i_ < 8; ++i_) S.c[i_] = __builtin_nontemporal_load((const f32x4*)(cb_ + (size_t)(live_ * 8 * i_) * KVL)); S.r = __builtin_nontemporal_load((const f32x4*)rb_); } while (0)
#define TWRITE(bufoff, S) do { _Pragma("unroll") for (int i_ = 0; i_ < 8; ++i_) { u32x2 w_; w_.x = cvtpk(S.c[i_][0], S.c[i_][1]); w_.y = cvtpk(S.c[i_][2], S.c[i_][3]); \
        *(u32x2*)(lds + (bufoff) + img_off(8 * i_ + wid, lane >> 1) + (lane & 1) * 8) = w_; } \
    { const int rrow_ = tid >> 3, rc4 = tid & 7; u32x2 w_; w_.x = cvtpk(S.r[0], S.r[1]); w_.y = cvtpk(S.r[2], S.r[3]); *(u32x2*)(lds + (bufoff) + off_rope(rrow_, rc4 >> 1) + (rc4 & 1) * 8) = w_; } } while (0)
    __attribute__((address_space(3))) int* pgl = (__attribute__((address_space(3))) int*)(lds + OFF_WS + 2048) + wid * 64;
    if (lane < AS_PAGES) pgl[lane] = pt[lane];
    asm volatile("s_waitcnt vmcnt(0) lgkmcnt(0)" ::: "memory");
    TLOAD(sA, 0); TLOAD(sB, 1);
    {
        const bf16* QN = (const bf16*)(ws + WS_QN); const bf16* QR = (const bf16*)(ws + WS_QR); const bf16* WUKB = (const bf16*)(ws + WS_WUKB);
        bf16* QABS = (bf16*)(ws + WS_QABS) + (size_t)b * 64 * 288;
        const size_t qrow0 = (size_t)(SAMP0 + b * 4);
        const int l15 = lane & 15, l4 = lane >> 4, tok = l15 & 3;
#pragma unroll 1
        for (int hh = 0; hh < 2; ++hh) { const int h = 2 * wid + hh;
            const bf16x8 bq0 = *(const bf16x8*)(QN + (qrow0 + tok) * 1024 + h * 64 + 8 * l4), bq1 = *(const bf16x8*)(QN + (qrow0 + tok) * 1024 + h * 64 + 32 + 8 * l4);
#pragma unroll 4
            for (int nt = 0; nt < 16; ++nt) { const bf16* wp = WUKB + (size_t)(nt * 16 + l15) * 1024 + h * 64 + 8 * l4;
                const bf16x8 a0 = *(const bf16x8*)wp, a1 = *(const bf16x8*)(wp + 32);
                f32x4 acc = (f32x4){0.f, 0.f, 0.f, 0.f};
                acc = __builtin_amdgcn_mfma_f32_16x16x32_bf16(a0, bq0, acc, 0, 0, 0);
                acc = __builtin_amdgcn_mfma_f32_16x16x32_bf16(a1, bq1, acc, 0, 0, 0);
                if (l15 < 4) { const int q = l15 * 16 + h, c0 = nt * 16 + l4 * 4; u32x2 w; w.x = cvtpk(acc[0], acc[1]); w.y = cvtpk(acc[2], acc[3]);
                    *(u32x2*)(lds + OFF_Q + img_off(q, c0 >> 3) + (c0 & 7) * 2) = w; if (s == 0) *(u32x2*)(QABS + (size_t)q * 288 + c0) = w; } }
        }
        if (tid < 256) { const int q = tid >> 2, c = tid & 3; const u32x4 w = *(const u32x4*)(QR + (qrow0 + (q >> 4)) * 512 + (q & 15) * 32 + c * 8);
            *(u32x4*)(lds + OFF_Q + off_rope(q, c)) = w; if (s == 0) *(u32x4*)(QABS + (size_t)q * 288 + 256 + c * 8) = w; }
    }
    unsigned kaddr[2], qaddr[2], kraddr, qraddr;
    { const unsigned krow = kh * 32 + r32, qrow = qg * 32 + r32;
#pragma unroll
      for (int od = 0; od < 2; ++od) { kaddr[od] = off_a(krow, 2 * od + hi); qaddr[od] = OFF_Q + off_a(qrow, 2 * od + hi); }
      kraddr = off_rope(krow, hi); qraddr = OFF_Q + off_rope(qrow, hi); }
    const unsigned kr2 = IMG_ROPE + 64u * (kh * 32 + r32) + 16u * ((2 + hi) ^ (((kh * 32 + r32) >> 2) & 3)), qr2 = OFF_Q + IMG_ROPE + 64u * (qg * 32 + r32) + 16u * ((2 + hi) ^ (((qg * 32 + r32) >> 2) & 3));
    unsigned vaddr[2];
    { const unsigned blk = (lane >> 4) & 1, q = (lane & 15) >> 2, p = lane & 3;
#pragma unroll
      for (int t = 0; t < 2; ++t) vaddr[t] = chh * IMG_HALF + off_a(32 * kh + 8 * hi + 4 * t + q, 2 * blk + (p >> 1)) + 8 * (p & 1); }
    float m_reg = -1e30f, l_reg = 0.f; f32x16 o[4] = {};
    const unsigned ldsb = (unsigned)(uintptr_t)lds;
#define KQ_LD(X, pp) do { constexpr unsigned so_ = 512u * ((pp) & 3) + (unsigned)IMG_HALF * ((pp) >> 2); \
        k##X##0 = *(const bf16x8*)(lds + bo_ + kaddr[0] + so_); q##X##0 = *(const bf16x8*)(lds + qaddr[0] + so_); k##X##1 = *(const bf16x8*)(lds + bo_ + kaddr[1] + so_); q##X##1 = *(const bf16x8*)(lds + qaddr[1] + so_); } while (0)
#define KQ_LDR(X) do { k##X##0 = *(const bf16x8*)(lds + bo_ + kraddr); q##X##0 = *(const bf16x8*)(lds + qraddr); k##X##1 = *(const bf16x8*)(lds + bo_ + kr2); q##X##1 = *(const bf16x8*)(lds + qr2); } while (0)
#define KQ_MM(X) do { p = __builtin_amdgcn_mfma_f32_32x32x16_bf16(k##X##0, q##X##0, p, 0, 0, 0); p = __builtin_amdgcn_mfma_f32_32x32x16_bf16(k##X##1, q##X##1, p, 0, 0, 0); } while (0)
#define PV_RD(X, nt) do { v##X##0 = tr_read_dyn(ldsb + bo_ + vaddr[0] + 512 * (nt)); v##X##1 = tr_read_dyn(ldsb + bo_ + vaddr[1] + 512 * (nt)); \
        v##X##2 = tr_read_dyn(ldsb + bo_ + vaddr[0] + 512 * (nt) + 4096); v##X##3 = tr_read_dyn(ldsb + bo_ + vaddr[1] + 512 * (nt) + 4096); } while (0)
#define PV_MM(X, nt) do { o[nt] = __builtin_amdgcn_mfma_f32_32x32x16_bf16(pa0, ((bf16x8){v##X##0[0], v##X##0[1], v##X##0[2], v##X##0[3], v##X##1[0], v##X##1[1], v##X##1[2], v##X##1[3]}), o[nt], 0, 0, 0); \
        o[nt] = __builtin_amdgcn_mfma_f32_32x32x16_bf16(pa1, ((bf16x8){v##X##2[0], v##X##2[1], v##X##2[2], v##X##2[3], v##X##3[0], v##X##3[1], v##X##3[2], v##X##3[3]}), o[nt], 0, 0, 0); } while (0)
#define LGKM_WAIT(N) do { asm volatile("s_waitcnt lgkmcnt(" #N ")" ::: "memory"); SBAR(); } while (0)
#define COMPUTE(bufoff) do { f32x16 p = f32x16{}; const unsigned bo_ = (bufoff); bf16x8 kA0, qA0, kA1, qA1, kB0, qB0, kB1, qB1; \
    KQ_LD(A, 0); KQ_LD(B, 1); SBAR(); KQ_MM(A); KQ_LD(A, 2); SBAR(); KQ_MM(B); KQ_LD(B, 3); SBAR(); KQ_MM(A); KQ_LD(A, 4); SBAR(); KQ_MM(B); KQ_LD(B, 5); SBAR(); \
    KQ_MM(A); KQ_LD(A, 6); SBAR(); KQ_MM(B); KQ_LD(B, 7); SBAR(); KQ_MM(A); KQ_LDR(A); SBAR(); KQ_MM(B); SBAR(); KQ_MM(A); SBAR(); \
    float pmax = p[0]; _Pragma("unroll") for (int r = 1; r < 16; ++r) pmax = fmaxf(pmax, p[r]); \
    { auto rr = __builtin_amdgcn_permlane32_swap(__float_as_uint(pmax), __float_as_uint(pmax), false, false); pmax = fmaxf(__uint_as_float(rr[0]), __uint_as_float(rr[1])); } \
    float alpha = 1.f; \
    if (!__all(pmax - m_reg <= THR)) { const float mn = fmaxf(m_reg, pmax); alpha = __builtin_amdgcn_exp2f(m_reg - mn); m_reg = mn; \
        if (hi == 0) wsf[r32] = alpha; asm volatile("s_waitcnt lgkmcnt(0)" ::: "memory"); \
        _Pragma("unroll") for (int n = 0; n < 4; ++n) _Pragma("unroll") for (int r = 0; r < 16; ++r) o[n][r] *= wsf[ap::crow(r, hi)]; } \
    s16x4 vA0, vA1, vA2, vA3, vB0, vB1, vB2, vB3; asm volatile("s_waitcnt lgkmcnt(0)" ::: "memory"); SBAR(); PV_RD(A, 0); SBAR();        \
    float ps = 0.f; _Pragma("unroll") for (int r = 0; r < 16; ++r) { p[r] = __builtin_amdgcn_exp2f(p[r] - m_reg); ps += p[r]; } \
    { auto rr = __builtin_amdgcn_permlane32_swap(__float_as_uint(ps), __float_as_uint(ps), false, false); ps = __uint_as_float(rr[0]) + __uint_as_float(rr[1]); } \
    l_reg = l_reg * alpha + ps; \
    bf16x8 pa0, pa1; PK4(p, 0, pa0); PK4(p, 8, pa1); SBAR(); \
    PV_RD(B, 1); LGKM_WAIT(4); PV_MM(A, 0); SBAR(); PV_RD(A, 2); LGKM_WAIT(4); PV_MM(B, 1); SBAR(); PV_RD(B, 3); LGKM_WAIT(4); PV_MM(A, 2); SBAR(); LGKM_WAIT(0); PV_MM(B, 3); SBAR(); } while (0)
    TWRITE(OFF_K0, sA); TLOAD(sA, 2); TWRITE(OFF_K0 + IMG_BYTES, sB); TLOAD(sB, 3); __syncthreads();
    { unsigned bc = OFF_K0, bn = OFF_K0 + IMG_BYTES, bw = OFF_K0 + 2 * IMG_BYTES;
#pragma unroll 1
      for (int t = 0; t < NTILE; t += 2) {
        SBAR(); COMPUTE(bc); SBAR();
        TWRITE(bw, sA); TLOAD(sA, t + 4);
        __syncthreads();
        { const unsigned x_ = bc; bc = bn; bn = bw; bw = x_; }
        SBAR(); COMPUTE(bc); SBAR();
        TWRITE(bw, sB); TLOAD(sB, t + 5);
        __syncthreads();
        { const unsigned x_ = bc; bc = bn; bn = bw; bw = x_; }
      } }
    { float* xo = (float*)lds + (size_t)(chh * 2 + qg) * 4096;
      float* xml = (float*)(lds + 65536) + (chh * 2 + qg) * 128;
      if (kh == 1) {
#pragma unroll
          for (int nt = 0; nt < 4; ++nt)
#pragma unroll
              for (int r = 0; r < 16; ++r) xo[(nt * 16 + r) * 64 + lane] = o[nt][r];
          xml[lane] = m_reg; xml[64 + lane] = l_reg; }
      __syncthreads();
      if (kh == 0) {
          const float m2 = xml[lane], l2 = xml[64 + lane]; const float mn = fmaxf(m_reg, m2); const float a1 = __builtin_amdgcn_exp2f(m_reg - mn), a2 = __builtin_amdgcn_exp2f(m2 - mn);
          l_reg = l_reg * a1 + l2 * a2; m_reg = mn;
          if (hi == 0) { wsf[r32] = a1; wsf[32 + r32] = a2; } asm volatile("s_waitcnt lgkmcnt(0)" ::: "memory");
          float* PO = (float*)(ws + WS_PART) + ((size_t)(b * 4 + s) * 64) * 256; float* PML = (float*)(ws + WS_PML) + (size_t)(b * 4 + s) * 128;
#pragma unroll
          for (int nt = 0; nt < 4; ++nt)
#pragma unroll
              for (int r = 0; r < 16; ++r) { const int qr_ = ap::crow(r, hi); PO[(size_t)(qg * 32 + qr_) * 256 + chh * 128 + nt * 32 + r32] = o[nt][r] * wsf[qr_] + xo[(nt * 16 + r) * 64 + lane] * wsf[32 + qr_]; }
          if (chh == 0 && hi == 0) { PML[qg * 32 + r32] = m_reg; PML[64 + qg * 32 + r32] = l_reg; } }
    }
    __syncthreads();
#undef TLOAD
#undef TWRITE
#undef COMPUTE
#undef KQ_LD
#undef KQ_LDR
#undef KQ_MM
#undef PV_RD
#undef PV_MM
#undef LGKM_WAIT
}
#undef PK4
#undef PKV
#undef KSWZ
}

__device__ __forceinline__ void comb_unit(const Args& A, int b, int hq, char* lds, const int wave) {
    unsigned char* ws = A.ws; const int tid = wave * 64 + lane_fresh(), lq = tid >> 5, l = lq >> 2, h = hq * 4 + (lq & 3), j = tid & 31, q = l * 16 + h;
    const bf16* QABS = (const bf16*)(ws + WS_QABS) + ((size_t)b * 64 + q) * 288; const bf16* CB = (const bf16*)(ws + WS_CB); const bf16* KRB = (const bf16*)(ws + WS_KRB);
    const float* PO = (const float*)(ws + WS_PART) + ((size_t)b * 4 * 64 + q) * 256; const float* PML = (const float*)(ws + WS_PML) + (size_t)b * 4 * 128;
    float* olds = (float*)lds;
    float qv[8], qrv[8];
    { const u32x4 w = *(const u32x4*)(QABS + j * 8);
#pragma unroll
      for (int k = 0; k < 4; ++k) { qv[2 * k] = bflo(w[k]); qv[2 * k + 1] = bfhi(w[k]); }
      u32x4 wr = (u32x4){0u, 0u, 0u, 0u}; if (j < 4) wr = *(const u32x4*)(QABS + 256 + j * 8);
#pragma unroll
      for (int k = 0; k < 4; ++k) { qrv[2 * k] = bflo(wr[k]); qrv[2 * k + 1] = bfhi(wr[k]); } }
    float sc[4], cn[4][8];
#pragma unroll
    for (int jn = 0; jn < 4; ++jn) { const size_t row = (size_t)(SAMP0 + b * 4 + jn); const u32x4 w = *(const u32x4*)(CB + row * 256 + j * 8); float d = 0.f;
#pragma unroll
        for (int k = 0; k < 4; ++k) { cn[jn][2 * k] = bflo(w[k]); cn[jn][2 * k + 1] = bfhi(w[k]); d += qv[2 * k] * cn[jn][2 * k] + qv[2 * k + 1] * cn[jn][2 * k + 1]; }
        if (j < 4) { const u32x4 wr = *(const u32x4*)(KRB + row * 32 + j * 8);
#pragma unroll
            for (int k = 0; k < 4; ++k) d += qrv[2 * k] * bflo(wr[k]) + qrv[2 * k + 1] * bfhi(wr[k]); }
#pragma unroll
        for (int o = 1; o < 32; o <<= 1) d = d + shfl_xor_f(d, o, tid & 63);
        sc[jn] = jn <= l ? d : -INFINITY; }
    float mp[4], lp[4], M = -INFINITY;
#pragma unroll
    for (int p = 0; p < AS_SPLITS; ++p) { mp[p] = PML[p * 128 + q]; lp[p] = PML[p * 128 + 64 + q]; M = fmaxf(M, mp[p]); }
#pragma unroll
    for (int jn = 0; jn < 4; ++jn) M = fmaxf(M, sc[jn]);
    float L = 0.f, acc[8];
#pragma unroll
    for (int k = 0; k < 8; ++k) acc[k] = 0.f;
#pragma unroll
    for (int p = 0; p < AS_SPLITS; ++p) { const float w = __builtin_amdgcn_exp2f(mp[p] - M); L += w * lp[p]; const f32x4 a = *(const f32x4*)(PO + (size_t)p * 64 * 256 + j * 8), c = *(const f32x4*)(PO + (size_t)p * 64 * 256 + j * 8 + 4);
#pragma unroll
        for (int k = 0; k < 4; ++k) { acc[k] += w * a[k]; acc[4 + k] += w * c[k]; } }
#pragma unroll
    for (int jn = 0; jn < 4; ++jn) { const float w = __builtin_amdgcn_exp2f(sc[jn] - M); L += w;
#pragma unroll
        for (int k = 0; k < 8; ++k) acc[k] += w * cn[jn][k]; }
    const float rl = 1.0f / L;
    *(f32x4*)(olds + lq * 256 + j * 8) = (f32x4){acc[0] * rl, acc[1] * rl, acc[2] * rl, acc[3] * rl}; *(f32x4*)(olds + lq * 256 + j * 8 + 4) = (f32x4){acc[4] * rl, acc[5] * rl, acc[6] * rl, acc[7] * rl};
    __syncthreads();
    const bf16* WUV = (const bf16*)(ws + WS_WUKV) + (size_t)(1024 + h * 64 + 2 * j) * 256;
    float o0 = 0.f, o1 = 0.f;
    for (int c = 0; c < 256; c += 8) { const u32x4 w0 = *(const u32x4*)(WUV + c), w1 = *(const u32x4*)(WUV + 256 + c); const f32x4 x0 = *(const f32x4*)(olds + lq * 256 + c), x1 = *(const f32x4*)(olds + lq * 256 + c + 4);
        o0 += x0[0] * bflo(w0[0]) + x0[1] * bfhi(w0[0]) + x0[2] * bflo(w0[1]) + x0[3] * bfhi(w0[1]) + x1[0] * bflo(w0[2]) + x1[1] * bfhi(w0[2]) + x1[2] * bflo(w0[3]) + x1[3] * bfhi(w0[3]);
        o1 += x0[0] * bflo(w1[0]) + x0[1] * bfhi(w1[0]) + x0[2] * bflo(w1[1]) + x0[3] * bfhi(w1[1]) + x1[0] * bflo(w1[2]) + x1[1] * bfhi(w1[2]) + x1[2] * bflo(w1[3]) + x1[3] * bfhi(w1[3]); }
    const size_t orow = (size_t)(SAMP0 + b * 4 + l) * 1024 + h * 64 + 2 * j;
    const unsigned z = *(const unsigned*)((const bf16*)(ws + WS_SZ) + orow);
    *(unsigned*)((bf16*)(ws + WS_OG) + orow) = cvtpk(o0 * bflo(z), o1 * bfhi(z));
    __syncthreads();
}
constexpr int N_AS_ITEMS = DECB * AS_SPLITS;
#ifndef PREF_DIV
#define PREF_DIV 4
#endif
#ifndef PREF_XCD
#define PREF_XCD 0
#endif
#ifndef PREF_NUM
#define PREF_NUM 2
#endif
#ifndef ARGS_RELOAD
#define ARGS_RELOAD 1
#endif
#ifndef REP_BAR
#define REP_BAR 1
#endif
#ifndef REP_ELT
#define REP_ELT 1
#endif
#ifndef TAIL_CONV
#define TAIL_CONV 1
#endif
#ifndef STATIC_SCHED
#define STATIC_SCHED 0
#endif
#ifndef REP_AS
#define REP_AS 1
#endif
#ifndef REP_AP
#define REP_AP 1
#endif
#ifndef REP_GEMM
#define REP_GEMM 1
#endif
#ifndef EN_P0
#define EN_P0 1
#endif
#ifndef EN_G1
#define EN_G1 1
#endif
#ifndef EN_CONV
#define EN_CONV 1
#endif
#ifndef EN_G4
#define EN_G4 1
#endif
#ifndef EN_LAT
#define EN_LAT 1
#endif
#ifndef EN_G5
#define EN_G5 1
#endif
#ifndef EN_G6
#define EN_G6 1
#endif
#ifndef EN_AP
#define EN_AP 1
#endif
#ifndef EN_AS
#define EN_AS 1
#endif
#ifndef EN_COMB
#define EN_COMB 1
#endif
#ifndef EN_GOUT
#define EN_GOUT 1
#endif
#ifndef EN_NORM
#define EN_NORM 1
#endif

__device__ __forceinline__ Args fresh_args() {
    const __attribute__((address_space(4))) unsigned long long* p = (const __attribute__((address_space(4))) unsigned long long*)__builtin_amdgcn_kernarg_segment_ptr();
    asm volatile("" : "+s"(p));
#define GP(T, i) ((T*)(__attribute__((address_space(1))) T*)p[i])
    Args a;
    a.x_prompt = GP(const float, 0); a.x_sample = GP(const float, 1); a.cache_ckv = GP(const float, 2); a.cache_krope = GP(const float, 3); a.state_conv = GP(const float, 4); a.page_table = GP(const int, 5);
    a.meta = GP(const float, 6); a.pre_g = GP(const float, 7); a.post_g = GP(const float, 8); a.w_in_conv = GP(const float, 9); a.conv_w = GP(const float, 10); a.w_out_conv = GP(const float, 11);
    a.kv_norm_g = GP(const float, 12); a.w_dkv = GP(const float, 13); a.kv_lat_g = GP(const float, 14); a.w_uk = GP(const float, 15); a.w_uv = GP(const float, 16); a.w_in_mla = GP(const float, 17);
    a.q_norm_g = GP(const float, 18); a.w_uq = GP(const float, 19); a.w_out_mla = GP(const float, 20); a.out = GP(float, 21); a.ws = GP(unsigned char, 22);
#undef GP
    return a;
}
static_assert(sizeof(Args) == 23 * 8, "Args = 23 pointers, no padding: fresh_args() reads them by index");
__global__ void __launch_bounds__(NWAVES * 64, 2) yoco_fwd(Args args_unused_directly) {
    extern __shared__ __attribute__((aligned(16))) unsigned char lds[];
    LAS unsigned char* ldsl = (LAS unsigned char*)lds;
    const int wave = __builtin_amdgcn_readfirstlane(threadIdx.x >> 6) & 7;
#define LANE_OPAQUE() const int lane = lane_fresh()
#define IS_T0() (wave == 0 && lane_fresh() == 0)
#if ARGS_RELOAD
#define PHASE_ARGS() const Args args = fresh_args(); unsigned char* const ws = args.ws; (void)ws; PHASE_IDS()
#else
#define PHASE_ARGS() Args args = args_unused_directly; asm volatile("" : "+s"(args.ws), "+s"(args.out)); unsigned char* const ws = args.ws; (void)ws; PHASE_IDS()
#endif
    const int G0 = gridDim.x, bx0 = blockIdx.x;
#define PHASE_IDS() int G = G0, bx = bx0; asm volatile("" : "+s"(G), "+s"(bx)); const int vcu = (G % 8 == 0) ? (bx % 8) * (G / 8) + bx / 8 : bx; const int gw = vcu * NWAVES + wave, NGW = G * NWAVES; (void)vcu; (void)gw; (void)NGW
    { const int t_ = wave * 64 + lane_fresh(); if (t_ < 8) ((LAS unsigned*)(ldsl + LDSCTL_OFF))[t_] = 0u; }
    __syncthreads();
    { PHASE_ARGS(); (void)xcd_barrier_post((unsigned*)(ws + WS_CTL) + CW_BAR, (volatile LAS unsigned*)(ldsl + LDSCTL_OFF), IS_T0()); }
#define GRID_BAR() do { PHASE_ARGS(); XcdBarrier b_; b_.bar = (unsigned*)(ws + WS_CTL) + CW_BAR; b_.x = xb_xcc_id(); b_.st = (volatile LAS unsigned*)(ldsl + LDSCTL_OFF); for (int rb_ = 0; rb_ < REP_BAR; ++rb_) xcd_barrier(b_, IS_T0()); } while (0)
#if EN_P0
    { PHASE_ARGS(); LANE_OPAQUE(); for (int re_ = 0; re_ < REP_ELT; ++re_) p0_prologue(args, ldsl, gw, NGW, wave, lane); }
#endif
    GRID_BAR();

#pragma unroll 1
    for (int l = 0; l < 4; ++l) {
        if (l < 2) {
            { PHASE_ARGS(); pg8::Gemm g{(const bf16*)(ws + WS_X), (const bf16*)(ws + WS_WIN) + (size_t)l * 4096 * 1024, NROWS, 4096, 1024}; pg8::RepOrder<REP_GEMM> S; S.init(NROWS, 4096, G, bx);
              pg8::EpiConvSplit E{(bf16*)(ws + WS_V1), (bf16*)(ws + WS_GZ), (const float*)(ws + WS_RS)};
#if EN_G1
              pg8::gemm_phase<pg8::EpiConvSplit, pg8::RepOrder<REP_GEMM>, true, true>(ldsl, g, S, E, wave);
#endif
              { constexpr int r_ = (67 * 16) % 256; if (TAIL_CONV && G == 256 && bx >= r_) { LANE_OPAQUE(); convert_set(args, l == 0 ? 1 : 3, ldsl, (bx - r_) * NWAVES + wave, (256 - r_) * NWAVES, wave, lane); }
                else if (TAIL_CONV && G != 256 && l == 0) { LANE_OPAQUE(); convert_set(args, 1, ldsl, gw, NGW, wave, lane); convert_set(args, 3, ldsl, gw, NGW, wave, lane); } }
 }
            GRID_BAR();
#if EN_CONV
            { PHASE_ARGS(); LANE_OPAQUE(); for (int re_ = 0; re_ < REP_ELT; ++re_) conv_phase(args, l, gw, NGW, lane); }
#endif
            GRID_BAR();
        } else {
            const int j = l - 2;
            { PHASE_ARGS(); pg8::Gemm g{(const bf16*)(ws + WS_X), (const bf16*)(ws + (j ? WS_WA1 : WS_WA0)), NROWS, j ? 1536 : 2048, 1024}; pg8::RepOrder<REP_GEMM> S; S.init(NROWS, j ? 1536 : 2048, G, bx);
              pg8::EpiMlaIn E{(float*)(ws + WS_CKR), (bf16*)(ws + WS_QL), (float*)(ws + WS_SSQ), (bf16*)(ws + WS_SZ), j ? 0 : 2, (const float*)(ws + WS_RS)};
#if EN_G4
              pg8::gemm_phase<pg8::EpiMlaIn, pg8::RepOrder<REP_GEMM>, true, true>(ldsl, g, S, E, wave);
#endif
 }
            GRID_BAR();
            if (j == 0) {
#if EN_LAT
                { PHASE_ARGS(); LANE_OPAQUE(); for (int re_ = 0; re_ < REP_ELT; ++re_) latent_phase(args, gw, NGW, lane); }
#endif
                GRID_BAR();
                { PHASE_ARGS(); pg8::Gemm g{(const bf16*)(ws + WS_CB), (const bf16*)(ws + WS_WUKV), NROWS, 2048, 256}; pg8::RepOrder<REP_GEMM> S; S.init(NROWS, 2048, G, bx);
                  pg8::EpiBf16 E{(bf16*)(ws + WS_KN), 1024, 1024, (size_t)(WS_VV - WS_KN) / 2};
#if EN_G5
                  pg8::gemm_phase<pg8::EpiBf16, pg8::RepOrder<REP_GEMM>, true, true>(ldsl, g, S, E, wave);
#endif
 }
            }
            { PHASE_ARGS(); pg8::Gemm g{(const bf16*)(ws + WS_QL), (const bf16*)(ws + WS_WUQ) + (size_t)j * 1536 * 512, NROWS, 1536, 512}; pg8::RepOrder<REP_GEMM> S; S.init(NROWS, 1536, G, bx);
              pg8::EpiQUp E{(bf16*)(ws + WS_QN), (bf16*)(ws + WS_QR), (const float*)(ws + WS_SSQ), (const float*)(ws + WS_COS), (const float*)(ws + WS_SIN)};
#if EN_G6
              pg8::gemm_phase<pg8::EpiQUp, pg8::RepOrder<REP_GEMM>, true, true>(ldsl, g, S, E, wave);
#endif
 }
            GRID_BAR();
            {
                PHASE_ARGS();
                unsigned* qh = (unsigned*)(ws + WS_CTL) + CW_Q + j * 16 * 64;
                volatile LAS int* slot = (volatile LAS int*)(ldsl + LDSCTL_OFF + 16);
                const int myq = bx & 7; const bool prefS = PREF_XCD ? ((bx & 7) < PREF_NUM) : (((bx >> 3) % PREF_DIV) < PREF_NUM);
                bool s_open = true, own_open = true; unsigned steal = 0xffffffffu;
#define DEQUEUE(dst, word) do { if (IS_T0()) *slot = (int)__hip_atomic_fetch_add(qh + (word) * 64, 1u, __ATOMIC_RELAXED, __HIP_MEMORY_SCOPE_AGENT); __syncthreads(); dst = *slot; __syncthreads(); } while (0)
#pragma unroll 1
                for (;;) {
                    int type = -1, id = 0, q = 0;
                    if (prefS && s_open) { DEQUEUE(id, 8); if (id < N_AS_ITEMS * REP_AS) type = 0; else s_open = false; }
                    if (type < 0 && own_open) { q = myq; DEQUEUE(id, q); if (id < 130 * REP_AP) { id = id % 130; type = id < 128 ? 1 : 2; } else own_open = false; }
                    if (type < 0 && s_open) { DEQUEUE(id, 8); if (id < N_AS_ITEMS * REP_AS) type = 0; else s_open = false; }
                    if (type < 0) {
                        if (steal == 0xffffffffu) { if (IS_T0()) { unsigned m_ = 0u;
#pragma unroll
                                for (int k_ = 0; k_ < 8; ++k_) if (__hip_atomic_load(qh + k_ * 64, __ATOMIC_RELAXED, __HIP_MEMORY_SCOPE_AGENT) < 130u * REP_AP) m_ |= 1u << k_;
                                *slot = (int)m_; } __syncthreads(); steal = (unsigned)*slot & ~(1u << myq); __syncthreads(); }
                        while (steal) { q = __builtin_ctz(steal); DEQUEUE(id, q); if (id < 130 * REP_AP) { id = id % 130; type = id < 128 ? 1 : 2; break; } steal &= ~(1u << q); }
                    }
                    if (type < 0) break;
#if EN_AS
                    if (type == 0) { id = id % N_AS_ITEMS; as::attn_s_unit(args, id / AS_SPLITS, id % AS_SPLITS, (char*)lds, wave); }
#endif
#if EN_AP
                    if (type >= 1) { const bool mt = type == 2; const int bh = q * 8 + (id & 7);
                        ap::attn_unit(ws, mt ? 0 : bh >> 4, mt ? q * 2 + (id - 128) : bh & 15, mt ? 0 : 15 - (id >> 3), mt, (char*)lds, wave); }
#endif
                }
#undef DEQUEUE
            }
            GRID_BAR();
#if EN_COMB
            { PHASE_ARGS(); for (int u = vcu; u < NSAMP * REP_ELT; u += G) comb_unit(args, (u % NSAMP) >> 2, u & 3, (char*)lds, wave); }
#endif
            GRID_BAR();
        }
        { PHASE_ARGS(); const bf16* Ag = (const bf16*)(ws + (l < 2 ? WS_G : WS_OG)); const bf16* Wl = (const bf16*)(ws + (l < 2 ? WS_WOC : WS_WOM)) + (size_t)(l & 1) * 1024 * 1024;
#if EN_GOUT
          { pg8::Gemm g{Ag, Wl, NMAIN, 1024, 1024}; pg8::StaticOrder S; S.init(NMAIN, 1024, G, bx); pg8::EpiBf16 E{(bf16*)(ws + WS_MB), 1024, 0, 0};
            pg8::gemm_phase<pg8::EpiBf16, pg8::StaticOrder, true, true>(ldsl, g, S, E, wave); }
          { pg8::Gemm g{Ag, Wl, NROWS, 1024, 1024 / GOUT_SPLITK, 1024}; pg8::SplitKSmallOrder<GOUT_SPLITK> S; S.init(1024, 1024, G, bx); pg8::EpiPartF32 E{(float*)(ws + WS_PARTG), 1024 / GOUT_SPLITK};
            pg8::gemm_phase<pg8::EpiPartF32, pg8::SplitKSmallOrder<GOUT_SPLITK>, true, true>(ldsl, g, S, E, wave); }
#endif
          if (l < 2) { constexpr int r_ = 96; if (TAIL_CONV && G == 256 && bx >= r_) { LANE_OPAQUE(); convert_set(args, l == 0 ? 2 : 4, ldsl, (bx - r_) * NWAVES + wave, (256 - r_) * NWAVES, wave, lane); }
                       else if (TAIL_CONV && G != 256 && l == 0) { LANE_OPAQUE(); convert_set(args, 2, ldsl, gw, NGW, wave, lane); convert_set(args, 4, ldsl, gw, NGW, wave, lane); } }
 }
        GRID_BAR();
#if EN_NORM
        { PHASE_ARGS(); LANE_OPAQUE(); norm_phase(args, l, gw, NGW, lane); }
#endif
        if (l < 3) GRID_BAR();
    }
}

extern "C" void kernel_launch(void* const* d_in, const int* in_sizes, int n_in, void* d_out, int out_size, void* d_ws, size_t ws_size, hipStream_t stream) {
    static int grid = 0;
    if (grid == 0) {
        if (n_in != 21 || out_size != (int)O_END || ws_size < WS_END) { fprintf(stderr, "kernel_launch: unexpected shapes: n_in %d out %d (want %zu) ws %zu (want >= %zu)\n", n_in, out_size, (size_t)O_END, ws_size, (size_t)WS_END); grid = -1; return; }
        int dev = 0, cus = 0, per_cu = 0;
        if (hipGetDevice(&dev) != hipSuccess || hipDeviceGetAttribute(&cus, hipDeviceAttributeMultiprocessorCount, dev) != hipSuccess) { grid = -1; return; }
        if (hipFuncSetAttribute((const void*)yoco_fwd, hipFuncAttributeMaxDynamicSharedMemorySize, LDS_BYTES) != hipSuccess) { fprintf(stderr, "kernel_launch: hipFuncSetAttribute failed\n"); grid = -1; return; }
        if (hipOccupancyMaxActiveBlocksPerMultiprocessor(&per_cu, (const void*)yoco_fwd, NWAVES * 64, LDS_BYTES) != hipSuccess || per_cu < 1) { fprintf(stderr, "kernel_launch: occupancy query says %d blocks per CU\n", per_cu); }
        (void)hipGetLastError();
        grid = cus;
    }
    if (grid < 0) return;
    if (hipMemsetAsync((char*)d_ws + WS_CTL, 0, CTL_ZERO_BYTES, stream) != hipSuccess) return;
    Args a{};
    a.x_prompt = (const float*)d_in[0]; a.x_sample = (const float*)d_in[1]; a.cache_ckv = (const float*)d_in[2]; a.cache_krope = (const float*)d_in[3]; a.state_conv = (const float*)d_in[4];
    a.page_table = (const int*)d_in[5]; a.meta = (const float*)d_in[6]; a.pre_g = (const float*)d_in[7]; a.post_g = (const float*)d_in[8]; a.w_in_conv = (const float*)d_in[9];
    a.conv_w = (const float*)d_in[10]; a.w_out_conv = (const float*)d_in[11]; a.kv_norm_g = (const float*)d_in[12]; a.w_dkv = (const float*)d_in[13]; a.kv_lat_g = (const float*)d_in[14];
    a.w_uk = (const float*)d_in[15]; a.w_uv = (const float*)d_in[16]; a.w_in_mla = (const float*)d_in[17]; a.q_norm_g = (const float*)d_in[18]; a.w_uq = (const float*)d_in[19]; a.w_out_mla = (const float*)d_in[20];
    a.out = (float*)d_out; a.ws = (unsigned char*)d_ws;
    hipLaunchKernelGGL(yoco_fwd, dim3(grid), dim3(NWAVES * 64), LDS_BYTES, stream, a);
    const hipError_t le = hipPeekAtLastError();
    if (le != hipSuccess) fprintf(stderr, "kernel_launch: launch failed: %s\n", hipGetErrorName(le));
}
```
